# Optimizing an MI355X kernel written in HIP

```python
import math
import jax, jax.numpy as jnp
from jax import lax
import numpy as np

D_MODEL = 2048
BATCH = 2
SEQ = 16384
DEPTH = 2

N_MEM = 256
HEAD_DIM = 128
MOBA_HEADS = 8
MOBA_BLOCK = 256
MOBA_TOPK = 3
MOBA_QBLOCK = 128
HGRN_HEADS = 4
HGRN_DK = 128
HGRN_DV = 128
HGRN_CHUNK = 64
MEM_HEADS = 4
D_FF = 5632
N_BRANCH = 3
RMS_EPS = 1e-6
NEG_INF = -1e30
F_MIN = 1e-20

MOBA_W = MOBA_HEADS * HEAD_DIM
HGRN_KW = HGRN_HEADS * HGRN_DK
HGRN_VW = HGRN_HEADS * HGRN_DV
MEM_W = MEM_HEADS * HEAD_DIM
N_IN = 3 * MOBA_W + 2 * HGRN_KW + 2 * HGRN_VW + MEM_W + N_BRANCH * D_MODEL

kernel_name = "hybrid_moba_hgrn2_memory_macaron"


def rms_norm(x, g):
    xf = x.astype(jnp.float32)
    r = lax.rsqrt(jnp.mean(xf * xf, axis=-1, keepdims=True) + RMS_EPS)
    return (xf * r).astype(x.dtype) * g


def swiglu_ffn(h, w1, w3, w2):
    return (jax.nn.silu(h @ w1) * (h @ w3)) @ w2


def alibi_slopes(n):
    return jnp.exp2(-8.0 * jnp.arange(1, n + 1, dtype=jnp.float32) / n)


def split_columns(p):
    sizes = (MOBA_W, MOBA_W, MOBA_W, HGRN_KW, HGRN_KW, HGRN_VW, HGRN_VW, MEM_W, N_BRANCH * D_MODEL)
    outs, off = [], 0
    for s in sizes:
        outs.append(p[..., off:off + s])
        off += s
    return outs


def moba_attention(q, k, v):
    B, T, H, Dh = q.shape
    BS, QB = MOBA_BLOCK, MOBA_QBLOCK
    Tp = -(-T // BS) * BS
    NB, NQ = Tp // BS, Tp // QB
    K = min(MOBA_TOPK, NB)
    scale = Dh ** -0.5

    def heads_major(a):
        a = jnp.pad(a, ((0, 0), (0, Tp - T), (0, 0), (0, 0)))
        return a.transpose(0, 2, 1, 3).reshape(B * H, Tp, Dh)

    qh, kh, vh = heads_major(q), heads_major(k), heads_major(v)
    kb = kh.reshape(B * H, NB, BS, Dh)
    vb = vh.reshape(B * H, NB, BS, Dh)
    k_mean = jnp.mean(kb.astype(jnp.float32), axis=2)
    t = jnp.arange(Tp, dtype=jnp.int32)
    n_past = t // BS
    past = jnp.arange(NB, dtype=jnp.int32)[None, :] < n_past[:, None]
    gate = jnp.einsum('ntd,nbd->ntb', qh.astype(jnp.float32), k_mean)
    gate = jnp.where(past[None], gate, NEG_INF)
    _, sel = lax.top_k(gate, K)
    sel_ok = (jnp.arange(K, dtype=jnp.int32)[None, :] < n_past[:, None]).reshape(NQ, QB, K)
    slopes = jnp.tile(alibi_slopes(H), B)
    offs_s = jnp.arange(BS, dtype=jnp.int32)
    offs_q = jnp.arange(QB, dtype=jnp.int32)

    def one_head(args):
        q_n, k_n, v_n, sel_n, m = args

        def one_block(args2):
            c, q_c, sel_c, ok_c = args2
            t_q = c * QB + offs_q
            own = (c * QB) // BS
            k_own, v_own = k_n[own], v_n[own]
            k_sel, v_sel = k_n[sel_c], v_n[sel_c]
            pos_own = own * BS + offs_s
            pos_sel = sel_c[..., None] * BS + offs_s
            d_own = (t_q[:, None] - pos_own[None, :]).astype(jnp.float32)
            d_sel = (t_q[:, None, None] - pos_sel).astype(jnp.float32)
            l_own = jnp.einsum('qd,sd->qs', q_c, k_own).astype(jnp.float32) * scale - m * d_own
            l_own = jnp.where(d_own >= 0, l_own, NEG_INF)
            l_sel = jnp.einsum('qd,qksd->qks', q_c, k_sel).astype(jnp.float32) * scale - m * d_sel
            l_sel = jnp.where(ok_c[..., None], l_sel, NEG_INF)
            p = jax.nn.softmax(jnp.concatenate([l_sel.reshape(QB, K * BS), l_own], axis=-1), axis=-1)
            p_sel = p[:, :K * BS].reshape(QB, K, BS).astype(v_n.dtype)
            p_own = p[:, K * BS:].astype(v_n.dtype)
            return jnp.einsum('qks,qksd->qd', p_sel, v_sel) + jnp.einsum('qs,sd->qd', p_own, v_own)

        return lax.map(one_block, (jnp.arange(NQ, dtype=jnp.int32), q_n, sel_n, sel_ok))

    out = lax.map(one_head, (qh.reshape(B * H, NQ, QB, Dh), kb, vb,
                             sel.reshape(B * H, NQ, QB, K), slopes))
    return out.reshape(B, H, Tp, Dh).transpose(0, 2, 1, 3)[:, :T]


def hgrn2_chunkwise(q, k, v, log_f):
    B, T, H, Dk = q.shape
    Dv = v.shape[-1]
    C = HGRN_CHUNK
    NC = T // C

    def to_chunks(a):
        return a.astype(jnp.float32).reshape(B, NC, C, H, a.shape[-1]).transpose(1, 0, 3, 2, 4)

    qc, kc, vc, gc = to_chunks(q), to_chunks(k), to_chunks(v), to_chunks(log_f)
    causal = jnp.tril(jnp.ones((C, C), dtype=bool))[:, :, None]

    def step(S, xs):
        qi, ki, vi, gi = xs
        G = jnp.cumsum(gi, axis=2)
        o_inter = jnp.einsum('bhcd,bhdv->bhcv', qi * jnp.exp(G), S)
        diff = G[:, :, :, None, :] - G[:, :, None, :, :]
        decay = jnp.where(causal, jnp.exp(jnp.minimum(diff, 0.0)), 0.0)
        A = jnp.einsum('bhtsd,bhsd->bhts', qi[:, :, :, None, :] * decay, ki)
        o_intra = jnp.einsum('bhts,bhsv->bhtv', A, vi)
        G_last = G[:, :, -1]
        S_new = jnp.exp(G_last)[..., None] * S + jnp.einsum(
            'bhsd,bhsv->bhdv', ki * jnp.exp(G_last[:, :, None] - G), vi)
        return S_new, o_inter + o_intra

    S0 = jnp.zeros((B, H, Dk, Dv), jnp.float32)
    _, o = lax.scan(step, S0, (qc, kc, vc, gc))
    return o.transpose(1, 0, 3, 2, 4).reshape(B, T, H, Dv)


def memory_attention(q, mk, mv):
    s = jnp.einsum('bthd,bmhd->bhtm', q, mk).astype(jnp.float32) * (q.shape[-1] ** -0.5)
    p = jax.nn.softmax(s, axis=-1).astype(mv.dtype)
    return jnp.einsum('bhtm,bmhd->bthd', p, mv)


def setup_inputs(seed: int = 0) -> dict:
    key = jax.random.key(seed)
    ks = jax.random.split(key, 24)
    f32 = jnp.float32

    def dense(k, shape, fan_in):
        return jax.random.normal(k, shape, f32) * (fan_in ** -0.5)

    def gain(k, shape):
        return 1.0 + 0.02 * jax.random.normal(k, shape, f32)

    L, D = DEPTH, D_MODEL
    return {
        'x': jax.random.normal(ks[0], (BATCH, SEQ, D), f32),
        'mem': jax.random.normal(ks[1], (BATCH, N_MEM, D), f32),
        'ffn1_norm': gain(ks[2], (L, D)),
        'ffn1_w1': dense(ks[3], (L, D, D_FF), D),
        'ffn1_w3': dense(ks[4], (L, D, D_FF), D),
        'ffn1_w2': dense(ks[5], (L, D_FF, D), D_FF),
        'mix_norm': gain(ks[6], (L, D)),
        'w_in': dense(ks[7], (L, D, N_IN), D),
        'hgrn_lb_logits': 0.5 * jax.random.normal(ks[8], (L, HGRN_KW), f32),
        'hgrn_out_norm': gain(ks[9], (L, HGRN_DV)),
        'mem_norm': gain(ks[10], (L, D)),
        'w_mem_kv': dense(ks[11], (L, D, 2 * MEM_W), D),
        'w_proj_moba': dense(ks[12], (L, MOBA_W, D), MOBA_W),
        'w_proj_hgrn': dense(ks[13], (L, HGRN_VW, D), HGRN_VW),
        'w_proj_mem': dense(ks[14], (L, MEM_W, D), MEM_W),
        'w_out': dense(ks[15], (L, D, D), D),
        'ffn2_norm': gain(ks[16], (L, D)),
        'ffn2_w1': dense(ks[17], (L, D, D_FF), D),
        'ffn2_w3': dense(ks[18], (L, D, D_FF), D),
        'ffn2_w2': dense(ks[19], (L, D_FF, D), D_FF),
        'final_norm': gain(ks[20], (D,)),
    }


def reference(x, mem, ffn1_norm, ffn1_w1, ffn1_w3, ffn1_w2, mix_norm, w_in, hgrn_lb_logits,
              hgrn_out_norm, mem_norm, w_mem_kv, w_proj_moba, w_proj_hgrn, w_proj_mem, w_out,
              ffn2_norm, ffn2_w1, ffn2_w3, ffn2_w2, final_norm):
    B, T, _ = x.shape
    M = mem.shape[1]
    p_lb = jax.nn.softmax(hgrn_lb_logits.astype(jnp.float32), axis=0)
    lower_bounds = jnp.cumsum(p_lb, axis=0) - p_lb[0:1]

    for l in range(DEPTH):
        x = x + 0.5 * swiglu_ffn(rms_norm(x, ffn1_norm[l]), ffn1_w1[l], ffn1_w3[l], ffn1_w2[l])

        h = rms_norm(x, mix_norm[l])
        qa, ka, va, qb, fb, ib, gb, qm, gates = split_columns(h @ w_in[l])

        hd = (B, T, MOBA_HEADS, HEAD_DIM)
        oa = moba_attention(qa.reshape(hd), ka.reshape(hd), va.reshape(hd)).reshape(B, T, MOBA_W)

        lb = lower_bounds[l]
        fb32 = fb.astype(jnp.float32)
        f_gate = lb + (1.0 - lb) * jax.nn.sigmoid(fb32)
        log_f = jnp.log(jnp.maximum(f_gate, F_MIN))
        k_b = (1.0 - lb) * jax.nn.sigmoid(-fb32)
        kd = (B, T, HGRN_HEADS, HGRN_DK)
        vd = (B, T, HGRN_HEADS, HGRN_DV)
        ob = hgrn2_chunkwise(jax.nn.silu(qb).reshape(kd), k_b.reshape(kd), ib.reshape(vd),
                             log_f.reshape(kd)).astype(x.dtype)
        ob = (rms_norm(ob, hgrn_out_norm[l]) * jax.nn.sigmoid(gb.reshape(vd))).reshape(B, T, HGRN_VW)

        kv = rms_norm(mem, mem_norm[l]) @ w_mem_kv[l]
        md = (B, M, MEM_HEADS, HEAD_DIM)
        om = memory_attention(qm.reshape(B, T, MEM_HEADS, HEAD_DIM),
                              kv[..., :MEM_W].reshape(md), kv[..., MEM_W:].reshape(md)).reshape(B, T, MEM_W)

        g = jax.nn.sigmoid(gates).reshape(B, T, N_BRANCH, D_MODEL)
        y = (g[:, :, 0] * (oa @ w_proj_moba[l])
             + g[:, :, 1] * (ob @ w_proj_hgrn[l])
             + g[:, :, 2] * (om @ w_proj_mem[l]))
        x = x + y @ w_out[l]

        x = x + 0.5 * swiglu_ffn(rms_norm(x, ffn2_norm[l]), ffn2_w1[l], ffn2_w3[l], ffn2_w2[l])

    return rms_norm(x, final_norm)
```

```cpp
#include <hip/hip_runtime.h>
#include <cstdio>
#include <cstdint>

#define LAS __attribute__((address_space(3)))
#define GAS __attribute__((address_space(1)))
namespace pg8 {
#define PG8_LAS __attribute__((address_space(3)))
typedef unsigned short bf16_t;
typedef short bf16x8 __attribute__((ext_vector_type(8)));
typedef float f32x4 __attribute__((ext_vector_type(4)));
typedef unsigned u32x4 __attribute__((ext_vector_type(4)));
constexpr int BM = 256, BK = 64, HALF = 128, HTB = HALF * BK * 2  , STAGE_BYTES = 8 * HTB, NXCD = 8, WGM = 8;

__host__ __device__ __forceinline__ int lds_byte(int r, int c) { const int st = (r >> 4) * 2 + (c >> 5), rr = r & 15, cc = c & 31, ob = rr * 64 + cc * 2; return st * 1024 + (ob ^ (((ob >> 9) & 1) << 5)); }
__host__ __device__ __forceinline__ void stage_rc(int b, int& R, int& C) { const int st = b / 1024, sb = b % 1024, swz = sb ^ (((sb >> 9) & 1) << 5); R = (st >> 1) * 16 + swz / 64; C = (st & 1) * 32 + (swz % 64) / 2; }
__host__ __device__ __forceinline__ int perm32(int rho) { const int n = rho >> 4, i = rho & 15; return 8 * (i >> 2) + 4 * n + (i & 3); }

struct Unit { int pm, pn, q; };
struct Gemm { const bf16_t* A; const bf16_t* Bt; int M, N, K, lda, ldb; };

struct StaticOrder {
    static constexpr bool VARK = false;
    int nM, nN, nwg, G, c, wgm;
    __host__ __device__ void init(int M, int N, int G_, int c_) { nM = M / BM; nN = N / BM; nwg = nM * nN; G = G_; c = c_; wgm = (nN == 8) ? 4 : WGM; }
    __host__ __device__ bool next(int i, Unit& u) const {
        const long L = (long)i * G + c; if (L >= nwg) return false;
        int wgid = (int)L; { const int q = nwg / NXCD, r = nwg % NXCD, xcd = wgid % NXCD, off = wgid / NXCD; wgid = (xcd < r ? xcd * (q + 1) : r * (q + 1) + (xcd - r) * q) + off; }
        const int nig = wgm * nN, gid = wgid / nig, fm = gid * wgm, gsz = (nM - fm) < wgm ? (nM - fm) : wgm;
        u.pm = fm + ((wgid % nig) % gsz); u.pn = (wgid % nig) / gsz; u.q = 0; return true;
    }
    __device__ __forceinline__ void a_ready(const Unit&) const {}
    __device__ __forceinline__ void done(const Unit&) const {}
};

template <int AO0, int AO1, int AO2, long WO0, long WO1, long WO2>
struct MergeOrder {
    static constexpr bool VARK = true;
    StaticOrder T; const char* A0; const char* W0;
    __device__ __forceinline__ bool next(int i, Unit& u) const { const int r = i / 3; if (!T.next(r, u)) return false; u.q = i - 3 * r; return true; }
    __device__ __forceinline__ void params(const Unit& u, const char*& pA, const char*& pB, int& ldb, int& nt) const {
        const int q = u.q; pA = A0 + (q == 0 ? AO0 : q == 1 ? AO1 : AO2); pB = W0 + (q == 0 ? WO0 : q == 1 ? WO1 : WO2); ldb = (q == 0) ? 1024 : 512; nt = ldb / BK; }
    __device__ __forceinline__ void a_ready(const Unit&) const {}
    __device__ __forceinline__ void done(const Unit&) const {}
};
typedef float f32x2 __attribute__((ext_vector_type(2)));
typedef __bf16 bf16x2_t __attribute__((ext_vector_type(2)));
__device__ __forceinline__ unsigned cvt_pk_bf16(float lo, float hi) { const f32x2 v = {lo, hi}; return __builtin_bit_cast(unsigned, __builtin_convertvector(v, bf16x2_t)); }
__device__ __forceinline__ float fsigmoid(float x) { return __builtin_amdgcn_rcpf(1.0f + __builtin_amdgcn_exp2f(-1.4426950408889634f * x)); }
__device__ __forceinline__ float xor32_sum(float x) { const unsigned u = __builtin_bit_cast(unsigned, x); const auto r = __builtin_amdgcn_permlane32_swap(u, u, false, false); return __builtin_bit_cast(float, (unsigned)r[0]) + __builtin_bit_cast(float, (unsigned)r[1]); }
__device__ __forceinline__ float xor32_max(float x) { const unsigned u = __builtin_bit_cast(unsigned, x); const auto r = __builtin_amdgcn_permlane32_swap(u, u, false, false); return fmaxf(__builtin_bit_cast(float, (unsigned)r[0]), __builtin_bit_cast(float, (unsigned)r[1])); }
__device__ __forceinline__ float xor16_sum(float x) { const unsigned u = __builtin_bit_cast(unsigned, x); const auto r = __builtin_amdgcn_permlane16_swap(u, u, false, false); return __builtin_bit_cast(float, (unsigned)r[0]) + __builtin_bit_cast(float, (unsigned)r[1]); }
__device__ __forceinline__ unsigned xor32_other(unsigned u, int hi_half) { const auto r = __builtin_amdgcn_permlane32_swap(u, u, false, false); return hi_half ? (unsigned)r[0] : (unsigned)r[1]; }
__device__ __forceinline__ float row16_sum(float x) {
    x += __builtin_bit_cast(float, __builtin_amdgcn_mov_dpp(__builtin_bit_cast(int, x), 0xB1, 0xF, 0xF, true));
    x += __builtin_bit_cast(float, __builtin_amdgcn_mov_dpp(__builtin_bit_cast(int, x), 0x4E, 0xF, 0xF, true));
    x += __builtin_bit_cast(float, __builtin_amdgcn_mov_dpp(__builtin_bit_cast(int, x), 0x141, 0xF, 0xF, true));
    x += __builtin_bit_cast(float, __builtin_amdgcn_mov_dpp(__builtin_bit_cast(int, x), 0x140, 0xF, 0xF, true));
    return x;
}
__device__ __forceinline__ float bflo(unsigned w) { return __builtin_bit_cast(float, w << 16); }
__device__ __forceinline__ float bfhi(unsigned w) { return __builtin_bit_cast(float, w & 0xffff0000u); }

struct NoState {};
struct RowScale8 { float r[2][4]; };
struct EpiBf16 {
    static constexpr bool PERM = true, AFTER_DRAIN = false, KEEP = false;
    typedef RowScale8 State;
    __device__ __forceinline__ void load_state(State& st, const Unit& u, int wr, int fr) const {
#pragma unroll
        for (int ai = 0; ai < 2; ++ai)
#pragma unroll
            for (int m = 0; m < 4; ++m) st.r[ai][m] = rs ? rs[u.pm * BM + wr * 64 + fr + ai * HALF + m * 16] : 1.f; }
    bf16_t* O; int ldc; unsigned modes; float* km; const float* rs; const float* cs;
    __device__ __forceinline__ void operator()(const f32x4 (&acc_in)[2][2][4][2], const Unit& u, int wr, int wc, int fr, int fq, const State& st) const {
        const int row0 = u.pm * BM + wr * 64 + fr, col0 = u.pn * BM + wc * 32 + 8 * fq;
        const unsigned mode = (modes >> (2 * (u.pn & 15))) & 3u;
        f32x4 acc[2][2][4][2];
#pragma unroll
        for (int ai = 0; ai < 2; ++ai)
#pragma unroll
            for (int m = 0; m < 4; ++m) { const float r = st.r[ai][m];
#pragma unroll
                for (int bj = 0; bj < 2; ++bj)
#pragma unroll
                    for (int n = 0; n < 2; ++n) acc[ai][bj][m][n] = acc_in[ai][bj][m][n] * r; }
        if (cs) {
#pragma unroll
            for (int bj = 0; bj < 2; ++bj) { const f32x4 c0 = *(const f32x4*)(cs + col0 + bj * HALF), c1 = *(const f32x4*)(cs + col0 + bj * HALF + 4);
#pragma unroll
                for (int ai = 0; ai < 2; ++ai)
#pragma unroll
                    for (int m = 0; m < 4; ++m) { acc[ai][bj][m][0] = acc[ai][bj][m][0] * c0; acc[ai][bj][m][1] = acc[ai][bj][m][1] * c1; } } }
#pragma unroll
        for (int ai = 0; ai < 2; ++ai)
#pragma unroll
            for (int m = 0; m < 4; ++m) { bf16_t* rowp = O + (size_t)(row0 + ai * HALF + m * 16) * ldc + col0;
#pragma unroll
                for (int bj = 0; bj < 2; ++bj) { f32x4 v0 = acc[ai][bj][m][0], v1 = acc[ai][bj][m][1];
                    if (mode != 0u) {
#pragma unroll
                        for (int j = 0; j < 4; ++j) { const float s0 = fsigmoid(v0[j]), s1 = fsigmoid(v1[j]); v0[j] = (mode == 1u) ? v0[j] * s0 : s0; v1[j] = (mode == 1u) ? v1[j] * s1 : s1; } }
                    u32x4 w; w.x = cvt_pk_bf16(v0[0], v0[1]); w.y = cvt_pk_bf16(v0[2], v0[3]); w.z = cvt_pk_bf16(v1[0], v1[1]); w.w = cvt_pk_bf16(v1[2], v1[3]);
                    *(u32x4*)(rowp + bj * HALF) = w; } }
        if (km != nullptr && u.pn >= 4 && u.pn < 8) {
            const int b = u.pm >> 6, blk = u.pm & 63;
#pragma unroll
            for (int bj = 0; bj < 2; ++bj)
#pragma unroll
                for (int n = 0; n < 2; ++n)
#pragma unroll
                    for (int e = 0; e < 4; ++e) {
                        float s = 0.f;
#pragma unroll
                        for (int ai = 0; ai < 2; ++ai)
#pragma unroll
                            for (int m = 0; m < 4; ++m) s += acc[ai][bj][m][n][e];
                        s = row16_sum(s);
                        if (fr == 0) { const int c = (u.pn - 4) * BM + bj * HALF + wc * 32 + 8 * fq + 4 * n + e, hd = c >> 7, d = c & 127;
                            __hip_atomic_fetch_add(km + ((size_t)((b * 8 + hd) * 64 + blk)) * 128 + d, s, __ATOMIC_RELAXED, __HIP_MEMORY_SCOPE_AGENT); }
                    }
        }
    }
};
struct EpiGateU8 {
    static constexpr bool PERM = true, AFTER_DRAIN = false, KEEP = false;
    unsigned char* O; int ldc; const float* rs;
    typedef RowScale8 State;
    __device__ __forceinline__ void load_state(State& st, const Unit& u, int wr, int fr) const {
#pragma unroll
        for (int ai = 0; ai < 2; ++ai)
#pragma unroll
            for (int m = 0; m < 4; ++m) st.r[ai][m] = rs[u.pm * BM + wr * 64 + fr + ai * HALF + m * 16]; }
    __device__ __forceinline__ void operator()(const f32x4 (&acc)[2][2][4][2], const Unit& u, int wr, int wc, int fr, int fq, const State& st) const {
        unsigned char* const tb = O + ((size_t)(u.pm * (ldc / BM) + u.pn) * 8 + (size_t)(wr * 4 + wc)) * 8192;
        const unsigned voff = (unsigned)(fr + 16 * fq) * 16u;
#pragma unroll
        for (int ai = 0; ai < 2; ++ai)
#pragma unroll
            for (int m = 0; m < 4; ++m) { const float rc = -1.4426950408889634f * st.r[ai][m]; unsigned q[2][8];
#pragma unroll
                for (int bj = 0; bj < 2; ++bj) {
#pragma unroll
                    for (int j = 0; j < 4; ++j) { q[bj][j] = (unsigned)fmaxf(__builtin_fmaf(__builtin_amdgcn_rcpf(1.0f + __builtin_amdgcn_exp2f(acc[ai][bj][m][0][j] * rc)), 255.f, 0.5f), 1.f); q[bj][4 + j] = (unsigned)fmaxf(__builtin_fmaf(__builtin_amdgcn_rcpf(1.0f + __builtin_amdgcn_exp2f(acc[ai][bj][m][1][j] * rc)), 255.f, 0.5f), 1.f); } }
                u32x4 w; w.x = q[0][0] | (q[0][1] << 8) | (q[0][2] << 16) | (q[0][3] << 24); w.y = q[0][4] | (q[0][5] << 8) | (q[0][6] << 16) | (q[0][7] << 24);
                w.z = q[1][0] | (q[1][1] << 8) | (q[1][2] << 16) | (q[1][3] << 24); w.w = q[1][4] | (q[1][5] << 8) | (q[1][6] << 16) | (q[1][7] << 24);
                *(u32x4*)(tb + (ai * 4 + m) * 1024 + voff) = w; }
    }
};
struct EpiSwiglu {
    static constexpr bool PERM = true, AFTER_DRAIN = false, KEEP = false;
    bf16_t* O; int ldc; const float* rs;
    typedef RowScale8 State;
    __device__ __forceinline__ void load_state(State& st, const Unit& u, int wr, int fr) const {
#pragma unroll
        for (int ai = 0; ai < 2; ++ai)
#pragma unroll
            for (int m = 0; m < 4; ++m) st.r[ai][m] = rs[u.pm * BM + wr * 64 + fr + ai * HALF + m * 16]; }
    __device__ __forceinline__ void operator()(const f32x4 (&acc)[2][2][4][2], const Unit& u, int wr, int wc, int fr, int fq, const State& st) const {
        const int row0 = u.pm * BM + wr * 64 + fr, col0 = u.pn * HALF + wc * 32 + 8 * fq;
#pragma unroll
        for (int ai = 0; ai < 2; ++ai)
#pragma unroll
            for (int m = 0; m < 4; ++m) { bf16_t* rowp = O + (size_t)(row0 + ai * HALF + m * 16) * ldc + col0; const float r = st.r[ai][m];
                const float rc = -1.4426950408889634f * r, r2 = r * r;
                const f32x4 a0 = acc[ai][0][m][0], a1 = acc[ai][0][m][1];
                const f32x4 p0 = (a0 * acc[ai][1][m][0]) * r2, p1 = (a1 * acc[ai][1][m][1]) * r2, x0 = a0 * rc, x1 = a1 * rc;
                f32x4 h0, h1;
#pragma unroll
                for (int j = 0; j < 4; ++j) { h0[j] = p0[j] * __builtin_amdgcn_rcpf(1.0f + __builtin_amdgcn_exp2f(x0[j])); h1[j] = p1[j] * __builtin_amdgcn_rcpf(1.0f + __builtin_amdgcn_exp2f(x1[j])); }
                u32x4 w; w.x = cvt_pk_bf16(h0[0], h0[1]); w.y = cvt_pk_bf16(h0[2], h0[3]); w.z = cvt_pk_bf16(h1[0], h1[1]); w.w = cvt_pk_bf16(h1[2], h1[3]);
                *(u32x4*)rowp = w; }
    }
};
struct EpiResid {
    static constexpr bool PERM = true, AFTER_DRAIN = false, KEEP = false;
    bf16_t* X; int ld; float scale; float* ssq;
    typedef NoState State;
    __device__ __forceinline__ void load_state(State&, const Unit&, int, int) const {}
    __device__ __forceinline__ void operator()(const f32x4 (&acc)[2][2][4][2], const Unit& u, int wr, int wc, int fr, int fq, const State&) const {
        const int row0 = u.pm * BM + wr * 64 + fr, col0 = u.pn * BM + wc * 32 + 8 * fq;
        u32x4 x[2][4][2];
#pragma unroll
        for (int ai = 0; ai < 2; ++ai)
#pragma unroll
            for (int m = 0; m < 4; ++m)
#pragma unroll
                for (int bj = 0; bj < 2; ++bj) x[ai][m][bj] = *(const u32x4*)(X + (size_t)(row0 + ai * HALF + m * 16) * ld + col0 + bj * HALF);
        asm volatile("" ::: "memory");
#pragma unroll
        for (int ai = 0; ai < 2; ++ai)
#pragma unroll
            for (int m = 0; m < 4; ++m)
            { float sq = 0.f;
#pragma unroll
                for (int bj = 0; bj < 2; ++bj) { const f32x4 v0 = acc[ai][bj][m][0], v1 = acc[ai][bj][m][1]; const u32x4 xx = x[ai][m][bj];
                    u32x4 w;
                    w.x = cvt_pk_bf16(bflo(xx.x) + scale * v0[0], bfhi(xx.x) + scale * v0[1]);
                    w.y = cvt_pk_bf16(bflo(xx.y) + scale * v0[2], bfhi(xx.y) + scale * v0[3]);
                    w.z = cvt_pk_bf16(bflo(xx.z) + scale * v1[0], bfhi(xx.z) + scale * v1[1]);
                    w.w = cvt_pk_bf16(bflo(xx.w) + scale * v1[2], bfhi(xx.w) + scale * v1[3]);
                    *(u32x4*)(X + (size_t)(row0 + ai * HALF + m * 16) * ld + col0 + bj * HALF) = w;
                    const float a0 = bflo(w.x), a1 = bfhi(w.x), a2 = bflo(w.y), a3 = bfhi(w.y), a4 = bflo(w.z), a5 = bfhi(w.z), a6 = bflo(w.w), a7 = bfhi(w.w);
                    sq += ((a0 * a0 + a1 * a1) + (a2 * a2 + a3 * a3)) + ((a4 * a4 + a5 * a5) + (a6 * a6 + a7 * a7)); }
                sq = xor32_sum(xor16_sum(sq));
                if (fq == 0) ssq[(size_t)(row0 + ai * HALF + m * 16) * 32 + u.pn * 4 + wc] = sq; }
        asm volatile("" ::: "memory");
    }
};
struct EpiMerge {
    static constexpr bool PERM = true, AFTER_DRAIN = false, KEEP = false;
    bf16_t* Y; int ldy; const unsigned char* Gt0; int ldg;
    typedef NoState State;
    __device__ __forceinline__ void load_state(State&, const Unit&, int, int) const {}
    __device__ __forceinline__ void operator()(const f32x4 (&acc)[2][2][4][2], const Unit& u, int wr, int wc, int fr, int fq, const State&) const {
        const int row0 = u.pm * BM + wr * 64 + fr, col0 = u.pn * BM + wc * 32 + 8 * fq;
        const unsigned char* Gt = Gt0 + u.q * ldy; const bool first = (u.q == 0);
#pragma unroll
        for (int ai = 0; ai < 2; ++ai) {
            typedef unsigned u32x2v __attribute__((ext_vector_type(2)));
            u32x2v g[4][2]; u32x4 yo[4][2];
#pragma unroll
            for (int m = 0; m < 4; ++m) { const size_t r = (size_t)(row0 + ai * HALF + m * 16);
#pragma unroll
                for (int bj = 0; bj < 2; ++bj) { g[m][bj] = *(const u32x2v*)(Gt + r * ldg + col0 + bj * HALF); yo[m][bj] = (u32x4){0u, 0u, 0u, 0u}; if (!first) yo[m][bj] = *(const u32x4*)(Y + r * ldy + col0 + bj * HALF); } }
            asm volatile("" ::: "memory");
#pragma unroll
            for (int m = 0; m < 4; ++m) { const size_t r = (size_t)(row0 + ai * HALF + m * 16);
#pragma unroll
                for (int bj = 0; bj < 2; ++bj) { const f32x4 v0 = acc[ai][bj][m][0], v1 = acc[ai][bj][m][1]; const u32x2v gg = g[m][bj]; const u32x4 yy = yo[m][bj]; constexpr float Q = 1.f / 255.f;
                    const float g0 = Q * (float)(gg.x & 255u), g1 = Q * (float)((gg.x >> 8) & 255u), g2 = Q * (float)((gg.x >> 16) & 255u), g3 = Q * (float)(gg.x >> 24);
                    const float g4 = Q * (float)(gg.y & 255u), g5 = Q * (float)((gg.y >> 8) & 255u), g6 = Q * (float)((gg.y >> 16) & 255u), g7 = Q * (float)(gg.y >> 24);
                    u32x4 w;
                    w.x = cvt_pk_bf16(bflo(yy.x) + g0 * v0[0], bfhi(yy.x) + g1 * v0[1]);
                    w.y = cvt_pk_bf16(bflo(yy.y) + g2 * v0[2], bfhi(yy.y) + g3 * v0[3]);
                    w.z = cvt_pk_bf16(bflo(yy.z) + g4 * v1[0], bfhi(yy.z) + g5 * v1[1]);
                    w.w = cvt_pk_bf16(bflo(yy.w) + g6 * v1[2], bfhi(yy.w) + g7 * v1[3]);
                    *(u32x4*)(Y + r * ldy + col0 + bj * HALF) = w; } }
            asm volatile("" ::: "memory");
        }
    }
};
struct EpiMergeR {
    static constexpr bool PERM = true, AFTER_DRAIN = false, KEEP = true;
    bf16_t* Y; int ldy; const unsigned char* Gt0; int ldg;
    typedef NoState State;
    __device__ __forceinline__ void load_state(State&, const Unit&, int, int) const {}
    static __device__ __forceinline__ float ub0(unsigned x) { return (float)(x & 255u); }
    static __device__ __forceinline__ float ub1(unsigned x) { return (float)((x >> 8) & 255u); }
    static __device__ __forceinline__ float ub2(unsigned x) { return (float)((x >> 16) & 255u); }
    static __device__ __forceinline__ float ub3(unsigned x) { return (float)(x >> 24); }
    __device__ __forceinline__ void operator()(f32x4 (&acc)[2][2][4][2], const Unit& u, int wr, int wc, int fr, int fq, const State&) const {
        typedef unsigned u32x2v __attribute__((ext_vector_type(2)));
        const int row0 = u.pm * BM + wr * 64 + fr, col0 = u.pn * BM + wc * 32 + 8 * fq;
        const unsigned char* const gp = Gt0 + ((size_t)(u.pm * (ldg / BM) + u.q * (ldy / BM) + u.pn) * 8 + (size_t)(wr * 4 + wc)) * 8192;
        const unsigned voffg = (unsigned)(fr + 16 * fq) * 16u;
        constexpr size_t NEXTQ = (size_t)8 * 65536;
        if (u.q < 2) {
            u32x2v ga[2][4][2], gb[2][4][2];
#pragma unroll
            for (int ai = 0; ai < 2; ++ai)
#pragma unroll
                for (int m = 0; m < 4; ++m) { const u32x4 wa = *(const u32x4*)(gp + (ai * 4 + m) * 1024 + voffg), wb = *(const u32x4*)(gp + NEXTQ + (ai * 4 + m) * 1024 + voffg);
                    ga[ai][m][0] = (u32x2v){wa.x, wa.y}; ga[ai][m][1] = (u32x2v){wa.z, wa.w}; gb[ai][m][0] = (u32x2v){wb.x, wb.y}; gb[ai][m][1] = (u32x2v){wb.z, wb.w}; }
            asm volatile("" ::: "memory");
#pragma unroll
            for (int ai = 0; ai < 2; ++ai)
#pragma unroll
                for (int m = 0; m < 4; ++m)
#pragma unroll
                    for (int bj = 0; bj < 2; ++bj) { const u32x2v a = ga[ai][m][bj], b = gb[ai][m][bj]; f32x4 v0 = acc[ai][bj][m][0], v1 = acc[ai][bj][m][1];
                        v0[0] *= ub0(a.x) * __builtin_amdgcn_rcpf(ub0(b.x)); v0[1] *= ub1(a.x) * __builtin_amdgcn_rcpf(ub1(b.x)); v0[2] *= ub2(a.x) * __builtin_amdgcn_rcpf(ub2(b.x)); v0[3] *= ub3(a.x) * __builtin_amdgcn_rcpf(ub3(b.x));
                        v1[0] *= ub0(a.y) * __builtin_amdgcn_rcpf(ub0(b.y)); v1[1] *= ub1(a.y) * __builtin_amdgcn_rcpf(ub1(b.y)); v1[2] *= ub2(a.y) * __builtin_amdgcn_rcpf(ub2(b.y)); v1[3] *= ub3(a.y) * __builtin_amdgcn_rcpf(ub3(b.y));
                        acc[ai][bj][m][0] = v0; acc[ai][bj][m][1] = v1; }
        } else {
            u32x2v g[2][4][2];
#pragma unroll
            for (int ai = 0; ai < 2; ++ai)
#pragma unroll
                for (int m = 0; m < 4; ++m)
                { const u32x4 wa = *(const u32x4*)(gp + (ai * 4 + m) * 1024 + voffg); g[ai][m][0] = (u32x2v){wa.x, wa.y}; g[ai][m][1] = (u32x2v){wa.z, wa.w}; }
            asm volatile("" ::: "memory");
#pragma unroll
            for (int ai = 0; ai < 2; ++ai)
#pragma unroll
                for (int m = 0; m < 4; ++m)
#pragma unroll
                    for (int bj = 0; bj < 2; ++bj) { const u32x2v gg = g[ai][m][bj]; const f32x4 v0 = acc[ai][bj][m][0], v1 = acc[ai][bj][m][1]; constexpr float Q = 1.f / 255.f;
                        u32x4 w;
                        w.x = cvt_pk_bf16(v0[0] * (Q * ub0(gg.x)), v0[1] * (Q * ub1(gg.x))); w.y = cvt_pk_bf16(v0[2] * (Q * ub2(gg.x)), v0[3] * (Q * ub3(gg.x)));
                        w.z = cvt_pk_bf16(v1[0] * (Q * ub0(gg.y)), v1[1] * (Q * ub1(gg.y))); w.w = cvt_pk_bf16(v1[2] * (Q * ub2(gg.y)), v1[3] * (Q * ub3(gg.y)));
                        *(u32x4*)(Y + (size_t)(row0 + ai * HALF + m * 16) * ldy + col0 + bj * HALF) = w; }
            asm volatile("" ::: "memory");
        }
    }
};
template <bool PERM>
__device__ __forceinline__ void voffb_for(int ldb, unsigned (&v)[2]) {
    int t = threadIdx.x; asm volatile("" : "+v"(t));
#pragma unroll
    for (int i = 0; i < 2; ++i) { int R, C; stage_rc(t * 16 + i * 8192, R, C); const int Rb = PERM ? ((R & ~31) + perm32(R & 31)) : R; v[i] = (unsigned)(Rb * ldb + C) * 2u; }
}
template <class Epi, class Sched, bool ALIGN_EPI = false, bool SP2 = false>
__device__ __forceinline__ void gemm_phase(PG8_LAS unsigned char* lds, const Gemm g, const Sched& S, const Epi& E) {
    int tid_ = threadIdx.x; asm volatile("" : "+v"(tid_));
    const int tid = tid_, wid = __builtin_amdgcn_readfirstlane(tid >> 6), lane = tid & 63, wr = wid >> 2, wc = wid & 3, fr = lane & 15, fq = lane >> 4;
    const int K = g.K; int nt = K / BK;
    unsigned voffA[2], voffB[2];
#pragma unroll
    for (int i = 0; i < 2; ++i) { int R, C; stage_rc(tid * 16 + i * 8192, R, C); const int Rb = Epi::PERM ? ((R & ~31) + perm32(R & 31)) : R;
        voffA[i] = (unsigned)(R * g.lda + C) * 2u; voffB[i] = (unsigned)(Rb * g.ldb + C) * 2u; }
    const size_t kstep = (size_t)(BK * 2);
    const size_t hstepA = (size_t)HALF * g.lda * 2; size_t hstepB = (size_t)HALF * g.ldb * 2;
    const size_t tstepA = 2 * hstepA; const size_t tstepB = 2 * hstepB;
    const unsigned ldsw = (unsigned)wid * 1024u;
    const int aoff = lds_byte(wr * 64 + fr, fq * 8), boff = lds_byte(wc * 32 + fr, fq * 8);
#define PG8_SA(b, h) (((b) * 2 + (h)) * HTB)
#define PG8_SB(b, h) ((4 + (b) * 2 + (h)) * HTB)
#define PG8_STAGE(bufoff, gbase, voff) do { _Pragma("unroll") for (int _i = 0; _i < 2; ++_i) \
        __builtin_amdgcn_global_load_lds((const unsigned*)((const char*)(gbase) + (voff)[_i]), (PG8_LAS unsigned*)(lds + (bufoff) + ldsw + _i * 8192), 16, 0, 0); } while (0)
#define PG8_LDA(dst, b, h) do { _Pragma("unroll") for (int m = 0; m < 4; ++m) _Pragma("unroll") for (int k = 0; k < 2; ++k) dst[m][k] = *(const PG8_LAS bf16x8*)(lds + PG8_SA(b, h) + aoff + m * 2048 + k * 1024); } while (0)
#define PG8_LDB(dst, b, h) do { _Pragma("unroll") for (int n = 0; n < 2; ++n) _Pragma("unroll") for (int k = 0; k < 2; ++k) dst[n][k] = *(const PG8_LAS bf16x8*)(lds + PG8_SB(b, h) + boff + n * 2048 + k * 1024); } while (0)
#define PG8_MMA(ai, bj, At, Bt) do { __builtin_amdgcn_s_setprio(1); _Pragma("unroll") for (int m = 0; m < 4; ++m) _Pragma("unroll") for (int n = 0; n < 2; ++n) _Pragma("unroll") for (int k = 0; k < 2; ++k) \
        acc[ai][bj][m][n] = __builtin_amdgcn_mfma_f32_16x16x32_bf16(Bt[n][k], At[m][k], acc[ai][bj][m][n], 0, 0, 0); __builtin_amdgcn_s_setprio(0); } while (0)
#define PG8_WAIT_V(n) asm volatile("s_waitcnt vmcnt(" #n ")" ::: "memory")
#define PG8_WAIT_L(n) asm volatile("s_waitcnt lgkmcnt(" #n ")" ::: "memory")
#define PG8_BAR __builtin_amdgcn_s_barrier()
#define PG8_SCHED __builtin_amdgcn_sched_barrier(0)
    Unit cur, nxt; int ui = 0;
    if (!S.next(0, cur)) return;
    f32x4 acc[2][2][4][2];
#pragma unroll
    for (int a = 0; a < 2; ++a)
#pragma unroll
        for (int b = 0; b < 2; ++b)
#pragma unroll
            for (int m = 0; m < 4; ++m)
#pragma unroll
                for (int n = 0; n < 2; ++n) acc[a][b][m][n] = (f32x4){0.f, 0.f, 0.f, 0.f};
    bf16x8 At[4][2], B0[2][2], B1[2][2];
    const char* cA = (const char*)g.A + (size_t)cur.pm * tstepA; const char* cB = (const char*)g.Bt + (size_t)cur.pn * tstepB;
    if constexpr (Sched::VARK) { const char* pA; const char* pB; int ldbc; S.params(cur, pA, pB, ldbc, nt); hstepB = (size_t)HALF * ldbc * 2; cA = pA + (size_t)cur.pm * tstepA; cB = pB + (size_t)cur.pn * (2 * hstepB);
        voffb_for<Epi::PERM>(ldbc, voffB); }
    typename Epi::State est; E.load_state(est, cur, wr, fr);
    S.a_ready(cur);
    if constexpr (SP2) {
        PG8_STAGE(PG8_SB(0, 0), cB, voffB); PG8_STAGE(PG8_SB(0, 1), cB + hstepB, voffB); PG8_STAGE(PG8_SA(0, 0), cA, voffA); PG8_STAGE(PG8_SA(0, 1), cA + hstepA, voffA);
        if (wr == 1) PG8_BAR;
        PG8_WAIT_V(2); PG8_BAR;
        PG8_STAGE(PG8_SB(1, 0), cB + kstep, voffB); PG8_STAGE(PG8_SA(1, 0), cA + kstep, voffA); PG8_STAGE(PG8_SB(1, 1), cB + hstepB + kstep, voffB);
        PG8_WAIT_V(6); PG8_BAR;
    } else {
        PG8_STAGE(PG8_SB(0, 0), cB, voffB); PG8_STAGE(PG8_SA(0, 0), cA, voffA); PG8_STAGE(PG8_SB(0, 1), cB + hstepB, voffB); PG8_STAGE(PG8_SA(0, 1), cA + hstepA, voffA);
        if (wr == 1) PG8_BAR;
        PG8_WAIT_V(4); PG8_BAR;
        PG8_STAGE(PG8_SB(1, 0), cB + kstep, voffB); PG8_STAGE(PG8_SA(1, 0), cA + kstep, voffA); PG8_STAGE(PG8_SB(1, 1), cB + hstepB + kstep, voffB);
        PG8_WAIT_V(6); PG8_BAR;
    }
    for (;;) {
        const bool has_next = S.next(ui + 1, nxt);
        const char* nA = has_next ? (const char*)g.A + (size_t)nxt.pm * tstepA : cA; const char* nB = has_next ? (const char*)g.Bt + (size_t)nxt.pn * tstepB : cB;
        unsigned voffBn[2] = {voffB[0], voffB[1]}; size_t hstepBn = hstepB; int ntn = nt;
        if constexpr (Sched::VARK) { if (has_next) { const char* pA; const char* pB; int ldbn; S.params(nxt, pA, pB, ldbn, ntn); hstepBn = (size_t)HALF * ldbn * 2; nA = pA + (size_t)nxt.pm * tstepA; nB = pB + (size_t)nxt.pn * (2 * hstepBn);
            voffb_for<Epi::PERM>(ldbn, voffBn); } }
        for (int t = 0; t < nt; t += 2) {
            const bool last = (t == nt - 2);
            const char* a1 = cA + (size_t)(t + 1) * kstep;
            const char* a2 = last ? nA : cA + (size_t)(t + 2) * kstep; const char* b2 = last ? nB : cB + (size_t)(t + 2) * kstep;
            const char* a3 = a2 + kstep; const char* b3 = b2 + kstep;
            if (last && has_next) S.a_ready(nxt);
            unsigned vBs[2]; size_t hsb;
            if constexpr (Sched::VARK) { vBs[0] = last ? voffBn[0] : voffB[0]; vBs[1] = last ? voffBn[1] : voffB[1]; hsb = last ? hstepBn : hstepB; } else { vBs[0] = voffB[0]; vBs[1] = voffB[1]; hsb = hstepB; }
            if constexpr (SP2) {
            PG8_LDB(B0, 0, 0); PG8_LDB(B1, 0, 1); PG8_SCHED; PG8_LDA(At, 0, 0); PG8_STAGE(PG8_SA(1, 1), a1 + hstepA, voffA);
            PG8_WAIT_V(8); PG8_WAIT_L(0); PG8_BAR; PG8_MMA(0, 0, At, B0); PG8_MMA(0, 1, At, B1); PG8_BAR; PG8_SCHED;
            PG8_LDA(At, 0, 1); PG8_STAGE(PG8_SB(0, 0), b2, vBs); PG8_STAGE(PG8_SB(0, 1), b2 + hsb, vBs); PG8_STAGE(PG8_SA(0, 0), a2, voffA);
            PG8_WAIT_V(8); PG8_WAIT_L(0); PG8_BAR; PG8_MMA(1, 0, At, B0); PG8_MMA(1, 1, At, B1); PG8_BAR; PG8_SCHED;
            PG8_LDB(B0, 1, 0); PG8_LDB(B1, 1, 1); PG8_SCHED; PG8_LDA(At, 1, 0); PG8_STAGE(PG8_SA(0, 1), a2 + hstepA, voffA);
            PG8_WAIT_V(8); PG8_WAIT_L(0); PG8_BAR; PG8_MMA(0, 0, At, B0); PG8_MMA(0, 1, At, B1); PG8_BAR; PG8_SCHED;
            PG8_LDA(At, 1, 1); PG8_STAGE(PG8_SB(1, 0), b3, vBs); PG8_STAGE(PG8_SB(1, 1), b3 + hsb, vBs); PG8_STAGE(PG8_SA(1, 0), a3, voffA);
            PG8_WAIT_V(8); PG8_WAIT_L(0); PG8_BAR; PG8_MMA(1, 0, At, B0); PG8_MMA(1, 1, At, B1); PG8_BAR; PG8_SCHED;
            } else {
            PG8_LDB(B0, 0, 0); PG8_SCHED; PG8_LDA(At, 0, 0); PG8_STAGE(PG8_SA(1, 1), a1 + hstepA, voffA);
            PG8_WAIT_L(8); PG8_BAR; PG8_WAIT_L(0); PG8_MMA(0, 0, At, B0); PG8_BAR; PG8_SCHED;
            PG8_LDB(B1, 0, 1); PG8_STAGE(PG8_SB(0, 0), b2, voffB);
            PG8_BAR; PG8_WAIT_L(0); PG8_MMA(0, 1, At, B1); PG8_BAR;
            PG8_LDA(At, 0, 1); PG8_STAGE(PG8_SA(0, 0), a2, voffA);
            PG8_BAR; PG8_WAIT_L(0); PG8_MMA(1, 0, At, B0); PG8_BAR; PG8_SCHED;
            PG8_STAGE(PG8_SB(0, 1), b2 + hstepB, voffB);
            PG8_WAIT_V(6); PG8_BAR; PG8_MMA(1, 1, At, B1); PG8_BAR;
            PG8_LDB(B0, 1, 0); PG8_SCHED; PG8_LDA(At, 1, 0); PG8_STAGE(PG8_SA(0, 1), a2 + hstepA, voffA);
            PG8_WAIT_L(8); PG8_BAR; PG8_WAIT_L(0); PG8_MMA(0, 0, At, B0); PG8_BAR; PG8_SCHED;
            PG8_LDB(B1, 1, 1); PG8_STAGE(PG8_SB(1, 0), b3, voffB);
            PG8_BAR; PG8_WAIT_L(0); PG8_MMA(0, 1, At, B1); PG8_BAR;
            PG8_LDA(At, 1, 1); PG8_STAGE(PG8_SA(1, 0), a3, voffA);
            PG8_BAR; PG8_WAIT_L(0); PG8_MMA(1, 0, At, B0); PG8_BAR; PG8_SCHED;
            PG8_STAGE(PG8_SB(1, 1), b3 + hstepB, voffB);
            PG8_WAIT_V(6); PG8_BAR; PG8_MMA(1, 1, At, B1); PG8_BAR;
            }
        }
        if constexpr (ALIGN_EPI) { if (wr == 0) PG8_BAR; }
        if constexpr (!Epi::AFTER_DRAIN) { E(acc, cur, wr, wc, fr, fq, est); S.done(cur); }
        if (!has_next) break;
        if (!Epi::KEEP || cur.q == 2) {
#pragma unroll
        for (int a = 0; a < 2; ++a)
#pragma unroll
            for (int b = 0; b < 2; ++b)
#pragma unroll
                for (int m = 0; m < 4; ++m)
#pragma unroll
                    for (int n = 0; n < 2; ++n) acc[a][b][m][n] = (f32x4){0.f, 0.f, 0.f, 0.f};
        }
        cur = nxt; cA = nA; cB = nB; ++ui; E.load_state(est, cur, wr, fr);
        if constexpr (Sched::VARK) { voffB[0] = voffBn[0]; voffB[1] = voffBn[1]; hstepB = hstepBn; nt = ntn; }
        if constexpr (ALIGN_EPI) { if (wr == 1) PG8_BAR; }
    }
    PG8_WAIT_V(0);
    if constexpr (!ALIGN_EPI) { if (wr == 0) PG8_BAR; }
    PG8_BAR;
    if constexpr (Epi::AFTER_DRAIN) { E.fused(acc, cur, wr, wc, fr, fq, lds, wid, lane); S.done(cur); }
#undef PG8_SA
#undef PG8_SB
#undef PG8_STAGE
#undef PG8_LDA
#undef PG8_LDB
#undef PG8_MMA
#undef PG8_WAIT_V
#undef PG8_WAIT_L
#undef PG8_BAR
#undef PG8_SCHED
}
}

typedef unsigned short bf16;
typedef unsigned v4u __attribute__((ext_vector_type(4)));
typedef unsigned v2u __attribute__((ext_vector_type(2)));
typedef float f32x4 __attribute__((ext_vector_type(4)));
typedef float f32x16 __attribute__((ext_vector_type(16)));
typedef short bf16x8 __attribute__((ext_vector_type(8)));
typedef GAS unsigned gu32;
#define RLX_AGENT __ATOMIC_RELAXED, __HIP_MEMORY_SCOPE_AGENT
#define LDS_WAIT() asm volatile("s_waitcnt lgkmcnt(0)" ::: "memory")
#define VM_WAIT() asm volatile("s_waitcnt vmcnt(0)" ::: "memory")
#define MFMA32(a, b, c) __builtin_amdgcn_mfma_f32_32x32x16_bf16((a), (b), (c), 0, 0, 0)
__device__ __forceinline__ unsigned f2bf(float f) { return pg8::cvt_pk_bf16(f, 0.f) & 0xffffu; }
__device__ __forceinline__ unsigned pk2(float lo, float hi) { return pg8::cvt_pk_bf16(lo, hi); }
__device__ __forceinline__ float bf2f(unsigned short b) { return __builtin_bit_cast(float, (unsigned)b << 16); }
using pg8::bflo; using pg8::bfhi; using pg8::fsigmoid;
__device__ __forceinline__ float fexp2(float x) { return __builtin_amdgcn_exp2f(x); }
__device__ __forceinline__ float fexp(float x) { return __builtin_amdgcn_exp2f(1.4426950408889634f * x); }
__device__ __forceinline__ bf16x8 as_bf16x8(v4u v) { return __builtin_bit_cast(bf16x8, v); }

constexpr int BATCH = 2, T = 16384, D = 2048, M = BATCH * T, DFF = 5632, NMEM = 256, DEPTH = 2;
constexpr int NMAIN = 4096, NVT = 1536, NGATE = 6144, NIN = 11776;
constexpr int CQA = 0, CKA = 1024, CQB = 2048, CFB = 2560, CGB = 3072, CQM = 3584;
constexpr int NWAVES = 8;
constexpr float RMS_EPS = 1e-6f;
constexpr size_t MiB = 1u << 20;
constexpr size_t WS_CTL = 0, CTL_ZERO_BYTES = 2 * MiB;
constexpr size_t WS_KMEAN = 1 * MiB;
constexpr size_t WS_R0 = 2 * MiB;
constexpr size_t WS_PM = 130 * MiB;
constexpr size_t WS_VT = 386 * MiB;
constexpr size_t WS_PG = 482 * MiB;
constexpr size_t WS_PO = WS_PG;
constexpr size_t WS_ML = WS_PG + 192 * MiB;
constexpr size_t WS_ST = WS_PG + 200 * MiB;
constexpr size_t WS_DEC = WS_PG + 328 * MiB;
constexpr size_t WS_SEL = WS_PG + 330 * MiB;
constexpr size_t WS_W = 866 * MiB;
constexpr size_t WS_MEMN = 932 * MiB;
constexpr size_t WS_WKV = 936 * MiB;
constexpr size_t WS_KM = 944 * MiB;
constexpr size_t WS_VMT = 945 * MiB;
constexpr size_t WS_RS = 946 * MiB;
constexpr size_t WS_SSQ = 947 * MiB;
constexpr size_t WS_END = 951 * MiB;
constexpr size_t WO_W2 = 44 * MiB, WO_PA = 46 * MiB, WO_PB = 50 * MiB, WO_PMM = 52 * MiB, WO_OUT = 54 * MiB;
constexpr int CW_TMO = 0, CW_BAR = 4096;
constexpr int RING_OFF = 0, RING_BYTES = 131072;
constexpr int SCR_BYTES = 155648;
constexpr int MISC_OFF = SCR_BYTES;
constexpr int LDS_BYTES = 163840;
constexpr int KSB = 272, VSB = 520;
constexpr int KS_OFF = 0, VS_OFF = 256 * KSB  , LIST_OFF = VS_OFF + 128 * VSB  , WCNT_OFF = LIST_OFF + 16384;
static_assert(WCNT_OFF + 64 <= SCR_BYTES, "LDS map");

#define XB_TMO      128
#define XB_XCNT(j)  (256  + 64 * (j))
#define XB_XSUB(j)  (1280 + 64 * (j))
#define XB_XGEN(j)  (2304 + 64 * (j))
#define XB_TOP      3328
#define XB_TOPGEN   3392
#define XCD_BAR_WORDS 3456
#define XB_SPIN_CAP (1u << 18)

__device__ __forceinline__ unsigned xb_ld(unsigned* p)              { return __hip_atomic_load(p, __ATOMIC_RELAXED, __HIP_MEMORY_SCOPE_AGENT); }
__device__ __forceinline__ unsigned xb_add(unsigned* p, unsigned v) { return __hip_atomic_fetch_add(p, v, __ATOMIC_RELAXED, __HIP_MEMORY_SCOPE_AGENT); }
__device__ __forceinline__ unsigned xb_xcc_id() { return (unsigned)__builtin_amdgcn_s_getreg((3 << 11) | 20) & 0xFu; }
#define XB_SPIN(cond, bar) do { unsigned _sp = 0; while (cond) { __builtin_amdgcn_s_sleep(1); \
    if ((++_sp & 255u) == 0u) { if (xb_ld(&(bar)[XB_TMO])) break; if (_sp > XB_SPIN_CAP) { atomicAdd(&(bar)[XB_TMO], 1u); break; } } } } while (0)

struct XcdBarrier {
    unsigned* bar; unsigned x;
    volatile LAS unsigned* st;
};

__device__ __forceinline__ XcdBarrier xcd_barrier_post(unsigned* bar, volatile LAS unsigned* st) {
    XcdBarrier b; b.bar = bar; b.x = xb_xcc_id(); b.st = st;
    if (threadIdx.x == 0) (void)xb_add(&bar[XB_XCNT(b.x)], 1u);
    return b;
}
__device__ __forceinline__ void xcd_barrier_complete(unsigned* bar, unsigned x, unsigned& nloc, unsigned& nx) {
    const unsigned G = gridDim.x * gridDim.y * gridDim.z;
    unsigned sum, cnt, mine, sp = 0u;
    for (;;) {
        sum = 0u; cnt = 0u; mine = 0u;
#pragma unroll
        for (unsigned j = 0; j < 16; ++j) { const unsigned c = xb_ld(&bar[XB_XCNT(j)]); sum += c; cnt += (c > 0u) ? 1u : 0u; mine = (j == x) ? c : mine; }
        if (sum == G) break;
        __builtin_amdgcn_s_sleep(1);
        if ((++sp & 255u) == 0u) { if (xb_ld(&bar[XB_TMO])) break; if (sp > XB_SPIN_CAP) { atomicAdd(&bar[XB_TMO], 1u); break; } }
    }
    nloc = mine > 0u ? mine : 1u; nx = cnt > 0u ? cnt : 1u;
}

__device__ __forceinline__ void xcd_barrier(const XcdBarrier& b) {
    asm volatile("s_waitcnt vmcnt(0)" ::: "memory");
    __syncthreads();
    if (threadIdx.x == 0) {
        unsigned* bar = b.bar;
        __builtin_amdgcn_s_waitcnt(0);
        unsigned nloc = b.st[0], nx = b.st[1];
        if (nloc == 0u) { xcd_barrier_complete(bar, b.x, nloc, nx); b.st[0] = nloc; b.st[1] = nx; }
        const unsigned old = xb_add(&bar[XB_XSUB(b.x)], 1u);
        const unsigned gen = old / nloc;
        if (old + 1u == (gen + 1u) * nloc) {
            __builtin_amdgcn_fence(__ATOMIC_RELEASE, "agent");
            asm volatile("s_waitcnt vmcnt(0)" ::: "memory");
            const unsigned og = xb_add(&bar[XB_TOP], 1u);
            const unsigned tg = og / nx;
            if (og + 1u == (tg + 1u) * nx) xb_add(&bar[XB_TOPGEN], 1u);
            else XB_SPIN(xb_ld(&bar[XB_TOPGEN]) == tg, bar);
            __builtin_amdgcn_fence(__ATOMIC_ACQUIRE, "agent");
            xb_add(&bar[XB_XGEN(b.x)], 1u);
            asm volatile("s_waitcnt vmcnt(0)" ::: "memory");
        } else {
            XB_SPIN(xb_ld(&bar[XB_XGEN(b.x)]) == gen, bar);
            __builtin_amdgcn_fence(__ATOMIC_ACQUIRE, "agent");
            asm volatile("s_waitcnt vmcnt(0)" ::: "memory");
        }
    }
    __syncthreads();
}


__device__ __forceinline__ float wave_sum(float v) {
    return pg8::xor32_sum(pg8::xor16_sum(pg8::row16_sum(v)));
}
__device__ __forceinline__ void rms_row_bf16(const float* xrow, const float* g, bf16* orow, int lane, bf16* xb = nullptr) {
    const f32x4* xr = (const f32x4*)xrow + lane; const f32x4* gr = (const f32x4*)g + lane;
    f32x4 v[8]; float s = 0.f;
#pragma unroll
    for (int j = 0; j < 8; ++j) { v[j] = xr[64 * j]; s += (v[j].x * v[j].x + v[j].y * v[j].y) + (v[j].z * v[j].z + v[j].w * v[j].w); }
    const float r = __builtin_amdgcn_rsqf(wave_sum(s) * (1.f / D) + RMS_EPS);
    v2u* o8 = (v2u*)orow + lane;
#pragma unroll
    for (int j = 0; j < 8; ++j) { const f32x4 gg = gr[64 * j]; v2u w; w.x = pk2(v[j].x * r * gg.x, v[j].y * r * gg.y); w.y = pk2(v[j].z * r * gg.z, v[j].w * r * gg.w); o8[64 * j] = w; }
    if (xb != nullptr) { v2u* x8 = (v2u*)xb + lane;
#pragma unroll
        for (int j = 0; j < 8; ++j) { v2u w; w.x = pk2(v[j].x, v[j].y); w.y = pk2(v[j].z, v[j].w); x8[64 * j] = w; } }
}
__device__ __forceinline__ void rms_xb_bf16(const bf16* xrow, const float* g, bf16* orow, int lane) {
    const v4u* xr = (const v4u*)xrow + lane; const f32x4* gr = (const f32x4*)g + 2 * lane;
    float v[4][8]; float s = 0.f;
#pragma unroll
    for (int j = 0; j < 4; ++j) { const v4u w = xr[64 * j]; v[j][0] = bflo(w.x); v[j][1] = bfhi(w.x); v[j][2] = bflo(w.y); v[j][3] = bfhi(w.y); v[j][4] = bflo(w.z); v[j][5] = bfhi(w.z); v[j][6] = bflo(w.w); v[j][7] = bfhi(w.w);
#pragma unroll
        for (int e = 0; e < 8; ++e) s += v[j][e] * v[j][e]; }
    const float r = __builtin_amdgcn_rsqf(wave_sum(s) * (1.f / D) + RMS_EPS);
    v4u* o = (v4u*)orow + lane;
#pragma unroll
    for (int j = 0; j < 4; ++j) { const f32x4 g0 = gr[128 * j], g1 = gr[128 * j + 1]; v4u w;
        w.x = pk2(v[j][0] * r * g0.x, v[j][1] * r * g0.y); w.y = pk2(v[j][2] * r * g0.z, v[j][3] * r * g0.w); w.z = pk2(v[j][4] * r * g1.x, v[j][5] * r * g1.y); w.w = pk2(v[j][6] * r * g1.z, v[j][7] * r * g1.w); o[64 * j] = w; }
}
__device__ __forceinline__ void rms_xb_f32(const bf16* xrow, const float* g, float* orow, int lane) {
    const v4u* xr = (const v4u*)xrow + lane; const f32x4* gr = (const f32x4*)g + 2 * lane;
    float v[4][8]; float s = 0.f;
#pragma unroll
    for (int j = 0; j < 4; ++j) { const v4u w = xr[64 * j]; v[j][0] = bflo(w.x); v[j][1] = bfhi(w.x); v[j][2] = bflo(w.y); v[j][3] = bfhi(w.y); v[j][4] = bflo(w.z); v[j][5] = bfhi(w.z); v[j][6] = bflo(w.w); v[j][7] = bfhi(w.w);
#pragma unroll
        for (int e = 0; e < 8; ++e) s += v[j][e] * v[j][e]; }
    const float r = __builtin_amdgcn_rsqf(wave_sum(s) * (1.f / D) + RMS_EPS);
    f32x4* o = (f32x4*)orow + 2 * lane;
#pragma unroll
    for (int j = 0; j < 4; ++j) { const f32x4 g0 = gr[128 * j], g1 = gr[128 * j + 1];
        o[128 * j] = (f32x4){v[j][0] * r * g0.x, v[j][1] * r * g0.y, v[j][2] * r * g0.z, v[j][3] * r * g0.w}; o[128 * j + 1] = (f32x4){v[j][4] * r * g1.x, v[j][5] * r * g1.y, v[j][6] * r * g1.z, v[j][7] * r * g1.w}; }
}
__device__ __forceinline__ void rms_xb_f32_x4(const bf16* x0, size_t rstride, const float* g, float* o0, size_t ostride, int lane) {
    v4u w[4][4];
#pragma unroll
    for (int q = 0; q < 4; ++q)
#pragma unroll
        for (int j = 0; j < 4; ++j) w[q][j] = ((const v4u*)(x0 + q * rstride) + lane)[64 * j];
    const f32x4* gr = (const f32x4*)g + 2 * lane;
#pragma unroll
    for (int q = 0; q < 4; ++q) { float v[4][8]; float s = 0.f;
#pragma unroll
        for (int j = 0; j < 4; ++j) { const v4u ww = w[q][j]; v[j][0] = bflo(ww.x); v[j][1] = bfhi(ww.x); v[j][2] = bflo(ww.y); v[j][3] = bfhi(ww.y); v[j][4] = bflo(ww.z); v[j][5] = bfhi(ww.z); v[j][6] = bflo(ww.w); v[j][7] = bfhi(ww.w);
#pragma unroll
            for (int e = 0; e < 8; ++e) s += v[j][e] * v[j][e]; }
        const float r = __builtin_amdgcn_rsqf(wave_sum(s) * (1.f / D) + RMS_EPS);
        f32x4* o = (f32x4*)(o0 + q * ostride) + 2 * lane;
#pragma unroll
        for (int j = 0; j < 4; ++j) { const f32x4 g0 = gr[128 * j], g1 = gr[128 * j + 1];
            o[128 * j] = (f32x4){v[j][0] * r * g0.x, v[j][1] * r * g0.y, v[j][2] * r * g0.z, v[j][3] * r * g0.w}; o[128 * j + 1] = (f32x4){v[j][4] * r * g1.x, v[j][5] * r * g1.y, v[j][6] * r * g1.z, v[j][7] * r * g1.w}; } }
}
__device__ __forceinline__ float rms_stat_xb(const bf16* xrow, int lane) {
    const v4u* xr = (const v4u*)xrow + lane; float s = 0.f;
#pragma unroll
    for (int j = 0; j < 4; ++j) { const v4u w = xr[64 * j]; const float a0 = bflo(w.x), a1 = bfhi(w.x), a2 = bflo(w.y), a3 = bfhi(w.y), a4 = bflo(w.z), a5 = bfhi(w.z), a6 = bflo(w.w), a7 = bfhi(w.w);
        s += ((a0 * a0 + a1 * a1) + (a2 * a2 + a3 * a3)) + ((a4 * a4 + a5 * a5) + (a6 * a6 + a7 * a7)); }
    return __builtin_amdgcn_rsqf(wave_sum(s) * (1.f / D) + RMS_EPS);
}
__device__ __forceinline__ float rms_stat_partials(const float* ssq_row) {
    float s = 0.f;
#pragma unroll
    for (int i = 0; i < 8; ++i) { const f32x4 v = ((const f32x4*)ssq_row)[i]; s += (v.x + v.y) + (v.z + v.w); }
    return __builtin_amdgcn_rsqf(s * (1.f / D) + RMS_EPS);
}
__device__ __forceinline__ float rms_stat_f32_copy(const float* xrow, bf16* xb, int lane) {
    const f32x4* xr = (const f32x4*)xrow + lane; v2u* x8 = (v2u*)xb + lane; float s = 0.f;
#pragma unroll
    for (int j = 0; j < 8; ++j) { const f32x4 v = xr[64 * j]; v2u w; w.x = pk2(v.x, v.y); w.y = pk2(v.z, v.w); x8[64 * j] = w;
        const float a0 = bflo(w.x), a1 = bfhi(w.x), a2 = bflo(w.y), a3 = bfhi(w.y); s += (a0 * a0 + a1 * a1) + (a2 * a2 + a3 * a3); }
    return __builtin_amdgcn_rsqf(wave_sum(s) * (1.f / D) + RMS_EPS);
}
__device__ __forceinline__ void rms_stat_f32_copy_x2(const float* x0, const float* x1, bf16* b0, bf16* b1, float* rs0, float* rs1, int lane) {
    f32x4 va[8], vb[8];
#pragma unroll
    for (int j = 0; j < 8; ++j) { va[j] = ((const f32x4*)x0 + lane)[64 * j]; vb[j] = ((const f32x4*)x1 + lane)[64 * j]; }
    float sa = 0.f, sb = 0.f;
#pragma unroll
    for (int j = 0; j < 8; ++j) { v2u w; w.x = pk2(va[j].x, va[j].y); w.y = pk2(va[j].z, va[j].w); ((v2u*)b0 + lane)[64 * j] = w;
        { const float a0 = bflo(w.x), a1 = bfhi(w.x), a2 = bflo(w.y), a3 = bfhi(w.y); sa += (a0 * a0 + a1 * a1) + (a2 * a2 + a3 * a3); }
        w.x = pk2(vb[j].x, vb[j].y); w.y = pk2(vb[j].z, vb[j].w); ((v2u*)b1 + lane)[64 * j] = w;
        { const float a0 = bflo(w.x), a1 = bfhi(w.x), a2 = bflo(w.y), a3 = bfhi(w.y); sb += (a0 * a0 + a1 * a1) + (a2 * a2 + a3 * a3); } }
    const float ra = __builtin_amdgcn_rsqf(wave_sum(sa) * (1.f / D) + RMS_EPS), rb = __builtin_amdgcn_rsqf(wave_sum(sb) * (1.f / D) + RMS_EPS);
    if (lane == 0) { *rs0 = ra; *rs1 = rb; }
}
__device__ __forceinline__ void rms_row_f32(const float* xrow, const float* g, float* orow, int lane) {
    const f32x4* xr = (const f32x4*)xrow + lane; const f32x4* gr = (const f32x4*)g + lane;
    f32x4 v[8]; float s = 0.f;
#pragma unroll
    for (int j = 0; j < 8; ++j) { v[j] = xr[64 * j]; s += (v[j].x * v[j].x + v[j].y * v[j].y) + (v[j].z * v[j].z + v[j].w * v[j].w); }
    const float r = __builtin_amdgcn_rsqf(wave_sum(s) * (1.f / D) + RMS_EPS);
    f32x4* o = (f32x4*)orow + lane;
#pragma unroll
    for (int j = 0; j < 8; ++j) { const f32x4 gg = gr[64 * j]; o[64 * j] = v[j] * r * gg; }
}
template <int NT>
__device__ __forceinline__ void transpose_items(const float* W, int N, const int (&k0)[NT], const int (&n0)[NT], bf16* WT, int Kd, const int (&drow0)[NT], LAS float* scr, int lane, const float* gk) {
    float v[NT][32];
#pragma unroll
    for (int t = 0; t < NT; ++t)
#pragma unroll
        for (int i = 0; i < 32; ++i) v[t][i] = W[(size_t)(k0[t] + 2 * i + (lane >> 5)) * N + n0[t] + (lane & 31)];
#pragma unroll
    for (int t = 0; t < NT; ++t)
#pragma unroll
        for (int i = 0; i < 32; ++i) scr[t * 2112 + (2 * i + (lane >> 5)) * 33 + (lane & 31)] = v[t][i];
    LDS_WAIT(); asm volatile("" ::: "memory");
    const int c = lane & 7;
#pragma unroll
    for (int t = 0; t < NT; ++t) {
        f32x4 ga = {1.f, 1.f, 1.f, 1.f}, gb = {1.f, 1.f, 1.f, 1.f}; if (gk) { ga = *(const f32x4*)(gk + k0[t] + 8 * c); gb = *(const f32x4*)(gk + k0[t] + 8 * c + 4); }
#pragma unroll
        for (int j = 0; j < 4; ++j) { const int n = (lane >> 3) + 8 * j; const LAS float* s = scr + t * 2112 + (8 * c) * 33 + n;
            v4u o; o.x = pk2(s[0 * 33] * ga.x, s[1 * 33] * ga.y); o.y = pk2(s[2 * 33] * ga.z, s[3 * 33] * ga.w); o.z = pk2(s[4 * 33] * gb.x, s[5 * 33] * gb.y); o.w = pk2(s[6 * 33] * gb.z, s[7 * 33] * gb.w);
            *(v4u*)(WT + (size_t)(drow0[t] + n) * Kd + k0[t] + 8 * c) = o; } }
    LDS_WAIT(); asm volatile("" ::: "memory");
}
__device__ __forceinline__ int win_row(int n) {
    if (n < 2048) return n;
    if (n < 3072) return 4096 + (n - 2048);
    if (n < 3584) return 2048 + (n - 3072);
    if (n < 4096) return 2560 + (n - 3584);
    if (n < 4608) return 5120 + (n - 4096);
    if (n < 5120) return 3072 + (n - 4608);
    if (n < 5632) return 3584 + (n - 5120);
    return n;
}
__device__ __forceinline__ void convert_matrix(const float* W, int K, int N, bf16* WT, int kind, int off, LAS float* scr, int gw, int NGW, int lane, const float* gk = nullptr) {
    const int nblk = N / 32, nitems = (K / 64) * nblk;
    int it = gw;
    for (; it + NGW < nitems; it += 2 * NGW) {
        int k0[2], n0[2], dr[2];
#pragma unroll
        for (int t = 0; t < 2; ++t) { const int i2 = it + t * NGW, kb = i2 / nblk, nb = i2 % nblk; k0[t] = 64 * kb; n0[t] = 32 * nb;
            dr[t] = (kind == 0) ? n0[t] + off : (kind == 1) ? (n0[t] >> 7) * 256 + off + (n0[t] & 127) : win_row(n0[t]); }
        transpose_items<2>(W, N, k0, n0, WT, K, dr, scr, lane, gk); }
    if (it < nitems) { const int kb = it / nblk, nb = it % nblk; const int k0[1] = {64 * kb}, n0[1] = {32 * nb};
        const int dr[1] = {(kind == 0) ? n0[0] + off : (kind == 1) ? (n0[0] >> 7) * 256 + off + (n0[0] & 127) : win_row(n0[0])};
        transpose_items<1>(W, N, k0, n0, WT, K, dr, scr, lane, gk); }
}
template <int ROWS, int ROWBYTES, int SB>
__device__ __forceinline__ void lds_fill(LAS unsigned char* dst, const bf16* src, size_t ld, int tid) {
    constexpr int CH = ROWBYTES / 16;
#pragma unroll 4
    for (int i = tid; i < ROWS * CH; i += NWAVES * 64) { const int rr = i / CH, c = i % CH;
        const v4u v = *(const v4u*)((const unsigned char*)(src + (size_t)rr * ld) + c * 16);
        LAS v2u* d = (LAS v2u*)(dst + rr * SB + c * 16); d[0] = (v2u){v.x, v.y}; d[1] = (v2u){v.z, v.w}; }
}
__device__ __forceinline__ void fill_kv_tiles(LAS unsigned char* lds, const bf16* kg, size_t kld, const bf16* vg, size_t vld, int tid) {
    v4u kreg[8], vreg[8];
#pragma unroll
    for (int i = 0; i < 8; ++i) { const int ci = tid + i * 512; kreg[i] = *(const v4u*)(kg + (size_t)(ci >> 4) * kld + (ci & 15) * 8); vreg[i] = *(const v4u*)(vg + (size_t)(ci >> 5) * vld + (ci & 31) * 8); }
#pragma unroll
    for (int i = 0; i < 8; ++i) { const int ci = tid + i * 512;
        LAS v2u* dk = (LAS v2u*)(lds + KS_OFF + (ci >> 4) * KSB + (ci & 15) * 16); dk[0] = (v2u){kreg[i].x, kreg[i].y}; dk[1] = (v2u){kreg[i].z, kreg[i].w};
        LAS v2u* dv = (LAS v2u*)(lds + VS_OFF + (ci >> 5) * VSB + (ci & 31) * 16); dv[0] = (v2u){vreg[i].x, vreg[i].y}; dv[1] = (v2u){vreg[i].z, vreg[i].w}; }
}
__device__ __forceinline__ void load_qfrags(bf16x8 (&qf)[8], const bf16* qrow, int h) {
#pragma unroll
    for (int s = 0; s < 8; ++s) qf[s] = *(const bf16x8*)(qrow + 16 * s + 8 * h);
}
template <bool BIAS, bool CAUSAL>
__device__ __forceinline__ void attn_chunk(const LAS unsigned char* Kc, const LAS unsigned char* Vc, bf16x8 (&qf)[8], f32x16 (&o)[4], float& m, float& l,
                                           const int dist0, const float slope_l2, const int r, const int h, const bf16* qnext = nullptr) {
    constexpr float C = 0.08838834764831845f * 1.4426950408889634f;
    f32x16 st[4];
    bf16x8 kf[3][4];
#pragma unroll
    for (int s = 0; s < 4; ++s) kf[0][s] = *(const LAS bf16x8*)(Kc + r * KSB + s * 32 + h * 16);
#pragma unroll
    for (int s = 0; s < 4; ++s) kf[1][s] = *(const LAS bf16x8*)(Kc + r * KSB + (4 + s) * 32 + h * 16);
#pragma unroll
    for (int hb = 0; hb < 8; ++hb) { const int kt = hb >> 1, s0 = (hb & 1) * 4;
        if (hb < 6) { const int kn = (hb + 2) >> 1, sn = ((hb + 2) & 1) * 4;
#pragma unroll
            for (int s = 0; s < 4; ++s) kf[(hb + 2) % 3][s] = *(const LAS bf16x8*)(Kc + (kn * 32 + r) * KSB + (sn + s) * 32 + h * 16); }
        __builtin_amdgcn_sched_barrier(0);
        if (s0 == 0) {
#pragma unroll
            for (int e = 0; e < 16; ++e) st[kt][e] = 0.f; }
#pragma unroll
        for (int s = 0; s < 4; ++s) st[kt] = MFMA32(kf[hb % 3][s], qf[s0 + s], st[kt]);
        __builtin_amdgcn_sched_barrier(0);
    }
    v2u vlo[3][4], vhi[3][4];
#pragma unroll
    for (int i = 0; i < 4; ++i) { const LAS unsigned char* vp = Vc + r * VSB + ((i >> 1) * 32 + 16 * (i & 1) + 4 * h) * 2; vlo[0][i] = *(const LAS v2u*)vp; vhi[0][i] = *(const LAS v2u*)(vp + 16); }
    __builtin_amdgcn_sched_barrier(0);
    if (qnext != nullptr) load_qfrags(qf, qnext, h);
    int dl = dist0 - 4 * h;
    float sl2 = slope_l2; asm volatile("" : "+v"(sl2), "+v"(dl));
    const float bias0 = -sl2 * (float)dl;
    float mx = -1e30f;
#pragma unroll
    for (int kt = 0; kt < 4; ++kt)
#pragma unroll
        for (int e = 0; e < 16; ++e) { const int kk = kt * 32 + (e & 3) + 8 * (e >> 2);
            float x = st[kt][e] * C;
            if (BIAS) x += __builtin_fmaf(sl2, (float)kk, bias0);
            if (CAUSAL) x = (dl - kk >= 0) ? x : -1e30f;
            st[kt][e] = x; mx = fmaxf(mx, x); }
    mx = pg8::xor32_max(mx);
    const float mn = fmaxf(m, mx), alpha = fexp2(m - mn); m = mn;
    float ps = 0.f;
#pragma unroll
    for (int kt = 0; kt < 4; ++kt)
#pragma unroll
        for (int e = 0; e < 16; ++e) { const float p = fexp2(st[kt][e] - mn); st[kt][e] = p; ps += p; }
    ps = pg8::xor32_sum(ps);
    l = l * alpha + ps;
#pragma unroll
    for (int dt = 0; dt < 4; ++dt) o[dt] = o[dt] * alpha;
    bf16x8 pf[4][2];
#pragma unroll
    for (int kt = 0; kt < 4; ++kt)
#pragma unroll
        for (int sg = 0; sg < 2; ++sg) { v4u w; w.x = pk2(st[kt][8 * sg + 0], st[kt][8 * sg + 1]); w.y = pk2(st[kt][8 * sg + 2], st[kt][8 * sg + 3]);
            w.z = pk2(st[kt][8 * sg + 4], st[kt][8 * sg + 5]); w.w = pk2(st[kt][8 * sg + 6], st[kt][8 * sg + 7]); pf[kt][sg] = as_bf16x8(w); }
#pragma unroll
    for (int b0 = 1; b0 < 2; ++b0)
#pragma unroll
        for (int i = 0; i < 4; ++i) { const int ii = b0 * 4 + i; const LAS unsigned char* vp = Vc + r * VSB + ((ii >> 1) * 32 + 16 * (ii & 1) + 4 * h) * 2; vlo[b0][i] = *(const LAS v2u*)vp; vhi[b0][i] = *(const LAS v2u*)(vp + 16); }
#pragma unroll
    for (int hb = 0; hb < 8; ++hb) { const int dt = hb >> 1, i0 = (hb & 1) * 4;
        if (hb < 6) { const int dn = (hb + 2) >> 1, in0 = ((hb + 2) & 1) * 4;
#pragma unroll
            for (int i = 0; i < 4; ++i) { const int ii = in0 + i; const LAS unsigned char* vp = Vc + (dn * 32 + r) * VSB + ((ii >> 1) * 32 + 16 * (ii & 1) + 4 * h) * 2; vlo[(hb + 2) % 3][i] = *(const LAS v2u*)vp; vhi[(hb + 2) % 3][i] = *(const LAS v2u*)(vp + 16); } }
        __builtin_amdgcn_sched_barrier(0);
#pragma unroll
        for (int i = 0; i < 4; ++i) { const int ii = i0 + i; o[dt] = MFMA32(as_bf16x8((v4u){vlo[hb % 3][i].x, vlo[hb % 3][i].y, vhi[hb % 3][i].x, vhi[hb % 3][i].y}), pf[ii >> 1][ii & 1], o[dt]); }
        __builtin_amdgcn_sched_barrier(0);
    }
}
__device__ __forceinline__ void store_ot_bf16(const f32x16 (&o)[4], float inv, bf16* orow, int h) {
#pragma unroll
    for (int dt = 0; dt < 4; ++dt)
#pragma unroll
        for (int a = 0; a < 4; ++a) { v2u w; w.x = pk2(o[dt][4 * a] * inv, o[dt][4 * a + 1] * inv); w.y = pk2(o[dt][4 * a + 2] * inv, o[dt][4 * a + 3] * inv);
            *(v2u*)(orow + 32 * dt + 8 * a + 4 * h) = w; }
}

__device__ __forceinline__ void store_ot_private(const f32x16 (&o)[4], float inv, bf16* prow, int h) {
#pragma unroll
    for (int dt = 0; dt < 4; ++dt)
#pragma unroll
        for (int hh = 0; hh < 2; ++hh) { v4u w; w.x = pk2(o[dt][8 * hh] * inv, o[dt][8 * hh + 1] * inv); w.y = pk2(o[dt][8 * hh + 2] * inv, o[dt][8 * hh + 3] * inv); w.z = pk2(o[dt][8 * hh + 4] * inv, o[dt][8 * hh + 5] * inv); w.w = pk2(o[dt][8 * hh + 6] * inv, o[dt][8 * hh + 7] * inv);
            *(v4u*)(prow + h * 64 + dt * 16 + hh * 8) = w; }
}
__device__ __forceinline__ void mem_attn_unit(LAS unsigned char* lds, bf16* PM, const bf16* KMl, const bf16* VMTl, int u, int tid_in) {
    int tid = tid_in; asm volatile("" : "+v"(tid));
    const int wave = __builtin_amdgcn_readfirstlane(tid >> 6), lane = tid & 63, r = lane & 31, h = lane >> 5;
    const int qb = u & 63, mh = (u >> 6) & 3, b = u >> 8;
    bf16* qrow = PM + (size_t)(b * T + qb * 256 + wave * 32 + r) * NMAIN + CQM + mh * 128;
    bf16x8 qf[8]; load_qfrags(qf, qrow, h);
    fill_kv_tiles(lds, KMl + (size_t)(b * 256) * 512 + mh * 128, 512, VMTl + (size_t)(mh * 128) * 512 + b * 256, 512, tid);
    LDS_WAIT(); __syncthreads();
    f32x16 o[4]; float m = -1e30f, l = 0.f;
#pragma unroll
    for (int dt = 0; dt < 4; ++dt)
#pragma unroll
        for (int e = 0; e < 16; ++e) o[dt][e] = 0.f;
#pragma unroll 1
    for (int c = 0; c < 2; ++c) attn_chunk<false, false>(lds + KS_OFF + c * 128 * KSB, lds + VS_OFF + c * 256, qf, o, m, l, 0, 0.f, r, h);
    store_ot_bf16(o, __builtin_amdgcn_rcpf(l), qrow, h);
    __syncthreads();
}

#define TOP3_INS(v, j) do { if ((v) > v2) { if ((v) > v1) { v2 = v1; i2 = i1; if ((v) > v0) { v1 = v0; i1 = i0; v0 = (v); i0 = (j); } else { v1 = (v); i1 = (j); } } else { v2 = (v); i2 = (j); } } } while (0)
#define TOP3_INS_TIE(v, j) do { if ((v) > v2 || ((v) == v2 && (j) < i2)) { if ((v) > v1 || ((v) == v1 && (j) < i1)) { v2 = v1; i2 = i1; if ((v) > v0 || ((v) == v0 && (j) < i0)) { v1 = v0; i1 = i0; v0 = (v); i0 = (j); } else { v1 = (v); i1 = (j); } } else { v2 = (v); i2 = (j); } } } while (0)
__device__ __forceinline__ void moba_sel_unit(LAS unsigned char* lds, const bf16* PM, const float* kml, unsigned* SEL, int u, int tid) {
    const int wave = __builtin_amdgcn_readfirstlane(tid >> 6), lane = tid & 63, r = lane & 31, h = lane >> 5;
    const int blk = u & 63, bh = u >> 6, b = bh >> 3, hd = bh & 7;
    const int t = blk * 256 + wave * 32 + r;
    if (blk == 0) { if (h == 0) SEL[(size_t)bh * T + t] = 0x00ffffffu; return; }
    LAS unsigned char* KH = lds, * KL = lds + 64 * KSB;
    for (int it = tid; it < 64 * 16; it += NWAVES * 64) { const int j = it >> 4, d8 = (it & 15) * 8;
        const f32x4 a = *(const f32x4*)(kml + ((size_t)bh * 64 + j) * 128 + d8), c = *(const f32x4*)(kml + ((size_t)bh * 64 + j) * 128 + d8 + 4);
        float x[8] = {a.x, a.y, a.z, a.w, c.x, c.y, c.z, c.w}; unsigned hp[4], lp[4];
#pragma unroll
        for (int e = 0; e < 8; ++e) x[e] *= (1.f / 256.f);
#pragma unroll
        for (int e = 0; e < 4; ++e) { hp[e] = pk2(x[2 * e], x[2 * e + 1]); lp[e] = pk2(x[2 * e] - bflo(hp[e]), x[2 * e + 1] - bfhi(hp[e])); }
        LAS v2u* dh = (LAS v2u*)(KH + j * KSB + d8 * 2); LAS v2u* dl = (LAS v2u*)(KL + j * KSB + d8 * 2);
        dh[0] = (v2u){hp[0], hp[1]}; dh[1] = (v2u){hp[2], hp[3]};
        dl[0] = (v2u){lp[0], lp[1]}; dl[1] = (v2u){lp[2], lp[3]}; }
    bf16x8 qf[8]; load_qfrags(qf, PM + (size_t)(b * T + t) * NMAIN + CQA + hd * 128, h);
    LDS_WAIT(); __syncthreads();
    f32x16 st[2];
#pragma unroll
    for (int jt = 0; jt < 2; ++jt) {
#pragma unroll
        for (int e = 0; e < 16; ++e) st[jt][e] = 0.f;
#pragma unroll
        for (int s = 0; s < 8; ++s) { const bf16x8 kh = *(const LAS bf16x8*)(KH + (jt * 32 + r) * KSB + s * 32 + h * 16), kl = *(const LAS bf16x8*)(KL + (jt * 32 + r) * KSB + s * 32 + h * 16);
            st[jt] = MFMA32(kh, qf[s], st[jt]); st[jt] = MFMA32(kl, qf[s], st[jt]); }
    }
    float v0 = -3e38f, v1 = -3e38f, v2 = -3e38f; int i0 = 255, i1 = 255, i2 = 255;
#pragma unroll
    for (int jt = 0; jt < 2; ++jt)
#pragma unroll
        for (int e = 0; e < 16; ++e) { const int j = jt * 32 + (e & 3) + 8 * (e >> 2) + 4 * h; const float v = (j < blk) ? st[jt][e] : -3e38f; TOP3_INS(v, j); }
    const float p0 = __builtin_bit_cast(float, pg8::xor32_other(__builtin_bit_cast(unsigned, v0), h)), p1 = __builtin_bit_cast(float, pg8::xor32_other(__builtin_bit_cast(unsigned, v1), h)), p2 = __builtin_bit_cast(float, pg8::xor32_other(__builtin_bit_cast(unsigned, v2), h));
    const int q0 = (int)pg8::xor32_other((unsigned)i0, h), q1 = (int)pg8::xor32_other((unsigned)i1, h), q2 = (int)pg8::xor32_other((unsigned)i2, h);
    if (q0 != 255) TOP3_INS_TIE(p0, q0);
    if (q1 != 255) TOP3_INS_TIE(p1, q1);
    if (q2 != 255) TOP3_INS_TIE(p2, q2);
    if (h == 0) SEL[(size_t)bh * T + t] = (unsigned)i0 | ((unsigned)i1 << 8) | ((unsigned)i2 << 16);
    __syncthreads();
}
__device__ __forceinline__ void moba_partial_task(LAS unsigned char* lds, const bf16* PM, const bf16* VT, const unsigned* SEL, bf16* PO, float* ML, int bh, int j, int tid_in) {
    int tid = tid_in; asm volatile("" : "+v"(tid));
    const int wave = __builtin_amdgcn_readfirstlane(tid >> 6), lane = tid & 63, r = lane & 31, h = lane >> 5;
    const int b = bh >> 3, hd = bh & 7;
    const bf16* kg = PM + (size_t)(b * T + 256 * j) * NMAIN + CKA + hd * 128; const bf16* vg = VT + (size_t)(hd * 128) * M + b * T + 256 * j;
    fill_kv_tiles(lds, kg, NMAIN, vg, M, tid);
    LAS unsigned short* list = (LAS unsigned short*)(lds + LIST_OFF); LAS unsigned* wcnt = (LAS unsigned*)(lds + WCNT_OFF);
    const float slope_l2 = 1.4426950408889634f * __builtin_amdgcn_exp2f(-(float)(hd + 1));
#pragma unroll 1
    for (int t_beg = 256 * (j + 1); t_beg < T; t_beg += 8192) {
        const int t_end = (t_beg + 8192 < T) ? t_beg + 8192 : T;
        unsigned slots0 = 0u, slots1 = 0u; int tot = 0; unsigned wsel[16];
#pragma unroll
        for (int it = 0; it < 16; ++it) { const int t = t_beg + wave * 1024 + it * 64 + lane; wsel[it] = SEL[(size_t)bh * T + (t < t_end ? t : t_end - 1)]; }
#pragma unroll
        for (int it = 0; it < 16; ++it) { const int t = t_beg + wave * 1024 + it * 64 + lane; const unsigned w = (t < t_end) ? wsel[it] : 0x00ffffffu;
            const unsigned sl = ((w & 255u) == (unsigned)j) ? 1u : (((w >> 8) & 255u) == (unsigned)j) ? 2u : (((w >> 16) & 255u) == (unsigned)j) ? 3u : 0u;
            if (it < 8) slots0 |= sl << (4 * it); else slots1 |= sl << (4 * (it - 8)); tot += __builtin_popcountll(__ballot(sl != 0u)); }
        if (lane == 0) wcnt[wave] = (unsigned)tot;
        LDS_WAIT(); __syncthreads();
        int off = 0, n = 0;
#pragma unroll
        for (int w = 0; w < NWAVES; ++w) { const int c = (int)wcnt[w]; off += (w < wave) ? c : 0; n += c; }
#pragma unroll
        for (int it = 0; it < 16; ++it) { const unsigned sl = ((it < 8 ? slots0 : slots1) >> (4 * (it & 7))) & 15u; const unsigned long long bal = __ballot(sl != 0u);
            if (sl != 0u) list[off + __builtin_popcountll(bal & ((1ull << lane) - 1ull))] = (unsigned short)((wave * 1024 + it * 64 + lane) | ((sl - 1u) << 13));
            off += __builtin_popcountll(bal); }
        LDS_WAIT(); __syncthreads();
        const int ngroups = (n + 31) >> 5;
        bf16x8 qf[8]; unsigned e = 0u;
        if (wave < ngroups) { const int idx0 = wave * 32 + r; e = list[idx0 < n ? idx0 : n - 1]; load_qfrags(qf, PM + (size_t)(b * T + t_beg + (int)(e & 8191u)) * NMAIN + CQA + hd * 128, h); }
        for (int g = wave; g < ngroups; g += NWAVES) {
            const int idx = g * 32 + r;
            const int t = t_beg + (int)(e & 8191u), slot = (int)(e >> 13);
            unsigned en = 0u; const bool more = (g + NWAVES) < ngroups; const bf16* qnext = nullptr;
            if (more) { const int idn = (g + NWAVES) * 32 + r; en = list[idn < n ? idn : n - 1]; qnext = PM + (size_t)(b * T + t_beg + (int)(en & 8191u)) * NMAIN + CQA + hd * 128; }
            f32x16 o[4]; float m = -1e30f, l = 0.f;
#pragma unroll
            for (int dt = 0; dt < 4; ++dt)
#pragma unroll
                for (int q = 0; q < 16; ++q) o[dt][q] = 0.f;
#pragma unroll 1
            for (int c = 0; c < 2; ++c) attn_chunk<true, false>(lds + KS_OFF + c * 128 * KSB, lds + VS_OFF + c * 256, qf, o, m, l, t - 256 * j - 128 * c, slope_l2, r, h, c == 1 ? qnext : nullptr);
            if (idx < n) { const size_t pi = ((size_t)bh * T + t) * 3 + slot;
                store_ot_private(o, __builtin_amdgcn_rcpf(l), PO + pi * 128, h);
                if (h == 0) { ML[pi * 2] = m; ML[pi * 2 + 1] = l; } }
            e = en;
        }
        __syncthreads();
    }
}
__device__ __forceinline__ void moba_own_unit(LAS unsigned char* lds, bf16* PM, const bf16* VT, const unsigned* SEL, const bf16* PO, const float* ML, int u, int tid_in) {
    int tid = tid_in; asm volatile("" : "+v"(tid));
    const int wave = __builtin_amdgcn_readfirstlane(tid >> 6), lane = tid & 63, r = lane & 31, h = lane >> 5;
    const int blk = u & 63, bh = u >> 6, b = bh >> 3, hd = bh & 7;
    const int tl = wave * 32 + r, t = blk * 256 + tl;
    bf16* qrow = PM + (size_t)(b * T + t) * NMAIN + CQA + hd * 128;
    const unsigned selw = SEL[(size_t)bh * T + t];
    const size_t pi0 = ((size_t)bh * T + t) * 3;
    float mlr[6];
#pragma unroll
    for (int k = 0; k < 6; ++k) mlr[k] = ML[pi0 * 2 + k];
    bf16x8 qf[8]; load_qfrags(qf, qrow, h);
    fill_kv_tiles(lds, PM + (size_t)(b * T + 256 * blk) * NMAIN + CKA + hd * 128, NMAIN, VT + (size_t)(hd * 128) * M + b * T + 256 * blk, M, tid);
    LDS_WAIT(); __syncthreads();
    const float slope_l2 = 1.4426950408889634f * __builtin_amdgcn_exp2f(-(float)(hd + 1));
    f32x16 o[4]; float m = -1e30f, l = 0.f;
#pragma unroll
    for (int dt = 0; dt < 4; ++dt)
#pragma unroll
        for (int q = 0; q < 16; ++q) o[dt][q] = 0.f;
    const int nch = (wave < 4) ? 1 : 2;
#pragma unroll 1
    for (int c = 0; c < nch; ++c) attn_chunk<true, true>(lds + KS_OFF + c * 128 * KSB, lds + VS_OFF + c * 256, qf, o, m, l, tl - 128 * c, slope_l2, r, h);
    v4u pw[3][4][2];
#pragma unroll
    for (int k = 0; k < 3; ++k) { const bool ok = ((selw >> (8 * k)) & 255u) != 255u; const bf16* pr = PO + (pi0 + (ok ? k : 0)) * 128 + h * 64;
#pragma unroll
        for (int dt = 0; dt < 4; ++dt)
#pragma unroll
            for (int hh = 0; hh < 2; ++hh) { const v4u w = *(const v4u*)(pr + dt * 16 + hh * 8); pw[k][dt][hh] = ok ? w : (v4u){0u, 0u, 0u, 0u}; } }
    float mk[3], lk[3]; float mm = m;
#pragma unroll
    for (int k = 0; k < 3; ++k) { const bool ok = ((selw >> (8 * k)) & 255u) != 255u; mk[k] = ok ? mlr[2 * k] : -1e30f; lk[k] = ok ? mlr[2 * k + 1] : 0.f; mm = fmaxf(mm, mk[k]); }
    const float wo = fexp2(m - mm); float den = l * wo;
#pragma unroll
    for (int dt = 0; dt < 4; ++dt) o[dt] = o[dt] * wo;
#pragma unroll
    for (int k = 0; k < 3; ++k) { const bool ok = ((selw >> (8 * k)) & 255u) != 255u; const float wk = lk[k] * fexp2(mk[k] - mm); den += wk;
#pragma unroll
        for (int dt = 0; dt < 4; ++dt)
#pragma unroll
            for (int hh = 0; hh < 2; ++hh) { const v4u w = pw[k][dt][hh]; const float wv = ok ? wk : 0.f;
                o[dt][8 * hh] += wv * bflo(w.x); o[dt][8 * hh + 1] += wv * bfhi(w.x); o[dt][8 * hh + 2] += wv * bflo(w.y); o[dt][8 * hh + 3] += wv * bfhi(w.y);
                o[dt][8 * hh + 4] += wv * bflo(w.z); o[dt][8 * hh + 5] += wv * bfhi(w.z); o[dt][8 * hh + 6] += wv * bflo(w.w); o[dt][8 * hh + 7] += wv * bfhi(w.w); } }
    store_ot_bf16(o, __builtin_amdgcn_rcpf(den), qrow, h);
    __syncthreads();
}
constexpr int HG_G = 0, HG_TOT = 32768, HG_LB = 34816, HG_KT = 36864, HG_KK1 = 55296, HG_QS = 36864, HG_QG = 54272, HG_KD = 71680, HG_KO = 89088, HG_SS = 97792, HG_KK3 = 98816, KTSB = 144;
__device__ __forceinline__ void hgrn_lb_table(LAS unsigned char* lds, const float* lbl  , int layer, int tid) {
    float lb = 0.f; if (layer > 0) lb = fsigmoid(lbl[512 + tid] - lbl[tid]);
    ((LAS float*)(lds + HG_LB))[tid] = lb;
    LDS_WAIT(); __syncthreads();
}
__device__ __forceinline__ void hgrn_gates(LAS unsigned char* lds, int kk_off, const v4u (&fbr)[2], int hh, int tid) {
    LAS float* G = (LAS float*)(lds + HG_G); LAS float* TOT = (LAS float*)(lds + HG_TOT); LAS float* LB = (LAS float*)(lds + HG_LB) + hh * 128; LAS float* KK = (LAS float*)(lds + kk_off);
#pragma unroll
    for (int it = 0; it < 2; ++it) { const int item = tid + it * 512, s = item >> 4, d8 = (item & 15) * 8;
        const unsigned fw[4] = {fbr[it].x, fbr[it].y, fbr[it].z, fbr[it].w}; float lg[8], kv[8];
        const f32x4 lbA = *(const LAS f32x4*)(LB + d8), lbB = *(const LAS f32x4*)(LB + d8 + 4); const float lb8[8] = {lbA.x, lbA.y, lbA.z, lbA.w, lbB.x, lbB.y, lbB.z, lbB.w};
#pragma unroll
        for (int e = 0; e < 8; ++e) { const float x = (e & 1) ? bfhi(fw[e >> 1]) : bflo(fw[e >> 1]); const float lb = lb8[e];
            const float ex = __builtin_amdgcn_exp2f(-1.4426950408889634f * x);
            const float sg = __builtin_amdgcn_rcpf(1.f + ex);
            const float fg = lb + (1.f - lb) * sg; lg[e] = 0.6931471805599453f * __builtin_amdgcn_logf(fmaxf(fg, 1e-20f)); kv[e] = (1.f - lb) * (ex < 1e30f ? ex * sg : 1.f); }
        *(LAS f32x4*)(G + s * 128 + d8) = (f32x4){lg[0], lg[1], lg[2], lg[3]}; *(LAS f32x4*)(G + s * 128 + d8 + 4) = (f32x4){lg[4], lg[5], lg[6], lg[7]};
        *(LAS f32x4*)(KK + s * 128 + d8) = (f32x4){kv[0], kv[1], kv[2], kv[3]}; *(LAS f32x4*)(KK + s * 128 + d8 + 4) = (f32x4){kv[4], kv[5], kv[6], kv[7]}; }
    LDS_WAIT(); __syncthreads();
    { const int d = tid & 127, q = tid >> 7; float gv[16];
#pragma unroll
        for (int s = 0; s < 16; ++s) gv[s] = G[(16 * q + s) * 128 + d];
        float run = 0.f;
#pragma unroll
        for (int s = 0; s < 16; ++s) { run += gv[s]; G[(16 * q + s) * 128 + d] = run; }
        TOT[q * 128 + d] = run; }
    LDS_WAIT(); __syncthreads();
}
__device__ __forceinline__ void hgrn_local_load(const bf16* PM, const bf16* VT, int u, int tid_in, v4u (&fbr)[2], bf16x8 (&va)[4]) {
    int tid = tid_in; asm volatile("" : "+v"(tid));
    const int wave = __builtin_amdgcn_readfirstlane(tid >> 6), lane = tid & 63, r = lane & 31, h = lane >> 5;
    const int c = u & 255, bh = u >> 8, b = bh >> 2, hh = bh & 3;
    const size_t row0 = (size_t)b * T + (size_t)c * 64;
    const int dvt = wave >> 1;
#pragma unroll
    for (int it = 0; it < 2; ++it) { const int item = tid + it * 512; fbr[it] = *(const v4u*)(PM + (row0 + (item >> 4)) * NMAIN + CFB + hh * 128 + (item & 15) * 8); }
    const bf16* vrow = VT + (size_t)(1024 + hh * 128 + dvt * 32 + r) * M + row0;
#pragma unroll
    for (int sg = 0; sg < 4; ++sg) va[sg] = *(const bf16x8*)(vrow + 16 * sg + 8 * h);
}
__device__ __forceinline__ void hgrn_local_unit(LAS unsigned char* lds, bf16* ST, float* DEC, int u, int tid_in, const v4u (&fbr)[2], const bf16x8 (&va)[4]) {
    int tid = tid_in; asm volatile("" : "+v"(tid));
    const int wave = __builtin_amdgcn_readfirstlane(tid >> 6), lane = tid & 63, r = lane & 31, h = lane >> 5;
    const int c = u & 255, bh = u >> 8, hh = bh & 3;
    const int dvt = wave >> 1, dk0 = 2 * (wave & 1);
    hgrn_gates(lds, HG_KK1, fbr, hh, tid);
    LAS float* G = (LAS float*)(lds + HG_G); LAS float* TOT = (LAS float*)(lds + HG_TOT); LAS float* KK = (LAS float*)(lds + HG_KK1);
#pragma unroll
    for (int it = 0; it < 2; ++it) { const int item = tid + it * 512, d = item & 127, s8 = (item >> 7) * 8;
        const float t0 = TOT[d], t1 = TOT[128 + d], t2 = TOT[256 + d], t3 = TOT[384 + d], glast = ((t0 + t1) + t2) + t3;
        const float pre = (s8 >= 48) ? ((t0 + t1) + t2) : (s8 >= 32) ? (t0 + t1) : (s8 >= 16) ? t0 : 0.f;
        float kb[8];
#pragma unroll
        for (int e = 0; e < 8; ++e) kb[e] = KK[(s8 + e) * 128 + d] * fexp(glast - (G[(s8 + e) * 128 + d] + pre));
        *(LAS v4u*)(lds + HG_KT + d * KTSB + s8 * 2) = (v4u){pk2(kb[0], kb[1]), pk2(kb[2], kb[3]), pk2(kb[4], kb[5]), pk2(kb[6], kb[7])};
        if (s8 == 0) DEC[((size_t)bh * 256 + c) * 128 + d] = fexp(glast); }
    LDS_WAIT(); __syncthreads();
    f32x16 acc[2];
#pragma unroll
    for (int e = 0; e < 2; ++e)
#pragma unroll
        for (int q = 0; q < 16; ++q) acc[e][q] = 0.f;
#pragma unroll
    for (int sg = 0; sg < 4; ++sg) {
#pragma unroll
        for (int e = 0; e < 2; ++e) { const bf16x8 bb = *(const LAS bf16x8*)(lds + HG_KT + ((dk0 + e) * 32 + r) * KTSB + (16 * sg + 8 * h) * 2); acc[e] = MFMA32(va[sg], bb, acc[e]); } }
    bf16* stb = ST + ((size_t)bh * 256 + c) * 16384;
#pragma unroll
    for (int e = 0; e < 2; ++e)
#pragma unroll
        for (int q = 0; q < 16; ++q) stb[(size_t)(dvt * 32 + (q & 3) + 8 * (q >> 2) + 4 * h) * 128 + (dk0 + e) * 32 + r] = (bf16)f2bf(acc[e][q]);
    __syncthreads();
}
__device__ __forceinline__ void hgrn_scan(LAS unsigned char* lds, bf16* ST, const float* DEC, int vcu, int G, int tid) {
    for (int e0 = vcu * 512; e0 < 8 * 16384; e0 += G * 512) { const int e = e0 + tid, bh = e0 >> 14, rem = e & 16383, dk = e & 127;
        __syncthreads();
        { const v4u* src = (const v4u*)(DEC + (size_t)bh * 256 * 128);
#pragma unroll
          for (int i = 0; i < 16; ++i) { const v4u w = src[tid + i * 512]; *(LAS v4u*)(lds + (size_t)(tid + i * 512) * 16) = w; } }
        LDS_WAIT(); __syncthreads();
        const LAS float* dl = (const LAS float*)lds + dk;
        bf16* sp = ST + (size_t)bh * 256 * 16384 + rem; float S = 0.f;
#pragma unroll 1
        for (int c0 = 0; c0 < 256; c0 += 64) { float L[64];
#pragma unroll
            for (int i = 0; i < 64; ++i) L[i] = bf2f(sp[(size_t)(c0 + i) * 16384]);
#pragma unroll
            for (int i = 0; i < 64; ++i) { sp[(size_t)(c0 + i) * 16384] = (bf16)f2bf(S); S = dl[(c0 + i) * 128] * S + L[i]; } } }
    __syncthreads();
}
struct HoutPre { v4u fbr[2], qbr[2]; bf16x8 sa[8]; v2u vlo[2][2], vhi[2][2]; v2u gbr[4]; };
__device__ __forceinline__ void hgrn_out_load(const bf16* PM, const bf16* VT, const bf16* ST, int u, int tid_in, HoutPre& P) {
    int tid = tid_in; asm volatile("" : "+v"(tid));
    const int wave = __builtin_amdgcn_readfirstlane(tid >> 6), lane = tid & 63, r = lane & 31, h = lane >> 5;
    const int c = u & 255, bh = u >> 8, b = bh >> 2, hh = bh & 3;
    const size_t row0 = (size_t)b * T + (size_t)c * 64;
    const int dvt = wave & 3, tt = wave >> 2;
#pragma unroll
    for (int it = 0; it < 2; ++it) { const int item = tid + it * 512; const bf16* p = PM + (row0 + (item >> 4)) * NMAIN + hh * 128 + (item & 15) * 8; P.fbr[it] = *(const v4u*)(p + CFB); P.qbr[it] = *(const v4u*)(p + CQB); }
    { const bf16* srow = ST + ((size_t)bh * 256 + c) * 16384 + (size_t)(dvt * 32 + r) * 128;
#pragma unroll
      for (int sg = 0; sg < 8; ++sg) P.sa[sg] = *(const bf16x8*)(srow + 16 * sg + 8 * h); }
    const bf16* vrow = VT + (size_t)(1024 + hh * 128 + dvt * 32 + r) * M + row0;
#pragma unroll
    for (int st = 0; st < 2; ++st)
#pragma unroll
        for (int sg = 0; sg < 2; ++sg) { P.vlo[st][sg] = *(const v2u*)(vrow + st * 32 + 16 * sg + 4 * h); P.vhi[st][sg] = *(const v2u*)(vrow + st * 32 + 16 * sg + 8 + 4 * h); }
    const bf16* orow = PM + (row0 + tt * 32 + r) * NMAIN;
#pragma unroll
    for (int a = 0; a < 4; ++a) P.gbr[a] = *(const v2u*)(orow + CGB + hh * 128 + dvt * 32 + 8 * a + 4 * h);
}
__device__ __forceinline__ void hgrn_out_unit(LAS unsigned char* lds, bf16* PM, const float* gain  , int u, int tid_in, const HoutPre& P) {
    int tid = tid_in; asm volatile("" : "+v"(tid));
    const int wave = __builtin_amdgcn_readfirstlane(tid >> 6), lane = tid & 63, r = lane & 31, h = lane >> 5;
    const int c = u & 255, bh = u >> 8, b = bh >> 2, hh = bh & 3;
    const size_t row0 = (size_t)b * T + (size_t)c * 64;
    const int dvt = wave & 3, tt = wave >> 2;
    const v4u (&fbr)[2] = P.fbr; const v4u (&qbr)[2] = P.qbr; const bf16x8 (&sa)[8] = P.sa; const v2u (&vlo)[2][2] = P.vlo; const v2u (&vhi)[2][2] = P.vhi; const v2u (&gbr)[4] = P.gbr;
    bf16* orow = PM + (row0 + tt * 32 + r) * NMAIN;
    hgrn_gates(lds, HG_KK3, fbr, hh, tid);
    LAS float* G = (LAS float*)(lds + HG_G); LAS float* TOT = (LAS float*)(lds + HG_TOT); LAS float* KK = (LAS float*)(lds + HG_KK3);
#pragma unroll
    for (int it = 0; it < 2; ++it) { const int item = tid + it * 512, s = item >> 4, d8 = (item & 15) * 8;
        const unsigned qw[4] = {qbr[it].x, qbr[it].y, qbr[it].z, qbr[it].w}; float qs[8], qg[8], kd[8], ko[8];
        const f32x4 kA = *(const LAS f32x4*)(KK + s * 128 + d8), kB = *(const LAS f32x4*)(KK + s * 128 + d8 + 4), gA = *(const LAS f32x4*)(G + s * 128 + d8), gB = *(const LAS f32x4*)(G + s * 128 + d8 + 4);
        const f32x4 t0A = *(const LAS f32x4*)(TOT + d8), t0B = *(const LAS f32x4*)(TOT + d8 + 4), t1A = *(const LAS f32x4*)(TOT + 128 + d8), t1B = *(const LAS f32x4*)(TOT + 128 + d8 + 4), t2A = *(const LAS f32x4*)(TOT + 256 + d8), t2B = *(const LAS f32x4*)(TOT + 256 + d8 + 4);
        const float k8[8] = {kA.x, kA.y, kA.z, kA.w, kB.x, kB.y, kB.z, kB.w}, g8[8] = {gA.x, gA.y, gA.z, gA.w, gB.x, gB.y, gB.z, gB.w};
        const float u0[8] = {t0A.x, t0A.y, t0A.z, t0A.w, t0B.x, t0B.y, t0B.z, t0B.w}, u1[8] = {t1A.x, t1A.y, t1A.z, t1A.w, t1B.x, t1B.y, t1B.z, t1B.w}, u2[8] = {t2A.x, t2A.y, t2A.z, t2A.w, t2B.x, t2B.y, t2B.z, t2B.w};
        const bool s16 = s >= 16, s32 = s >= 32, s48 = s >= 48;
#pragma unroll
        for (int e = 0; e < 8; ++e) { const float qv = (e & 1) ? bfhi(qw[e >> 1]) : bflo(qw[e >> 1]);
            const float k = k8[e], g31 = u0[e] + u1[e];
            const float pre = s48 ? (g31 + u2[e]) : s32 ? g31 : s16 ? u0[e] : 0.f;
            const float gs = g8[e] + pre, gref = s32 ? g31 : 0.f;
            qs[e] = qv * fexp(gs - gref); qg[e] = qv * fexp(gs); kd[e] = k * fexp(fminf(gref - gs, 80.f)); ko[e] = k * fexp(fminf(g31 - gs, 0.f)); }
        *(LAS v4u*)(lds + HG_QS + s * KSB + d8 * 2) = (v4u){pk2(qs[0], qs[1]), pk2(qs[2], qs[3]), pk2(qs[4], qs[5]), pk2(qs[6], qs[7])};
        *(LAS v4u*)(lds + HG_QG + s * KSB + d8 * 2) = (v4u){pk2(qg[0], qg[1]), pk2(qg[2], qg[3]), pk2(qg[4], qg[5]), pk2(qg[6], qg[7])};
        *(LAS v4u*)(lds + HG_KD + s * KSB + d8 * 2) = (v4u){pk2(kd[0], kd[1]), pk2(kd[2], kd[3]), pk2(kd[4], kd[5]), pk2(kd[6], kd[7])};
        if (s < 32) *(LAS v4u*)(lds + HG_KO + s * KSB + d8 * 2) = (v4u){pk2(ko[0], ko[1]), pk2(ko[2], ko[3]), pk2(ko[4], ko[5]), pk2(ko[6], ko[7])}; }
    LDS_WAIT(); __syncthreads();
    f32x16 o;
#pragma unroll
    for (int q = 0; q < 16; ++q) o[q] = 0.f;
#pragma unroll
    for (int sg = 0; sg < 8; ++sg) { const bf16x8 bb = *(const LAS bf16x8*)(lds + HG_QG + (tt * 32 + r) * KSB + (16 * sg + 8 * h) * 2); o = MFMA32(sa[sg], bb, o); }
#pragma unroll
    for (int st = 0; st < 2; ++st) if (st <= tt) {
        f32x16 at;
#pragma unroll
        for (int q = 0; q < 16; ++q) at[q] = 0.f;
        const LAS unsigned char* kbase = (st == tt) ? (lds + HG_KD + (st * 32 + r) * KSB) : (lds + HG_KO + r * KSB);
#pragma unroll
        for (int sg = 0; sg < 8; ++sg) { const bf16x8 a = *(const LAS bf16x8*)(kbase + (16 * sg + 8 * h) * 2), bb = *(const LAS bf16x8*)(lds + HG_QS + (tt * 32 + r) * KSB + (16 * sg + 8 * h) * 2);
            at = MFMA32(a, bb, at); }
        if (st == tt) {
#pragma unroll
            for (int q = 0; q < 16; ++q) at[q] = ((q & 3) + 8 * (q >> 2) + 4 * h <= r) ? at[q] : 0.f; }
#pragma unroll
        for (int sg = 0; sg < 2; ++sg) { const v4u pw = {pk2(at[8 * sg], at[8 * sg + 1]), pk2(at[8 * sg + 2], at[8 * sg + 3]), pk2(at[8 * sg + 4], at[8 * sg + 5]), pk2(at[8 * sg + 6], at[8 * sg + 7])};
            o = MFMA32(as_bf16x8((v4u){vlo[st][sg].x, vlo[st][sg].y, vhi[st][sg].x, vhi[st][sg].y}), as_bf16x8(pw), o); }
    }
    LAS float* SS = (LAS float*)(lds + HG_SS);
    float ss = 0.f;
#pragma unroll
    for (int q = 0; q < 16; ++q) ss += o[q] * o[q];
    ss = pg8::xor32_sum(ss);
    if (h == 0) SS[(tt * 4 + dvt) * 32 + r] = ss;
    LDS_WAIT(); __syncthreads();
    const float tot = (SS[(tt * 4 + 0) * 32 + r] + SS[(tt * 4 + 1) * 32 + r]) + (SS[(tt * 4 + 2) * 32 + r] + SS[(tt * 4 + 3) * 32 + r]);
    const float rr = __builtin_amdgcn_rsqf(tot * (1.f / 128.f) + RMS_EPS);
#pragma unroll
    for (int a = 0; a < 4; ++a) { const int dv0 = dvt * 32 + 8 * a + 4 * h; const f32x4 gn = *(const f32x4*)(gain + dv0); const v2u gb = gbr[a];
        v2u w; w.x = pk2(o[4 * a] * rr * gn.x * bflo(gb.x), o[4 * a + 1] * rr * gn.y * bfhi(gb.x)); w.y = pk2(o[4 * a + 2] * rr * gn.z * bflo(gb.y), o[4 * a + 3] * rr * gn.w * bfhi(gb.y));
        *(v2u*)(orow + CQB + hh * 128 + dv0) = w; }
    __syncthreads();
}
struct Args { const float* in[21]; float* out; unsigned char* ws; int ph_lo, ph_hi; };
enum { IN_X = 0, IN_MEM, IN_F1N, IN_F1W1, IN_F1W3, IN_F1W2, IN_MIXN, IN_WIN, IN_LB, IN_HON, IN_MEMN, IN_WKV, IN_WPA, IN_WPB, IN_WPM, IN_WOUT, IN_F2N, IN_F2W1, IN_F2W3, IN_F2W2, IN_FINN };
constexpr int PH_PER_LAYER = 14, PH_FINAL = DEPTH * PH_PER_LAYER, PH_TOTAL = PH_FINAL + 1;
#ifndef DIS_GEMM
#define GEMM_PHASE(EPI, g, S, E) pg8::gemm_phase<EPI, pg8::StaticOrder, true, true>(lds + RING_OFF, g, S, E)
#else
#define GEMM_PHASE(EPI, g, S, E) do { (void)g; (void)S; (void)E; } while (0)
#endif
#ifdef DIS_G_SWIGLU
#define GEMM_PHASE_SWIGLU(EPI, g, S, E) do { (void)g; (void)S; (void)E; } while (0)
#else
#define GEMM_PHASE_SWIGLU(EPI, g, S, E) GEMM_PHASE(EPI, g, S, E)
#endif
#ifdef DIS_G_KV
#define GEMM_PHASE_KV(EPI, g, S, E) do { (void)g; (void)S; (void)E; } while (0)
#else
#define GEMM_PHASE_KV(EPI, g, S, E) GEMM_PHASE(EPI, g, S, E)
#endif
#ifdef DIS_G_DOWN
#define GEMM_PHASE_DOWN(EPI, g, S, E) do { (void)g; (void)S; (void)E; } while (0)
#else
#define GEMM_PHASE_DOWN(EPI, g, S, E) GEMM_PHASE(EPI, g, S, E)
#endif
#ifdef DIS_G_G3A
#define GEMM_PHASE_G3A(EPI, g, S, E) do { (void)g; (void)S; (void)E; } while (0)
#else
#define GEMM_PHASE_G3A(EPI, g, S, E) GEMM_PHASE(EPI, g, S, E)
#endif
#ifdef DIS_G_G3B
#define GEMM_PHASE_G3B(EPI, g, S, E) do { (void)g; (void)S; (void)E; } while (0)
#else
#define GEMM_PHASE_G3B(EPI, g, S, E) GEMM_PHASE(EPI, g, S, E)
#endif
#ifdef DIS_G_MERGE
#define GEMM_PHASE_MERGE(EPI, g, S, E) do { (void)g; (void)S; (void)E; } while (0)
#else
typedef pg8::MergeOrder<CQA * 2, CQB * 2, CQM * 2, (long)WO_PA, (long)WO_PB, (long)WO_PMM> MergeOrderG4;
#define GEMM_PHASE_MERGE(EPI, g, S, E) pg8::gemm_phase<EPI, MergeOrderG4, true, true>(lds + RING_OFF, g, S, E)
#endif
#ifdef DIS_G_OUT
#define GEMM_PHASE_OUT(EPI, g, S, E) do { (void)g; (void)S; (void)E; } while (0)
#else
#define GEMM_PHASE_OUT(EPI, g, S, E) GEMM_PHASE(EPI, g, S, E)
#endif

__global__ void __launch_bounds__(NWAVES * 64, 2) fwd(Args args) {
    extern __shared__ __attribute__((aligned(16))) unsigned char lds_raw[];
    LAS unsigned char* lds = (LAS unsigned char*)lds_raw;
    const int tid0 = threadIdx.x;
#define PHASE_IDS int tid = tid0; asm volatile("" : "+v"(tid)); const int lane = tid & 63, wave = __builtin_amdgcn_readfirstlane(tid >> 6), gw = vcu * NWAVES + wave; LAS float* scr = (LAS float*)(lds + wave * 19456); (void)lane; (void)gw; (void)scr
    const int G = gridDim.x, bx = blockIdx.x, vcu = (G % 8 == 0) ? (bx % 8) * (G / 8) + bx / 8 : bx;
    volatile LAS unsigned* MISC = (volatile LAS unsigned*)(lds + MISC_OFF);
    for (int u = tid0; u < (LDS_BYTES - MISC_OFF) / 4; u += NWAVES * 64) ((LAS unsigned*)(lds + MISC_OFF))[u] = 0u;
    __syncthreads();
    unsigned char* ws = args.ws;
    XcdBarrier bar = xcd_barrier_post((unsigned*)(ws + WS_CTL) + CW_BAR, MISC + 8);
    const int lo = args.ph_lo, hi = args.ph_hi;
#define RUN(k) (lo <= (k) && (k) < hi)
#define SEAM(k) do { if (RUN(k) && RUN((k) + 1)) xcd_barrier(bar); } while (0)
    float* const out = args.out; const float* const xin = args.in[IN_X];
    float* const RS = (float*)(ws + WS_RS);
    float* const SSQ = (float*)(ws + WS_SSQ);
    bf16* const XB = (bf16*)(ws + WS_R0);
    bf16* const YB = (bf16*)(ws + WS_PG + 192 * MiB);
    bf16* const R0 = (bf16*)(ws + WS_R0); bf16* const PMb = (bf16*)(ws + WS_PM); bf16* const VTb = (bf16*)(ws + WS_VT); bf16* const PGb = (bf16*)(ws + WS_PG);
    bf16* const Wb = (bf16*)(ws + WS_W); bf16* const MEMN = (bf16*)(ws + WS_MEMN); bf16* const WKV = (bf16*)(ws + WS_WKV); bf16* const KMb = (bf16*)(ws + WS_KM); bf16* const VMTb = (bf16*)(ws + WS_VMT);
    const int NGW = G * NWAVES;

#pragma unroll 1
    for (int l = 0; l < DEPTH; ++l) {
        const int pb = l * PH_PER_LAYER;
#pragma unroll 1
        for (int f = 0; f < 2; ++f) {
            const int p0 = pb + (f ? 11 : 0);
#ifndef DIS_THIN
            if (RUN(p0)) {
                PHASE_IDS;
                const float* gn = args.in[f ? IN_F2N : IN_F1N] + (size_t)l * D;
                if (l == 0 && f == 0) { int m = gw;
                    for (; m + NGW < M; m += 2 * NGW) rms_stat_f32_copy_x2(xin + (size_t)m * D, xin + (size_t)(m + NGW) * D, XB + (size_t)m * D, XB + (size_t)(m + NGW) * D, RS + m, RS + m + NGW, lane);
                    if (m < M) { const float r = rms_stat_f32_copy(xin + (size_t)m * D, XB + (size_t)m * D, lane); if (lane == 0) RS[m] = r; } }
                else { for (int m = gw * 64 + lane; m < M; m += NGW * 64) RS[m] = rms_stat_partials(SSQ + (size_t)m * 32); }
                const float* w1 = args.in[f ? IN_F2W1 : IN_F1W1] + (size_t)l * D * DFF; const float* w3 = args.in[f ? IN_F2W3 : IN_F1W3] + (size_t)l * D * DFF; const float* w2 = args.in[f ? IN_F2W2 : IN_F1W2] + (size_t)l * D * DFF;
                convert_matrix(w1, D, DFF, Wb, 1, 0, scr, gw, NGW, lane, gn);
                convert_matrix(w3, D, DFF, Wb, 1, 128, scr, gw, NGW, lane, gn);
                convert_matrix(w2, DFF, D, (bf16*)(ws + WS_W + WO_W2), 0, 0, scr, gw, NGW, lane);
                if (l == 0 && f == 0) {
                    for (int m = gw; m < DEPTH * 512; m += NGW) { const int ll = m >> 9, row = m & 511; rms_row_bf16(args.in[IN_MEM] + (size_t)row * D, args.in[IN_MEMN] + (size_t)ll * D, MEMN + (size_t)m * D, lane); }
                    for (int ll = 0; ll < DEPTH; ++ll) convert_matrix(args.in[IN_WKV] + (size_t)ll * D * 1024, D, 1024, WKV + (size_t)ll * 1024 * D, 0, 0, scr, gw, NGW, lane);
                }
            }
#endif
            SEAM(p0);
            if (RUN(p0 + 1)) {
                { pg8::Gemm g{XB, Wb, M, 2 * DFF, D, D, D}; pg8::StaticOrder S; S.init(M, 2 * DFF, G, bx); pg8::EpiSwiglu E{PGb, DFF, RS}; GEMM_PHASE_SWIGLU(pg8::EpiSwiglu, g, S, E); }
            }
            SEAM(p0 + 1);
            if (RUN(p0 + 2)) { pg8::Gemm g{PGb, (bf16*)(ws + WS_W + WO_W2), M, D, DFF, DFF, DFF}; pg8::StaticOrder S; S.init(M, D, G, bx); pg8::EpiResid E{XB, D, 0.5f, SSQ}; GEMM_PHASE_DOWN(pg8::EpiResid, g, S, E); }
            SEAM(p0 + 2);
            if (f == 0) {
                float* const kml = (float*)(ws + WS_KMEAN) + (size_t)l * 16 * 64 * 128;
                bf16* const POb = (bf16*)(ws + WS_PO); float* const MLb = (float*)(ws + WS_ML); bf16* const STb = (bf16*)(ws + WS_ST); float* const DECb = (float*)(ws + WS_DEC); unsigned* const SELb = (unsigned*)(ws + WS_SEL);
                const float* lbl = args.in[IN_LB];
#ifndef DIS_THIN
                if (RUN(pb + 3)) {
                PHASE_IDS;
                    const float* gn = args.in[IN_MIXN] + (size_t)l * D;
                    for (int m = gw * 64 + lane; m < M; m += NGW * 64) RS[m] = rms_stat_partials(SSQ + (size_t)m * 32);
                    const bool kvwg = (l == 0) && (bx < 32) && ((bx & 7) < 4);
                    if (kvwg) { const int q = bx >> 3, ll = q >> 1, vt = q & 1;
                        const bf16* mn = MEMN + (size_t)ll * 512 * D; const bf16* wk = WKV + (size_t)ll * 1024 * D + (vt ? (size_t)512 * D : 0);
                        pg8::Gemm g{vt ? wk : mn, vt ? mn : wk, 512, 512, D, D, D}; pg8::StaticOrder S; S.init(512, 512, G, bx & 7);
                        pg8::EpiBf16 E{(vt ? VMTb : KMb) + (size_t)ll * 512 * 512, 512, 0u, nullptr, nullptr, nullptr}; GEMM_PHASE_KV(pg8::EpiBf16, g, S, E); }
                    else { int gwc = gw, ngwc = NGW; if (l == 0) { const int below = (bx >= 32) ? 16 : ((bx >> 3) * 4 + ((bx & 7) < 4 ? (bx & 7) : 4)); gwc = (bx - below) * NWAVES + wave; ngwc = (G - 16) * NWAVES; }
                        convert_matrix(args.in[IN_WIN] + (size_t)l * D * NIN, D, NIN, Wb, 2, 0, scr, gwc, ngwc, lane, gn); }
                    convert_matrix(args.in[IN_WPA] + (size_t)l * 1024 * D, 1024, D, (bf16*)(ws + WS_W + WO_PA), 0, 0, scr, gw, NGW, lane);
                    convert_matrix(args.in[IN_WPB] + (size_t)l * 512 * D, 512, D, (bf16*)(ws + WS_W + WO_PB), 0, 0, scr, gw, NGW, lane);
                    convert_matrix(args.in[IN_WPM] + (size_t)l * 512 * D, 512, D, (bf16*)(ws + WS_W + WO_PMM), 0, 0, scr, gw, NGW, lane);
                    convert_matrix(args.in[IN_WOUT] + (size_t)l * D * D, D, D, (bf16*)(ws + WS_W + WO_OUT), 0, 0, scr, gw, NGW, lane);
                }
#endif
                SEAM(pb + 3);
                if (RUN(pb + 4)) {
#pragma unroll 1
                    for (int q = 0; q < 2; ++q) {
                        pg8::Gemm g{q ? Wb + (size_t)NMAIN * D : XB, q ? XB : Wb, q ? NVT : M, q ? M : NMAIN, D, D, D}; pg8::StaticOrder S; S.init(g.M, g.N, G, bx);
                        pg8::EpiBf16 E{q ? VTb : PMb, q ? M : NMAIN, q ? 0u : ((1u << 16) | (1u << 18) | (2u << 24) | (2u << 26)), q ? nullptr : kml, q ? nullptr : RS, q ? RS : nullptr}; GEMM_PHASE_G3A(pg8::EpiBf16, g, S, E); }
                }
                SEAM(pb + 4);
                if (RUN(pb + 5)) {
                PHASE_IDS;
                    #ifndef DIS_LOCAL
                    hgrn_lb_table(lds, lbl, l, tid);
                    { v4u fbr[2] = {}; bf16x8 va[4] = {}; int u = vcu;
                      if (u < 2048) hgrn_local_load(PMb, VTb, u, tid, fbr, va);
#pragma unroll 1
                      for (; u < 2048; u += G) { v4u fbn[2] = {}; bf16x8 van[4] = {}; const bool nx = (u + G) < 2048;
                          if (nx) hgrn_local_load(PMb, VTb, u + G, tid, fbn, van);
                          hgrn_local_unit(lds, STb, DECb, u, tid, fbr, va);
                          if (nx) { fbr[0] = fbn[0]; fbr[1] = fbn[1]; va[0] = van[0]; va[1] = van[1]; va[2] = van[2]; va[3] = van[3]; } } }
#endif
                    #ifndef DIS_SEL
                    for (int u = vcu; u < 1024; u += G) moba_sel_unit(lds, PMb, kml, SELb, u, tid);
#endif
                    #ifndef DIS_MEM
                    for (int u = vcu; u < 512; u += G) mem_attn_unit(lds, PMb, KMb + (size_t)l * 512 * 512, VMTb + (size_t)l * 512 * 512, u, tid);
#endif
                }
                SEAM(pb + 5);
                if (RUN(pb + 6)) {
                PHASE_IDS;
                    #ifndef DIS_PART
                    {
                        unsigned* qctr = (unsigned*)(ws + WS_CTL) + 12288 + 64 * l; LAS unsigned* qslot = (LAS unsigned*)(lds + WCNT_OFF + 32);
                        for (;;) {
                            if (tid == 0) *qslot = __hip_atomic_fetch_add(qctr, 1u, __ATOMIC_RELAXED, __HIP_MEMORY_SCOPE_AGENT);
                            LDS_WAIT(); __syncthreads();
                            const int u = (int)*qslot;
                            if (u >= 16 * 63) break;
                            moba_partial_task(lds, PMb, VTb, SELb, POb, MLb, u & 15, u >> 4, tid);
                        }
                    }
#endif
                    #ifndef DIS_SCAN
                    hgrn_scan(lds, STb, DECb, vcu, G, tid);
#endif
                }
                SEAM(pb + 6);
                if (RUN(pb + 7)) {
                PHASE_IDS;
                    #ifndef DIS_OWN
                    for (int u = vcu; u < 1024; u += G) moba_own_unit(lds, PMb, VTb, SELb, POb, MLb, u, tid);
#endif
                    #ifndef DIS_HOUT
                    hgrn_lb_table(lds, lbl, l, tid);
                    { HoutPre P = {}; int u = vcu;
                      if (u < 2048) hgrn_out_load(PMb, VTb, STb, u, tid, P);
#pragma unroll 1
                      for (; u < 2048; u += G) { HoutPre Pn = {}; const bool nx = (u + G) < 2048;
                          if (nx) hgrn_out_load(PMb, VTb, STb, u + G, tid, Pn);
                          hgrn_out_unit(lds, PMb, args.in[IN_HON] + (size_t)l * 128, u, tid, P);
                          if (nx) P = Pn; } }
#endif
                }
                SEAM(pb + 7);
                if (RUN(pb + 8)) { pg8::Gemm g{XB, Wb + (size_t)(NMAIN + NVT) * D, M, NGATE, D, D, D}; pg8::StaticOrder S; S.init(M, NGATE, G, bx); pg8::EpiGateU8 E{(unsigned char*)PGb, NGATE, RS}; GEMM_PHASE_G3B(pg8::EpiGateU8, g, S, E); }
                SEAM(pb + 8);
                if (RUN(pb + 9)) {
                    pg8::Gemm g{PMb, (bf16*)(ws + WS_W + WO_PA), M, D, 1024, NMAIN, 1024};
                    MergeOrderG4 S; S.T.init(M, D, G, bx); S.A0 = (const char*)PMb; S.W0 = (const char*)(ws + WS_W);
                    pg8::EpiMergeR E{YB, D, (const unsigned char*)PGb, NGATE}; GEMM_PHASE_MERGE(pg8::EpiMergeR, g, S, E);
                }
                SEAM(pb + 9);
                if (RUN(pb + 10)) { pg8::Gemm g{YB, (bf16*)(ws + WS_W + WO_OUT), M, D, D, D, D}; pg8::StaticOrder S; S.init(M, D, G, bx); pg8::EpiResid E{XB, D, 1.0f, SSQ}; GEMM_PHASE_OUT(pg8::EpiResid, g, S, E); }
                SEAM(pb + 10);
            }
        }
    }
#ifndef DIS_THIN
    if (RUN(PH_FINAL)) { PHASE_IDS; const float* gn = args.in[IN_FINN]; if (M % (4 * NGW) == 0) { for (int m = gw; m < M; m += 4 * NGW) rms_xb_f32_x4(XB + (size_t)m * D, (size_t)NGW * D, gn, out + (size_t)m * D, (size_t)NGW * D, lane); }
        else { for (int m = gw; m < M; m += NGW) rms_xb_f32(XB + (size_t)m * D, gn, out + (size_t)m * D, lane); } }
#endif
#undef RUN
#undef SEAM
}

extern "C" void kernel_launch(void* const* d_in, const int* in_sizes, int n_in, void* d_out, int out_size, void* d_ws, size_t ws_size, hipStream_t stream) {
    static int grid = 0;
    if (grid == 0) {
        if (n_in != 21 || in_sizes[0] != M * D || out_size != M * D || ws_size < WS_END) { fprintf(stderr, "kernel_launch: unexpected shapes (n_in %d, in0 %d, out %d, ws %zu); nothing launched\n", n_in, n_in > 0 ? in_sizes[0] : -1, out_size, ws_size); grid = -1; return; }
        int dev = 0, cus = 0, per_cu = 0;
        if (hipGetDevice(&dev) != hipSuccess || hipDeviceGetAttribute(&cus, hipDeviceAttributeMultiprocessorCount, dev) != hipSuccess) { grid = -1; return; }
        if (hipFuncSetAttribute((const void*)fwd, hipFuncAttributeMaxDynamicSharedMemorySize, LDS_BYTES) != hipSuccess) { fprintf(stderr, "kernel_launch: hipFuncSetAttribute failed\n"); grid = -1; return; }
        if (hipOccupancyMaxActiveBlocksPerMultiprocessor(&per_cu, (const void*)fwd, NWAVES * 64, LDS_BYTES) != hipSuccess || per_cu < 1) fprintf(stderr, "kernel_launch: note: occupancy query reports %d\n", per_cu);
        (void)hipGetLastError();
        grid = cus;
    }
    if (grid < 0) return;
    if (hipMemsetAsync((char*)d_ws + WS_CTL, 0, CTL_ZERO_BYTES, stream) != hipSuccess) return;
    Args a{};
    for (int i = 0; i < 21; ++i) a.in[i] = (const float*)d_in[i];
    a.out = (float*)d_out; a.ws = (unsigned char*)d_ws; a.ph_lo = 0; a.ph_hi = PH_TOTAL;
    hipLaunchKernelGGL(fwd, dim3(grid), dim3(NWAVES * 64), LDS_BYTES, stream, a);
}
```

```cpp
#include <hip/hip_runtime.h>
#include <cstdio>
#include <cstdint>

#define LAS __attribute__((address_space(3)))
#define GAS __attribute__((address_space(1)))
namespace pg8 {
#define PG8_LAS __attribute__((address_space(3)))
typedef unsigned short bf16_t;
typedef short bf16x8 __attribute__((ext_vector_type(8)));
typedef float f32x4 __attribute__((ext_vector_type(4)));
typedef unsigned u32x4 __attribute__((ext_vector_type(4)));
constexpr int BM = 256, BK = 64, HALF = 128, HTB = HALF * BK * 2  , STAGE_BYTES = 8 * HTB, NXCD = 8, WGM = 8;

__host__ __device__ __forceinline__ int lds_byte(int r, int c) { const int st = (r >> 4) * 2 + (c >> 5), rr = r & 15, cc = c & 31, ob = rr * 64 + cc * 2; return st * 1024 + (ob ^ (((ob >> 9) & 1) << 5)); }
__host__ __device__ __forceinline__ void stage_rc(int b, int& R, int& C) { const int st = b / 1024, sb = b % 1024, swz = sb ^ (((sb >> 9) & 1) << 5); R = (st >> 1) * 16 + swz / 64; C = (st & 1) * 32 + (swz % 64) / 2; }
__host__ __device__ __forceinline__ int perm32(int rho) { const int n = rho >> 4, i = rho & 15; return 8 * (i >> 2) + 4 * n + (i & 3); }

struct Unit { int pm, pn, q; };
struct Gemm { const bf16_t* A; const bf16_t* Bt; int M, N, K, lda, ldb; };

struct StaticOrder {
    static constexpr bool VARK = false;
    int nM, nN, nwg, G, c, wgm;
    __host__ __device__ void init(int M, int N, int G_, int c_) { nM = M / BM; nN = N / BM; nwg = nM * nN; G = G_; c = c_; wgm = (nN == 8) ? 4 : WGM; }
    __host__ __device__ bool next(int i, Unit& u) const {
        const long L = (long)i * G + c; if (L >= nwg) return false;
        int wgid = (int)L; { const int q = nwg / NXCD, r = nwg % NXCD, xcd = wgid % NXCD, off = wgid / NXCD; wgid = (xcd < r ? xcd * (q + 1) : r * (q + 1) + (xcd - r) * q) + off; }
        const int nig = wgm * nN, gid = wgid / nig, fm = gid * wgm, gsz = (nM - fm) < wgm ? (nM - fm) : wgm;
        u.pm = fm + ((wgid % nig) % gsz); u.pn = (wgid % nig) / gsz; u.q = 0; return true;
    }
    __device__ __forceinline__ void a_ready(const Unit&) const {}
    __device__ __forceinline__ void done(const Unit&) const {}
};

template <int AO0, int AO1, int AO2, long WO0, long WO1, long WO2>
struct MergeOrder {
    static constexpr bool VARK = true;
    StaticOrder T; const char* A0; const char* W0;
    __device__ __forceinline__ bool next(int i, Unit& u) const { const int r = i / 3; if (!T.next(r, u)) return false; u.q = i - 3 * r; return true; }
    __device__ __forceinline__ void params(const Unit& u, const char*& pA, const char*& pB, int& ldb, int& nt) const {
        const int q = u.q; pA = A0 + (q == 0 ? AO0 : q == 1 ? AO1 : AO2); pB = W0 + (q == 0 ? WO0 : q == 1 ? WO1 : WO2); ldb = (q == 0) ? 1024 : 512; nt = ldb / BK; }
    __device__ __forceinline__ void a_ready(const Unit&) const {}
    __device__ __forceinline__ void done(const Unit&) const {}
};
typedef float f32x2 __attribute__((ext_vector_type(2)));
typedef __bf16 bf16x2_t __attribute__((ext_vector_type(2)));
__device__ __forceinline__ unsigned cvt_pk_bf16(float lo, float hi) { const f32x2 v = {lo, hi}; return __builtin_bit_cast(unsigned, __builtin_convertvector(v, bf16x2_t)); }
__device__ __forceinline__ float fsigmoid(float x) { return __builtin_amdgcn_rcpf(1.0f + __builtin_amdgcn_exp2f(-1.4426950408889634f * x)); }
__device__ __forceinline__ float xor32_sum(float x) { const unsigned u = __builtin_bit_cast(unsigned, x); const auto r = __builtin_amdgcn_permlane32_swap(u, u, false, false); return __builtin_bit_cast(float, (unsigned)r[0]) + __builtin_bit_cast(float, (unsigned)r[1]); }
__device__ __forceinline__ float xor32_max(float x) { const unsigned u = __builtin_bit_cast(unsigned, x); const auto r = __builtin_amdgcn_permlane32_swap(u, u, false, false); return fmaxf(__builtin_bit_cast(float, (unsigned)r[0]), __builtin_bit_cast(float, (unsigned)r[1])); }
__device__ __forceinline__ float xor16_sum(float x) { const unsigned u = __builtin_bit_cast(unsigned, x); const auto r = __builtin_amdgcn_permlane16_swap(u, u, false, false); return __builtin_bit_cast(float, (unsigned)r[0]) + __builtin_bit_cast(float, (unsigned)r[1]); }
__device__ __forceinline__ unsigned xor32_other(unsigned u, int hi_half) { const auto r = __builtin_amdgcn_permlane32_swap(u, u, false, false); return hi_half ? (unsigned)r[0] : (unsigned)r[1]; }
__device__ __forceinline__ float row16_sum(float x) {
    x += __builtin_bit_cast(float, __builtin_amdgcn_mov_dpp(__builtin_bit_cast(int, x), 0xB1, 0xF, 0xF, true));
    x += __builtin_bit_cast(float, __builtin_amdgcn_mov_dpp(__builtin_bit_cast(int, x), 0x4E, 0xF, 0xF, true));
    x += __builtin_bit_cast(float, __builtin_amdgcn_mov_dpp(__builtin_bit_cast(int, x), 0x141, 0xF, 0xF, true));
    x += __builtin_bit_cast(float, __builtin_amdgcn_mov_dpp(__builtin_bit_cast(int, x), 0x140, 0xF, 0xF, true));
    return x;
}
__device__ __forceinline__ float bflo(unsigned w) { return __builtin_bit_cast(float, w << 16); }
__device__ __forceinline__ float bfhi(unsigned w) { return __builtin_bit_cast(float, w & 0xffff0000u); }

struct NoState {};
struct RowScale8 { float r[2][4]; };
struct EpiBf16 {
    static constexpr bool PERM = true, AFTER_DRAIN = false, KEEP = false;
    typedef RowScale8 State;
    __device__ __forceinline__ void load_state(State& st, const Unit& u, int wr, int fr) const {
#pragma unroll
        for (int ai = 0; ai < 2; ++ai)
#pragma unroll
            for (int m = 0; m < 4; ++m) st.r[ai][m] = rs ? rs[u.pm * BM + wr * 64 + fr + ai * HALF + m * 16] : 1.f; }
    bf16_t* O; int ldc; unsigned modes; float* km; const float* rs; const float* cs;
    __device__ __forceinline__ void operator()(const f32x4 (&acc_in)[2][2][4][2], const Unit& u, int wr, int wc, int fr, int fq, const State& st) const {
        const int row0 = u.pm * BM + wr * 64 + fr, col0 = u.pn * BM + wc * 32 + 8 * fq;
        const unsigned mode = (modes >> (2 * (u.pn & 15))) & 3u;
        f32x4 acc[2][2][4][2];
#pragma unroll
        for (int ai = 0; ai < 2; ++ai)
#pragma unroll
            for (int m = 0; m < 4; ++m) { const float r = st.r[ai][m];
#pragma unroll
                for (int bj = 0; bj < 2; ++bj)
#pragma unroll
                    for (int n = 0; n < 2; ++n) acc[ai][bj][m][n] = acc_in[ai][bj][m][n] * r; }
        if (cs) {
#pragma unroll
            for (int bj = 0; bj < 2; ++bj) { const f32x4 c0 = *(const f32x4*)(cs + col0 + bj * HALF), c1 = *(const f32x4*)(cs + col0 + bj * HALF + 4);
#pragma unroll
                for (int ai = 0; ai < 2; ++ai)
#pragma unroll
                    for (int m = 0; m < 4; ++m) { acc[ai][bj][m][0] = acc[ai][bj][m][0] * c0; acc[ai][bj][m][1] = acc[ai][bj][m][1] * c1; } } }
#pragma unroll
        for (int ai = 0; ai < 2; ++ai)
#pragma unroll
            for (int m = 0; m < 4; ++m) { bf16_t* rowp = O + (size_t)(row0 + ai * HALF + m * 16) * ldc + col0;
#pragma unroll
                for (int bj = 0; bj < 2; ++bj) { f32x4 v0 = acc[ai][bj][m][0], v1 = acc[ai][bj][m][1];
                    if (mode != 0u) {
#pragma unroll
                        for (int j = 0; j < 4; ++j) { const float s0 = fsigmoid(v0[j]), s1 = fsigmoid(v1[j]); v0[j] = (mode == 1u) ? v0[j] * s0 : s0; v1[j] = (mode == 1u) ? v1[j] * s1 : s1; } }
                    u32x4 w; w.x = cvt_pk_bf16(v0[0], v0[1]); w.y = cvt_pk_bf16(v0[2], v0[3]); w.z = cvt_pk_bf16(v1[0], v1[1]); w.w = cvt_pk_bf16(v1[2], v1[3]);
                    *(u32x4*)(rowp + bj * HALF) = w; } }
        if (km != nullptr && u.pn >= 4 && u.pn < 8) {
            const int b = u.pm >> 6, blk = u.pm & 63;
#pragma unroll
            for (int bj = 0; bj < 2; ++bj)
#pragma unroll
                for (int n = 0; n < 2; ++n)
#pragma unroll
                    for (int e = 0; e < 4; ++e) {
                        float s = 0.f;
#pragma unroll
                        for (int ai = 0; ai < 2; ++ai)
#pragma unroll
                            for (int m = 0; m < 4; ++m) s += acc[ai][bj][m][n][e];
                        s = row16_sum(s);
                        if (fr == 0) { const int c = (u.pn - 4) * BM + bj * HALF + wc * 32 + 8 * fq + 4 * n + e, hd = c >> 7, d = c & 127;
                            __hip_atomic_fetch_add(km + ((size_t)((b * 8 + hd) * 64 + blk)) * 128 + d, s, __ATOMIC_RELAXED, __HIP_MEMORY_SCOPE_AGENT); }
                    }
        }
    }
};
struct EpiGateU8 {
    static constexpr bool PERM = true, AFTER_DRAIN = false, KEEP = false;
    unsigned char* O; int ldc; const float* rs;
    typedef RowScale8 State;
    __device__ __forceinline__ void load_state(State& st, const Unit& u, int wr, int fr) const {
#pragma unroll
        for (int ai = 0; ai < 2; ++ai)
#pragma unroll
            for (int m = 0; m < 4; ++m) st.r[ai][m] = rs[u.pm * BM + wr * 64 + fr + ai * HALF + m * 16]; }
    __device__ __forceinline__ void operator()(const f32x4 (&acc)[2][2][4][2], const Unit& u, int wr, int wc, int fr, int fq, const State& st) const {
        unsigned char* const tb = O + ((size_t)(u.pm * (ldc / BM) + u.pn) * 8 + (size_t)(wr * 4 + wc)) * 8192;
        const unsigned voff = (unsigned)(fr + 16 * fq) * 16u;
#pragma unroll
        for (int ai = 0; ai < 2; ++ai)
#pragma unroll
            for (int m = 0; m < 4; ++m) { const float rc = -1.4426950408889634f * st.r[ai][m]; unsigned q[2][8];
#pragma unroll
                for (int bj = 0; bj < 2; ++bj) {
#pragma unroll
                    for (int j = 0; j < 4; ++j) { q[bj][j] = (unsigned)fmaxf(__builtin_fmaf(__builtin_amdgcn_rcpf(1.0f + __builtin_amdgcn_exp2f(acc[ai][bj][m][0][j] * rc)), 255.f, 0.5f), 1.f); q[bj][4 + j] = (unsigned)fmaxf(__builtin_fmaf(__builtin_amdgcn_rcpf(1.0f + __builtin_amdgcn_exp2f(acc[ai][bj][m][1][j] * rc)), 255.f, 0.5f), 1.f); } }
                u32x4 w; w.x = q[0][0] | (q[0][1] << 8) | (q[0][2] << 16) | (q[0][3] << 24); w.y = q[0][4] | (q[0][5] << 8) | (q[0][6] << 16) | (q[0][7] << 24);
                w.z = q[1][0] | (q[1][1] << 8) | (q[1][2] << 16) | (q[1][3] << 24); w.w = q[1][4] | (q[1][5] << 8) | (q[1][6] << 16) | (q[1][7] << 24);
                *(u32x4*)(tb + (ai * 4 + m) * 1024 + voff) = w; }
    }
};
struct EpiSwiglu {
    static constexpr bool PERM = true, AFTER_DRAIN = false, KEEP = false;
    bf16_t* O; int ldc; const float* rs;
    typedef RowScale8 State;
    __device__ __forceinline__ void load_state(State& st, const Unit& u, int wr, int fr) const {
#pragma unroll
        for (int ai = 0; ai < 2; ++ai)
#pragma unroll
            for (int m = 0; m < 4; ++m) st.r[ai][m] = rs[u.pm * BM + wr * 64 + fr + ai * HALF + m * 16]; }
    __device__ __forceinline__ void operator()(const f32x4 (&acc)[2][2][4][2], const Unit& u, int wr, int wc, int fr, int fq, const State& st) const {
        const int row0 = u.pm * BM + wr * 64 + fr, col0 = u.pn * HALF + wc * 32 + 8 * fq;
#pragma unroll
        for (int ai = 0; ai < 2; ++ai)
#pragma unroll
            for (int m = 0; m < 4; ++m) { bf16_t* rowp = O + (size_t)(row0 + ai * HALF + m * 16) * ldc + col0; const float r = st.r[ai][m];
                const float rc = -1.4426950408889634f * r, r2 = r * r;
                const f32x4 a0 = acc[ai][0][m][0], a1 = acc[ai][0][m][1];
                const f32x4 p0 = (a0 * acc[ai][1][m][0]) * r2, p1 = (a1 * acc[ai][1][m][1]) * r2, x0 = a0 * rc, x1 = a1 * rc;
                f32x4 h0, h1;
#pragma unroll
                for (int j = 0; j < 4; ++j) { h0[j] = p0[j] * __builtin_amdgcn_rcpf(1.0f + __builtin_amdgcn_exp2f(x0[j])); h1[j] = p1[j] * __builtin_amdgcn_rcpf(1.0f + __builtin_amdgcn_exp2f(x1[j])); }
                u32x4 w; w.x = cvt_pk_bf16(h0[0], h0[1]); w.y = cvt_pk_bf16(h0[2], h0[3]); w.z = cvt_pk_bf16(h1[0], h1[1]); w.w = cvt_pk_bf16(h1[2], h1[3]);
                *(u32x4*)rowp = w; }
    }
};
struct EpiResid {
    static constexpr bool PERM = true, AFTER_DRAIN = false, KEEP = false;
    bf16_t* X; int ld; float scale; float* ssq;
    typedef NoState State;
    __device__ __forceinline__ void load_state(State&, const Unit&, int, int) const {}
    __device__ __forceinline__ void operator()(const f32x4 (&acc)[2][2][4][2], const Unit& u, int wr, int wc, int fr, int fq, const State&) const {
        const int row0 = u.pm * BM + wr * 64 + fr, col0 = u.pn * BM + wc * 32 + 8 * fq;
        u32x4 x[2][4][2];
#pragma unroll
        for (int ai = 0; ai < 2; ++ai)
#pragma unroll
            for (int m = 0; m < 4; ++m)
#pragma unroll
                for (int bj = 0; bj < 2; ++bj) x[ai][m][bj] = *(const u32x4*)(X + (size_t)(row0 + ai * HALF + m * 16) * ld + col0 + bj * HALF);
        asm volatile("" ::: "memory");
#pragma unroll
        for (int ai = 0; ai < 2; ++ai)
#pragma unroll
            for (int m = 0; m < 4; ++m)
            { float sq = 0.f;
#pragma unroll
                for (int bj = 0; bj < 2; ++bj) { const f32x4 v0 = acc[ai][bj][m][0], v1 = acc[ai][bj][m][1]; const u32x4 xx = x[ai][m][bj];
                    u32x4 w;
                    w.x = cvt_pk_bf16(bflo(xx.x) + scale * v0[0], bfhi(xx.x) + scale * v0[1]);
                    w.y = cvt_pk_bf16(bflo(xx.y) + scale * v0[2], bfhi(xx.y) + scale * v0[3]);
                    w.z = cvt_pk_bf16(bflo(xx.z) + scale * v1[0], bfhi(xx.z) + scale * v1[1]);
                    w.w = cvt_pk_bf16(bflo(xx.w) + scale * v1[2], bfhi(xx.w) + scale * v1[3]);
                    *(u32x4*)(X + (size_t)(row0 + ai * HALF + m * 16) * ld + col0 + bj * HALF) = w;
                    const float a0 = bflo(w.x), a1 = bfhi(w.x), a2 = bflo(w.y), a3 = bfhi(w.y), a4 = bflo(w.z), a5 = bfhi(w.z), a6 = bflo(w.w), a7 = bfhi(w.w);
                    sq += ((a0 * a0 + a1 * a1) + (a2 * a2 + a3 * a3)) + ((a4 * a4 + a5 * a5) + (a6 * a6 + a7 * a7)); }
                sq = xor32_sum(xor16_sum(sq));
                if (fq == 0) ssq[(size_t)(row0 + ai * HALF + m * 16) * 32 + u.pn * 4 + wc] = sq; }
        asm volatile("" ::: "memory");
    }
};
struct EpiMerge {
    static constexpr bool PERM = true, AFTER_DRAIN = false, KEEP = false;
    bf16_t* Y; int ldy; const unsigned char* Gt0; int ldg;
    typedef NoState State;
    __device__ __forceinline__ void load_state(State&, const Unit&, int, int) const {}
    __device__ __forceinline__ void operator()(const f32x4 (&acc)[2][2][4][2], const Unit& u, int wr, int wc, int fr, int fq, const State&) const {
        const int row0 = u.pm * BM + wr * 64 + fr, col0 = u.pn * BM + wc * 32 + 8 * fq;
        const unsigned char* Gt = Gt0 + u.q * ldy; const bool first = (u.q == 0);
#pragma unroll
        for (int ai = 0; ai < 2; ++ai) {
            typedef unsigned u32x2v __attribute__((ext_vector_type(2)));
            u32x2v g[4][2]; u32x4 yo[4][2];
#pragma unroll
            for (int m = 0; m < 4; ++m) { const size_t r = (size_t)(row0 + ai * HALF + m * 16);
#pragma unroll
                for (int bj = 0; bj < 2; ++bj) { g[m][bj] = *(const u32x2v*)(Gt + r * ldg + col0 + bj * HALF); yo[m][bj] = (u32x4){0u, 0u, 0u, 0u}; if (!first) yo[m][bj] = *(const u32x4*)(Y + r * ldy + col0 + bj * HALF); } }
            asm volatile("" ::: "memory");
#pragma unroll
            for (int m = 0; m < 4; ++m) { const size_t r = (size_t)(row0 + ai * HALF + m * 16);
#pragma unroll
                for (int bj = 0; bj < 2; ++bj) { const f32x4 v0 = acc[ai][bj][m][0], v1 = acc[ai][bj][m][1]; const u32x2v gg = g[m][bj]; const u32x4 yy = yo[m][bj]; constexpr float Q = 1.f / 255.f;
                    const float g0 = Q * (float)(gg.x & 255u), g1 = Q * (float)((gg.x >> 8) & 255u), g2 = Q * (float)((gg.x >> 16) & 255u), g3 = Q * (float)(gg.x >> 24);
                    const float g4 = Q * (float)(gg.y & 255u), g5 = Q * (float)((gg.y >> 8) & 255u), g6 = Q * (float)((gg.y >> 16) & 255u), g7 = Q * (float)(gg.y >> 24);
                    u32x4 w;
                    w.x = cvt_pk_bf16(bflo(yy.x) + g0 * v0[0], bfhi(yy.x) + g1 * v0[1]);
                    w.y = cvt_pk_bf16(bflo(yy.y) + g2 * v0[2], bfhi(yy.y) + g3 * v0[3]);
                    w.z = cvt_pk_bf16(bflo(yy.z) + g4 * v1[0], bfhi(yy.z) + g5 * v1[1]);
                    w.w = cvt_pk_bf16(bflo(yy.w) + g6 * v1[2], bfhi(yy.w) + g7 * v1[3]);
                    *(u32x4*)(Y + r * ldy + col0 + bj * HALF) = w; } }
            asm volatile("" ::: "memory");
        }
    }
};
struct EpiMergeR {
    static constexpr bool PERM = true, AFTER_DRAIN = false, KEEP = true;
    bf16_t* Y; int ldy; const unsigned char* Gt0; int ldg;
    typedef NoState State;
    __device__ __forceinline__ void load_state(State&, const Unit&, int, int) const {}
    static __device__ __forceinline__ float ub0(unsigned x) { return (float)(x & 255u); }
    static __device__ __forceinline__ float ub1(unsigned x) { return (float)((x >> 8) & 255u); }
    static __device__ __forceinline__ float ub2(unsigned x) { return (float)((x >> 16) & 255u); }
    static __device__ __forceinline__ float ub3(unsigned x) { return (float)(x >> 24); }
    __device__ __forceinline__ void operator()(f32x4 (&acc)[2][2][4][2], const Unit& u, int wr, int wc, int fr, int fq, const State&) const {
        typedef unsigned u32x2v __attribute__((ext_vector_type(2)));
        const int row0 = u.pm * BM + wr * 64 + fr, col0 = u.pn * BM + wc * 32 + 8 * fq;
        const unsigned char* const gp = Gt0 + ((size_t)(u.pm * (ldg / BM) + u.q * (ldy / BM) + u.pn) * 8 + (size_t)(wr * 4 + wc)) * 8192;
        const unsigned voffg = (unsigned)(fr + 16 * fq) * 16u;
        constexpr size_t NEXTQ = (size_t)8 * 65536;
        if (u.q < 2) {
            u32x2v ga[2][4][2], gb[2][4][2];
#pragma unroll
            for (int ai = 0; ai < 2; ++ai)
#pragma unroll
                for (int m = 0; m < 4; ++m) { const u32x4 wa = *(const u32x4*)(gp + (ai * 4 + m) * 1024 + voffg), wb = *(const u32x4*)(gp + NEXTQ + (ai * 4 + m) * 1024 + voffg);
                    ga[ai][m][0] = (u32x2v){wa.x, wa.y}; ga[ai][m][1] = (u32x2v){wa.z, wa.w}; gb[ai][m][0] = (u32x2v){wb.x, wb.y}; gb[ai][m][1] = (u32x2v){wb.z, wb.w}; }
            asm volatile("" ::: "memory");
#pragma unroll
            for (int ai = 0; ai < 2; ++ai)
#pragma unroll
                for (int m = 0; m < 4; ++m)
#pragma unroll
                    for (int bj = 0; bj < 2; ++bj) { const u32x2v a = ga[ai][m][bj], b = gb[ai][m][bj]; f32x4 v0 = acc[ai][bj][m][0], v1 = acc[ai][bj][m][1];
                        v0[0] *= ub0(a.x) * __builtin_amdgcn_rcpf(ub0(b.x)); v0[1] *= ub1(a.x) * __builtin_amdgcn_rcpf(ub1(b.x)); v0[2] *= ub2(a.x) * __builtin_amdgcn_rcpf(ub2(b.x)); v0[3] *= ub3(a.x) * __builtin_amdgcn_rcpf(ub3(b.x));
                        v1[0] *= ub0(a.y) * __builtin_amdgcn_rcpf(ub0(b.y)); v1[1] *= ub1(a.y) * __builtin_amdgcn_rcpf(ub1(b.y)); v1[2] *= ub2(a.y) * __builtin_amdgcn_rcpf(ub2(b.y)); v1[3] *= ub3(a.y) * __builtin_amdgcn_rcpf(ub3(b.y));
                        acc[ai][bj][m][0] = v0; acc[ai][bj][m][1] = v1; }
        } else {
            u32x2v g[2][4][2];
#pragma unroll
            for (int ai = 0; ai < 2; ++ai)
#pragma unroll
                for (int m = 0; m < 4; ++m)
                { const u32x4 wa = *(const u32x4*)(gp + (ai * 4 + m) * 1024 + voffg); g[ai][m][0] = (u32x2v){wa.x, wa.y}; g[ai][m][1] = (u32x2v){wa.z, wa.w}; }
            asm volatile("" ::: "memory");
#pragma unroll
            for (int ai = 0; ai < 2; ++ai)
#pragma unroll
                for (int m = 0; m < 4; ++m)
#pragma unroll
                    for (int bj = 0; bj < 2; ++bj) { const u32x2v gg = g[ai][m][bj]; const f32x4 v0 = acc[ai][bj][m][0], v1 = acc[ai][bj][m][1]; constexpr float Q = 1.f / 255.f;
                        u32x4 w;
                        w.x = cvt_pk_bf16(v0[0] * (Q * ub0(gg.x)), v0[1] * (Q * ub1(gg.x))); w.y = cvt_pk_bf16(v0[2] * (Q * ub2(gg.x)), v0[3] * (Q * ub3(gg.x)));
                        w.z = cvt_pk_bf16(v1[0] * (Q * ub0(gg.y)), v1[1] * (Q * ub1(gg.y))); w.w = cvt_pk_bf16(v1[2] * (Q * ub2(gg.y)), v1[3] * (Q * ub3(gg.y)));
                        *(u32x4*)(Y + (size_t)(row0 + ai * HALF + m * 16) * ldy + col0 + bj * HALF) = w; }
            asm volatile("" ::: "memory");
        }
    }
};
template <bool PERM>
__device__ __forceinline__ void voffb_for(int ldb, unsigned (&v)[2]) {
    int t = threadIdx.x; asm volatile("" : "+v"(t));
#pragma unroll
    for (int i = 0; i < 2; ++i) { int R, C; stage_rc(t * 16 + i * 8192, R, C); const int Rb = PERM ? ((R & ~31) + perm32(R & 31)) : R; v[i] = (unsigned)(Rb * ldb + C) * 2u; }
}
template <class Epi, class Sched, bool ALIGN_EPI = false, bool SP2 = false>
__device__ __forceinline__ void gemm_phase(PG8_LAS unsigned char* lds, const Gemm g, const Sched& S, const Epi& E) {
    int tid_ = threadIdx.x; asm volatile("" : "+v"(tid_));
    const int tid = tid_, wid = __builtin_amdgcn_readfirstlane(tid >> 6), lane = tid & 63, wr = wid >> 2, wc = wid & 3, fr = lane & 15, fq = lane >> 4;
    const int K = g.K; int nt = K / BK;
    unsigned voffA[2], voffB[2];
#pragma unroll
    for (int i = 0; i < 2; ++i) { int R, C; stage_rc(tid * 16 + i * 8192, R, C); const int Rb = Epi::PERM ? ((R & ~31) + perm32(R & 31)) : R;
        voffA[i] = (unsigned)(R * g.lda + C) * 2u; voffB[i] = (unsigned)(Rb * g.ldb + C) * 2u; }
    const size_t kstep = (size_t)(BK * 2);
    const size_t hstepA = (size_t)HALF * g.lda * 2; size_t hstepB = (size_t)HALF * g.ldb * 2;
    const size_t tstepA = 2 * hstepA; const size_t tstepB = 2 * hstepB;
    const unsigned ldsw = (unsigned)wid * 1024u;
    const int aoff = lds_byte(wr * 64 + fr, fq * 8), boff = lds_byte(wc * 32 + fr, fq * 8);
#define PG8_SA(b, h) (((b) * 2 + (h)) * HTB)
#define PG8_SB(b, h) ((4 + (b) * 2 + (h)) * HTB)
#define PG8_STAGE(bufoff, gbase, voff) do { _Pragma("unroll") for (int _i = 0; _i < 2; ++_i) \
        __builtin_amdgcn_global_load_lds((const unsigned*)((const char*)(gbase) + (voff)[_i]), (PG8_LAS unsigned*)(lds + (bufoff) + ldsw + _i * 8192), 16, 0, 0); } while (0)
#define PG8_LDA(dst, b, h) do { _Pragma("unroll") for (int m = 0; m < 4; ++m) _Pragma("unroll") for (int k = 0; k < 2; ++k) dst[m][k] = *(const PG8_LAS bf16x8*)(lds + PG8_SA(b, h) + aoff + m * 2048 + k * 1024); } while (0)
#define PG8_LDB(dst, b, h) do { _Pragma("unroll") for (int n = 0; n < 2; ++n) _Pragma("unroll") for (int k = 0; k < 2; ++k) dst[n][k] = *(const PG8_LAS bf16x8*)(lds + PG8_SB(b, h) + boff + n * 2048 + k * 1024); } while (0)
#define PG8_MMA(ai, bj, At, Bt) do { __builtin_amdgcn_s_setprio(1); _Pragma("unroll") for (int m = 0; m < 4; ++m) _Pragma("unroll") for (int n = 0; n < 2; ++n) _Pragma("unroll") for (int k = 0; k < 2; ++k) \
        acc[ai][bj][m][n] = __builtin_amdgcn_mfma_f32_16x16x32_bf16(Bt[n][k], At[m][k], acc[ai][bj][m][n], 0, 0, 0); __builtin_amdgcn_s_setprio(0); } while (0)
#define PG8_WAIT_V(n) asm volatile("s_waitcnt vmcnt(" #n ")" ::: "memory")
#define PG8_WAIT_L(n) asm volatile("s_waitcnt lgkmcnt(" #n ")" ::: "memory")
#define PG8_BAR __builtin_amdgcn_s_barrier()
#define PG8_SCHED __builtin_amdgcn_sched_barrier(0)
    Unit cur, nxt; int ui = 0;
    if (!S.next(0, cur)) return;
    f32x4 acc[2][2][4][2];
#pragma unroll
    for (int a = 0; a < 2; ++a)
#pragma unroll
        for (int b = 0; b < 2; ++b)
#pragma unroll
            for (int m = 0; m < 4; ++m)
#pragma unroll
                for (int n = 0; n < 2; ++n) acc[a][b][m][n] = (f32x4){0.f, 0.f, 0.f, 0.f};
    bf16x8 At[4][2], B0[2][2], B1[2][2];
    const char* cA = (const char*)g.A + (size_t)cur.pm * tstepA; const char* cB = (const char*)g.Bt + (size_t)cur.pn * tstepB;
    if constexpr (Sched::VARK) { const char* pA; const char* pB; int ldbc; S.params(cur, pA, pB, ldbc, nt); hstepB = (size_t)HALF * ldbc * 2; cA = pA + (size_t)cur.pm * tstepA; cB = pB + (size_t)cur.pn * (2 * hstepB);
        voffb_for<Epi::PERM>(ldbc, voffB); }
    typename Epi::State est; E.load_state(est, cur, wr, fr);
    S.a_ready(cur);
    if constexpr (SP2) {
        PG8_STAGE(PG8_SB(0, 0), cB, voffB); PG8_STAGE(PG8_SB(0, 1), cB + hstepB, voffB); PG8_STAGE(PG8_SA(0, 0), cA, voffA); PG8_STAGE(PG8_SA(0, 1), cA + hstepA, voffA);
        if (wr == 1) PG8_BAR;
        PG8_WAIT_V(2); PG8_BAR;
        PG8_STAGE(PG8_SB(1, 0), cB + kstep, voffB); PG8_STAGE(PG8_SA(1, 0), cA + kstep, voffA); PG8_STAGE(PG8_SB(1, 1), cB + hstepB + kstep, voffB);
        PG8_WAIT_V(6); PG8_BAR;
    } else {
        PG8_STAGE(PG8_SB(0, 0), cB, voffB); PG8_STAGE(PG8_SA(0, 0), cA, voffA); PG8_STAGE(PG8_SB(0, 1), cB + hstepB, voffB); PG8_STAGE(PG8_SA(0, 1), cA + hstepA, voffA);
        if (wr == 1) PG8_BAR;
        PG8_WAIT_V(4); PG8_BAR;
        PG8_STAGE(PG8_SB(1, 0), cB + kstep, voffB); PG8_STAGE(PG8_SA(1, 0), cA + kstep, voffA); PG8_STAGE(PG8_SB(1, 1), cB + hstepB + kstep, voffB);
        PG8_WAIT_V(6); PG8_BAR;
    }
    for (;;) {
        const bool has_next = S.next(ui + 1, nxt);
        const char* nA = has_next ? (const char*)g.A + (size_t)nxt.pm * tstepA : cA; const char* nB = has_next ? (const char*)g.Bt + (size_t)nxt.pn * tstepB : cB;
        unsigned voffBn[2] = {voffB[0], voffB[1]}; size_t hstepBn = hstepB; int ntn = nt;
        if constexpr (Sched::VARK) { if (has_next) { const char* pA; const char* pB; int ldbn; S.params(nxt, pA, pB, ldbn, ntn); hstepBn = (size_t)HALF * ldbn * 2; nA = pA + (size_t)nxt.pm * tstepA; nB = pB + (size_t)nxt.pn * (2 * hstepBn);
            voffb_for<Epi::PERM>(ldbn, voffBn); } }
        for (int t = 0; t < nt; t += 2) {
            const bool last = (t == nt - 2);
            const char* a1 = cA + (size_t)(t + 1) * kstep;
            const char* a2 = last ? nA : cA + (size_t)(t + 2) * kstep; const char* b2 = last ? nB : cB + (size_t)(t + 2) * kstep;
            const char* a3 = a2 + kstep; const char* b3 = b2 + kstep;
            if (last && has_next) S.a_ready(nxt);
            unsigned vBs[2]; size_t hsb;
            if constexpr (Sched::VARK) { vBs[0] = last ? voffBn[0] : voffB[0]; vBs[1] = last ? voffBn[1] : voffB[1]; hsb = last ? hstepBn : hstepB; } else { vBs[0] = voffB[0]; vBs[1] = voffB[1]; hsb = hstepB; }
            if constexpr (SP2) {
            PG8_LDB(B0, 0, 0); PG8_LDB(B1, 0, 1); PG8_SCHED; PG8_LDA(At, 0, 0); PG8_STAGE(PG8_SA(1, 1), a1 + hstepA, voffA);
            PG8_WAIT_V(8); PG8_WAIT_L(0); PG8_BAR; PG8_MMA(0, 0, At, B0); PG8_MMA(0, 1, At, B1); PG8_BAR; PG8_SCHED;
            PG8_LDA(At, 0, 1); PG8_STAGE(PG8_SB(0, 0), b2, vBs); PG8_STAGE(PG8_SB(0, 1), b2 + hsb, vBs); PG8_STAGE(PG8_SA(0, 0), a2, voffA);
            PG8_WAIT_V(8); PG8_WAIT_L(0); PG8_BAR; PG8_MMA(1, 0, At, B0); PG8_MMA(1, 1, At, B1); PG8_BAR; PG8_SCHED;
            PG8_LDB(B0, 1, 0); PG8_LDB(B1, 1, 1); PG8_SCHED; PG8_LDA(At, 1, 0); PG8_STAGE(PG8_SA(0, 1), a2 + hstepA, voffA);
            PG8_WAIT_V(8); PG8_WAIT_L(0); PG8_BAR; PG8_MMA(0, 0, At, B0); PG8_MMA(0, 1, At, B1); PG8_BAR; PG8_SCHED;
            PG8_LDA(At, 1, 1); PG8_STAGE(PG8_SB(1, 0), b3, vBs); PG8_STAGE(PG8_SB(1, 1), b3 + hsb, vBs); PG8_STAGE(PG8_SA(1, 0), a3, voffA);
            PG8_WAIT_V(8); PG8_WAIT_L(0); PG8_BAR; PG8_MMA(1, 0, At, B0); PG8_MMA(1, 1, At, B1); PG8_BAR; PG8_SCHED;
            } else {
            PG8_LDB(B0, 0, 0); PG8_SCHED; PG8_LDA(At, 0, 0); PG8_STAGE(PG8_SA(1, 1), a1 + hstepA, voffA);
            PG8_WAIT_L(8); PG8_BAR; PG8_WAIT_L(0); PG8_MMA(0, 0, At, B0); PG8_BAR; PG8_SCHED;
            PG8_LDB(B1, 0, 1); PG8_STAGE(PG8_SB(0, 0), b2, voffB);
            PG8_BAR; PG8_WAIT_L(0); PG8_MMA(0, 1, At, B1); PG8_BAR;
            PG8_LDA(At, 0, 1); PG8_STAGE(PG8_SA(0, 0), a2, voffA);
            PG8_BAR; PG8_WAIT_L(0); PG8_MMA(1, 0, At, B0); PG8_BAR; PG8_SCHED;
            PG8_STAGE(PG8_SB(0, 1), b2 + hstepB, voffB);
            PG8_WAIT_V(6); PG8_BAR; PG8_MMA(1, 1, At, B1); PG8_BAR;
            PG8_LDB(B0, 1, 0); PG8_SCHED; PG8_LDA(At, 1, 0); PG8_STAGE(PG8_SA(0, 1), a2 + hstepA, voffA);
            PG8_WAIT_L(8); PG8_BAR; PG8_WAIT_L(0); PG8_MMA(0, 0, At, B0); PG8_BAR; PG8_SCHED;
            PG8_LDB(B1, 1, 1); PG8_STAGE(PG8_SB(1, 0), b3, voffB);
            PG8_BAR; PG8_WAIT_L(0); PG8_MMA(0, 1, At, B1); PG8_BAR;
            PG8_LDA(At, 1, 1); PG8_STAGE(PG8_SA(1, 0), a3, voffA);
            PG8_BAR; PG8_WAIT_L(0); PG8_MMA(1, 0, At, B0); PG8_BAR; PG8_SCHED;
            PG8_STAGE(PG8_SB(1, 1), b3 + hstepB, voffB);
            PG8_WAIT_V(6); PG8_BAR; PG8_MMA(1, 1, At, B1); PG8_BAR;
            }
        }
        if constexpr (ALIGN_EPI) { if (wr == 0) PG8_BAR; }
        if constexpr (!Epi::AFTER_DRAIN) { E(acc, cur, wr, wc, fr, fq, est); S.done(cur); }
        if (!has_next) break;
        if (!Epi::KEEP || cur.q == 2) {
#pragma unroll
        for (int a = 0; a < 2; ++a)
#pragma unroll
            for (int b = 0; b < 2; ++b)
#pragma unroll
                for (int m = 0; m < 4; ++m)
#pragma unroll
                    for (int n = 0; n < 2; ++n) acc[a][b][m][n] = (f32x4){0.f, 0.f, 0.f, 0.f};
        }
        cur = nxt; cA = nA; cB = nB; ++ui; E.load_state(est, cur, wr, fr);
        if constexpr (Sched::VARK) { voffB[0] = voffBn[0]; voffB[1] = voffBn[1]; hstepB = hstepBn; nt = ntn; }
        if constexpr (ALIGN_EPI) { if (wr == 1) PG8_BAR; }
    }
    PG8_WAIT_V(0);
    if constexpr (!ALIGN_EPI) { if (wr == 0) PG8_BAR; }
    PG8_BAR;
    if constexpr (Epi::AFTER_DRAIN) { E.fused(acc, cur, wr, wc, fr, fq, lds, wid, lane); S.done(cur); }
#undef PG8_SA
#undef PG8_SB
#undef PG8_STAGE
#undef PG8_LDA
#undef PG8_LDB
#undef PG8_MMA
#undef PG8_WAIT_V
#undef PG8_WAIT_L
#undef PG8_BAR
#undef PG8_SCHED
}
}

typedef unsigned short bf16;
typedef unsigned v4u __attribute__((ext_vector_type(4)));
typedef unsigned v2u __attribute__((ext_vector_type(2)));
typedef float f32x4 __attribute__((ext_vector_type(4)));
typedef float f32x16 __attribute__((ext_vector_type(16)));
typedef short bf16x8 __attribute__((ext_vector_type(8)));
typedef GAS unsigned gu32;
#define RLX_AGENT __ATOMIC_RELAXED, __HIP_MEMORY_SCOPE_AGENT
#define LDS_WAIT() asm volatile("s_waitcnt lgkmcnt(0)" ::: "memory")
#define VM_WAIT() asm volatile("s_waitcnt vmcnt(0)" ::: "memory")
#define MFMA32(a, b, c) __builtin_amdgcn_mfma_f32_32x32x16_bf16((a), (b), (c), 0, 0, 0)
__device__ __forceinline__ unsigned f2bf(float f) { return pg8::cvt_pk_bf16(f, 0.f) & 0xffffu; }
__device__ __forceinline__ unsigned pk2(float lo, float hi) { return pg8::cvt_pk_bf16(lo, hi); }
__device__ __forceinline__ float bf2f(unsigned short b) { return __builtin_bit_cast(float, (unsigned)b << 16); }
using pg8::bflo; using pg8::bfhi; using pg8::fsigmoid;
__device__ __forceinline__ float fexp2(float x) { return __builtin_amdgcn_exp2f(x); }
__device__ __forceinline__ float fexp(float x) { return __builtin_amdgcn_exp2f(1.4426950408889634f * x); }
__device__ __forceinline__ bf16x8 as_bf16x8(v4u v) { return __builtin_bit_cast(bf16x8, v); }

constexpr int BATCH = 2, T = 16384, D = 2048, M = BATCH * T, DFF = 5632, NMEM = 256, DEPTH = 2;
constexpr int NMAIN = 4096, NVT = 1536, NGATE = 6144, NIN = 11776;
constexpr int CQA = 0, CKA = 1024, CQB = 2048, CFB = 2560, CGB = 3072, CQM = 3584;
constexpr int NWAVES = 8;
constexpr float RMS_EPS = 1e-6f;
constexpr size_t MiB = 1u << 20;
constexpr size_t WS_CTL = 0, CTL_ZERO_BYTES = 2 * MiB;
constexpr size_t WS_KMEAN = 1 * MiB;
constexpr size_t WS_R0 = 2 * MiB;
constexpr size_t WS_PM = 130 * MiB;
constexpr size_t WS_VT = 386 * MiB;
constexpr size_t WS_PG = 482 * MiB;
constexpr size_t WS_PO = WS_PG;
constexpr size_t WS_ML = WS_PG + 192 * MiB;
constexpr size_t WS_ST = WS_PG + 200 * MiB;
constexpr size_t WS_DEC = WS_PG + 328 * MiB;
constexpr size_t WS_SEL = WS_PG + 330 * MiB;
constexpr size_t WS_W = 866 * MiB;
constexpr size_t WS_MEMN = 932 * MiB;
constexpr size_t WS_WKV = 936 * MiB;
constexpr size_t WS_KM = 944 * MiB;
constexpr size_t WS_VMT = 945 * MiB;
constexpr size_t WS_RS = 946 * MiB;
constexpr size_t WS_SSQ = 947 * MiB;
constexpr size_t WS_END = 951 * MiB;
constexpr size_t WO_W2 = 44 * MiB, WO_PA = 46 * MiB, WO_PB = 50 * MiB, WO_PMM = 52 * MiB, WO_OUT = 54 * MiB;
constexpr int CW_TMO = 0, CW_BAR = 4096;
constexpr int RING_OFF = 0, RING_BYTES = 131072;
constexpr int SCR_BYTES = 155648;
constexpr int MISC_OFF = SCR_BYTES;
constexpr int LDS_BYTES = 163840;
constexpr int KSB = 272, VSB = 520;
constexpr int KS_OFF = 0, VS_OFF = 256 * KSB  , LIST_OFF = VS_OFF + 128 * VSB  , WCNT_OFF = LIST_OFF + 16384;
static_assert(WCNT_OFF + 64 <= SCR_BYTES, "LDS map");

#define XB_TMO      128
#define XB_XCNT(j)  (256  + 64 * (j))
#define XB_XSUB(j)  (1280 + 64 * (j))
#define XB_XGEN(j)  (2304 + 64 * (j))
#define XB_TOP      3328
#define XB_TOPGEN   3392
#define XCD_BAR_WORDS 3456
#define XB_SPIN_CAP (1u << 18)

__device__ __forceinline__ unsigned xb_ld(unsigned* p)              { return __hip_atomic_load(p, __ATOMIC_RELAXED, __HIP_MEMORY_SCOPE_AGENT); }
__device__ __forceinline__ unsigned xb_add(unsigned* p, unsigned v) { return __hip_atomic_fetch_add(p, v, __ATOMIC_RELAXED, __HIP_MEMORY_SCOPE_AGENT); }
__device__ __forceinline__ unsigned xb_xcc_id() { return (unsigned)__builtin_amdgcn_s_getreg((3 << 11) | 20) & 0xFu; }
#define XB_SPIN(cond, bar) do { unsigned _sp = 0; while (cond) { __builtin_amdgcn_s_sleep(1); \
    if ((++_sp & 255u) == 0u) { if (xb_ld(&(bar)[XB_TMO])) break; if (_sp > XB_SPIN_CAP) { atomicAdd(&(bar)[XB_TMO], 1u); break; } } } } while (0)

struct XcdBarrier {
    unsigned* bar; unsigned x;
    volatile LAS unsigned* st;
};

__device__ __forceinline__ XcdBarrier xcd_barrier_post(unsigned* bar, volatile LAS unsigned* st) {
    XcdBarrier b; b.bar = bar; b.x = xb_xcc_id(); b.st = st;
    if (threadIdx.x == 0) (void)xb_add(&bar[XB_XCNT(b.x)], 1u);
    return b;
}
__device__ __forceinline__ void xcd_barrier_complete(unsigned* bar, unsigned x, unsigned& nloc, unsigned& nx) {
    const unsigned G = gridDim.x * gridDim.y * gridDim.z;
    unsigned sum, cnt, mine, sp = 0u;
    for (;;) {
        sum = 0u; cnt = 0u; mine = 0u;
#pragma unroll
        for (unsigned j = 0; j < 16; ++j) { const unsigned c = xb_ld(&bar[XB_XCNT(j)]); sum += c; cnt += (c > 0u) ? 1u : 0u; mine = (j == x) ? c : mine; }
        if (sum == G) break;
        __builtin_amdgcn_s_sleep(1);
        if ((++sp & 255u) == 0u) { if (xb_ld(&bar[XB_TMO])) break; if (sp > XB_SPIN_CAP) { atomicAdd(&bar[XB_TMO], 1u); break; } }
    }
    nloc = mine > 0u ? mine : 1u; nx = cnt > 0u ? cnt : 1u;
}

__device__ __forceinline__ void xcd_barrier(const XcdBarrier& b) {
    asm volatile("s_waitcnt vmcnt(0)" ::: "memory");
    __syncthreads();
    if (threadIdx.x == 0) {
        unsigned* bar = b.bar;
        __builtin_amdgcn_s_waitcnt(0);
        unsigned nloc = b.st[0], nx = b.st[1];
        if (nloc == 0u) { xcd_barrier_complete(bar, b.x, nloc, nx); b.st[0] = nloc; b.st[1] = nx; }
        const unsigned old = xb_add(&bar[XB_XSUB(b.x)], 1u);
        const unsigned gen = old / nloc;
        if (old + 1u == (gen + 1u) * nloc) {
            __builtin_amdgcn_fence(__ATOMIC_RELEASE, "agent");
            asm volatile("s_waitcnt vmcnt(0)" ::: "memory");
            const unsigned og = xb_add(&bar[XB_TOP], 1u);
            const unsigned tg = og / nx;
            if (og + 1u == (tg + 1u) * nx) xb_add(&bar[XB_TOPGEN], 1u);
            else XB_SPIN(xb_ld(&bar[XB_TOPGEN]) == tg, bar);
            __builtin_amdgcn_fence(__ATOMIC_ACQUIRE, "agent");
            xb_add(&bar[XB_XGEN(b.x)], 1u);
            asm volatile("s_waitcnt vmcnt(0)" ::: "memory");
        } else {
            XB_SPIN(xb_ld(&bar[XB_XGEN(b.x)]) == gen, bar);
            __builtin_amdgcn_fence(__ATOMIC_ACQUIRE, "agent");
            asm volatile("s_waitcnt vmcnt(0)" ::: "memory");
        }
    }
    __syncthreads();
}


__device__ __forceinline__ float wave_sum(float v) {
    return pg8::xor32_sum(pg8::xor16_sum(pg8::row16_sum(v)));
}
__device__ __forceinline__ void rms_row_bf16(const float* xrow, const float* g, bf16* orow, int lane, bf16* xb = nullptr) {
    const f32x4* xr = (const f32x4*)xrow + lane; const f32x4* gr = (const f32x4*)g + lane;
    f32x4 v[8]; float s = 0.f;
#pragma unroll
    for (int j = 0; j < 8; ++j) { v[j] = xr[64 * j]; s += (v[j].x * v[j].x + v[j].y * v[j].y) + (v[j].z * v[j].z + v[j].w * v[j].w); }
    const float r = __builtin_amdgcn_rsqf(wave_sum(s) * (1.f / D) + RMS_EPS);
    v2u* o8 = (v2u*)orow + lane;
#pragma unroll
    for (int j = 0; j < 8; ++j) { const f32x4 gg = gr[64 * j]; v2u w; w.x = pk2(v[j].x * r * gg.x, v[j].y * r * gg.y); w.y = pk2(v[j].z * r * gg.z, v[j].w * r * gg.w); o8[64 * j] = w; }
    if (xb != nullptr) { v2u* x8 = (v2u*)xb + lane;
#pragma unroll
        for (int j = 0; j < 8; ++j) { v2u w; w.x = pk2(v[j].x, v[j].y); w.y = pk2(v[j].z, v[j].w); x8[64 * j] = w; } }
}
__device__ __forceinline__ void rms_xb_bf16(const bf16* xrow, const float* g, bf16* orow, int lane) {
    const v4u* xr = (const v4u*)xrow + lane; const f32x4* gr = (const f32x4*)g + 2 * lane;
    float v[4][8]; float s = 0.f;
#pragma unroll
    for (int j = 0; j < 4; ++j) { const v4u w = xr[64 * j]; v[j][0] = bflo(w.x); v[j][1] = bfhi(w.x); v[j][2] = bflo(w.y); v[j][3] = bfhi(w.y); v[j][4] = bflo(w.z); v[j][5] = bfhi(w.z); v[j][6] = bflo(w.w); v[j][7] = bfhi(w.w);
#pragma unroll
        for (int e = 0; e < 8; ++e) s += v[j][e] * v[j][e]; }
    const float r = __builtin_amdgcn_rsqf(wave_sum(s) * (1.f / D) + RMS_EPS);
    v4u* o = (v4u*)orow + lane;
#pragma unroll
    for (int j = 0; j < 4; ++j) { const f32x4 g0 = gr[128 * j], g1 = gr[128 * j + 1]; v4u w;
        w.x = pk2(v[j][0] * r * g0.x, v[j][1] * r * g0.y); w.y = pk2(v[j][2] * r * g0.z, v[j][3] * r * g0.w); w.z = pk2(v[j][4] * r * g1.x, v[j][5] * r * g1.y); w.w = pk2(v[j][6] * r * g1.z, v[j][7] * r * g1.w); o[64 * j] = w; }
}
__device__ __forceinline__ void rms_xb_f32(const bf16* xrow, const float* g, float* orow, int lane) {
    const v4u* xr = (const v4u*)xrow + lane; const f32x4* gr = (const f32x4*)g + 2 * lane;
    float v[4][8]; float s = 0.f;
#pragma unroll
    for (int j = 0; j < 4; ++j) { const v4u w = xr[64 * j]; v[j][0] = bflo(w.x); v[j][1] = bfhi(w.x); v[j][2] = bflo(w.y); v[j][3] = bfhi(w.y); v[j][4] = bflo(w.z); v[j][5] = bfhi(w.z); v[j][6] = bflo(w.w); v[j][7] = bfhi(w.w);
#pragma unroll
        for (int e = 0; e < 8; ++e) s += v[j][e] * v[j][e]; }
    const float r = __builtin_amdgcn_rsqf(wave_sum(s) * (1.f / D) + RMS_EPS);
    f32x4* o = (f32x4*)orow + 2 * lane;
#pragma unroll
    for (int j = 0; j < 4; ++j) { const f32x4 g0 = gr[128 * j], g1 = gr[128 * j + 1];
        o[128 * j] = (f32x4){v[j][0] * r * g0.x, v[j][1] * r * g0.y, v[j][2] * r * g0.z, v[j][3] * r * g0.w}; o[128 * j + 1] = (f32x4){v[j][4] * r * g1.x, v[j][5] * r * g1.y, v[j][6] * r * g1.z, v[j][7] * r * g1.w}; }
}
__device__ __forceinline__ void rms_xb_f32_x4(const bf16* x0, size_t rstride, const float* g, float* o0, size_t ostride, int lane) {
    v4u w[4][4];
#pragma unroll
    for (int q = 0; q < 4; ++q)
#pragma unroll
        for (int j = 0; j < 4; ++j) w[q][j] = ((const v4u*)(x0 + q * rstride) + lane)[64 * j];
    const f32x4* gr = (const f32x4*)g + 2 * lane;
#pragma unroll
    for (int q = 0; q < 4; ++q) { float v[4][8]; float s = 0.f;
#pragma unroll
        for (int j = 0; j < 4; ++j) { const v4u ww = w[q][j]; v[j][0] = bflo(ww.x); v[j][1] = bfhi(ww.x); v[j][2] = bflo(ww.y); v[j][3] = bfhi(ww.y); v[j][4] = bflo(ww.z); v[j][5] = bfhi(ww.z); v[j][6] = bflo(ww.w); v[j][7] = bfhi(ww.w);
#pragma unroll
            for (int e = 0; e < 8; ++e) s += v[j][e] * v[j][e]; }
        const float r = __builtin_amdgcn_rsqf(wave_sum(s) * (1.f / D) + RMS_EPS);
        f32x4* o = (f32x4*)(o0 + q * ostride) + 2 * lane;
#pragma unroll
        for (int j = 0; j < 4; ++j) { const f32x4 g0 = gr[128 * j], g1 = gr[128 * j + 1];
            o[128 * j] = (f32x4){v[j][0] * r * g0.x, v[j][1] * r * g0.y, v[j][2] * r * g0.z, v[j][3] * r * g0.w}; o[128 * j + 1] = (f32x4){v[j][4] * r * g1.x, v[j][5] * r * g1.y, v[j][6] * r * g1.z, v[j][7] * r * g1.w}; } }
}
__device__ __forceinline__ float rms_stat_xb(const bf16* xrow, int lane) {
    const v4u* xr = (const v4u*)xrow + lane; float s = 0.f;
#pragma unroll
    for (int j = 0; j < 4; ++j) { const v4u w = xr[64 * j]; const float a0 = bflo(w.x), a1 = bfhi(w.x), a2 = bflo(w.y), a3 = bfhi(w.y), a4 = bflo(w.z), a5 = bfhi(w.z), a6 = bflo(w.w), a7 = bfhi(w.w);
        s += ((a0 * a0 + a1 * a1) + (a2 * a2 + a3 * a3)) + ((a4 * a4 + a5 * a5) + (a6 * a6 + a7 * a7)); }
    return __builtin_amdgcn_rsqf(wave_sum(s) * (1.f / D) + RMS_EPS);
}
__device__ __forceinline__ float rms_stat_partials(const float* ssq_row) {
    float s = 0.f;
#pragma unroll
    for (int i = 0; i < 8; ++i) { const f32x4 v = ((const f32x4*)ssq_row)[i]; s += (v.x + v.y) + (v.z + v.w); }
    return __builtin_amdgcn_rsqf(s * (1.f / D) + RMS_EPS);
}
__device__ __forceinline__ float rms_stat_f32_copy(const float* xrow, bf16* xb, int lane) {
    const f32x4* xr = (const f32x4*)xrow + lane; v2u* x8 = (v2u*)xb + lane; float s = 0.f;
#pragma unroll
    for (int j = 0; j < 8; ++j) { const f32x4 v = xr[64 * j]; v2u w; w.x = pk2(v.x, v.y); w.y = pk2(v.z, v.w); x8[64 * j] = w;
        const float a0 = bflo(w.x), a1 = bfhi(w.x), a2 = bflo(w.y), a3 = bfhi(w.y); s += (a0 * a0 + a1 * a1) + (a2 * a2 + a3 * a3); }
    return __builtin_amdgcn_rsqf(wave_sum(s) * (1.f / D) + RMS_EPS);
}
__device__ __forceinline__ void rms_stat_f32_copy_x2(const float* x0, const float* x1, bf16* b0, bf16* b1, float* rs0, float* rs1, int lane) {
    f32x4 va[8], vb[8];
#pragma unroll
    for (int j = 0; j < 8; ++j) { va[j] = ((const f32x4*)x0 + lane)[64 * j]; vb[j] = ((const f32x4*)x1 + lane)[64 * j]; }
    float sa = 0.f, sb = 0.f;
#pragma unroll
    for (int j = 0; j < 8; ++j) { v2u w; w.x = pk2(va[j].x, va[j].y); w.y = pk2(va[j].z, va[j].w); ((v2u*)b0 + lane)[64 * j] = w;
        { const float a0 = bflo(w.x), a1 = bfhi(w.x), a2 = bflo(w.y), a3 = bfhi(w.y); sa += (a0 * a0 + a1 * a1) + (a2 * a2 + a3 * a3); }
        w.x = pk2(vb[j].x, vb[j].y); w.y = pk2(vb[j].z, vb[j].w); ((v2u*)b1 + lane)[64 * j] = w;
        { const float a0 = bflo(w.x), a1 = bfhi(w.x), a2 = bflo(w.y), a3 = bfhi(w.y); sb += (a0 * a0 + a1 * a1) + (a2 * a2 + a3 * a3); } }
    const float ra = __builtin_amdgcn_rsqf(wave_sum(sa) * (1.f / D) + RMS_EPS), rb = __builtin_amdgcn_rsqf(wave_sum(sb) * (1.f / D) + RMS_EPS);
    if (lane == 0) { *rs0 = ra; *rs1 = rb; }
}
__device__ __forceinline__ void rms_row_f32(const float* xrow, const float* g, float* orow, int lane) {
    const f32x4* xr = (const f32x4*)xrow + lane; const f32x4* gr = (const f32x4*)g + lane;
    f32x4 v[8]; float s = 0.f;
#pragma unroll
    for (int j = 0; j < 8; ++j) { v[j] = xr[64 * j]; s += (v[j].x * v[j].x + v[j].y * v[j].y) + (v[j].z * v[j].z + v[j].w * v[j].w); }
    const float r = __builtin_amdgcn_rsqf(wave_sum(s) * (1.f / D) + RMS_EPS);
    f32x4* o = (f32x4*)orow + lane;
#pragma unroll
    for (int j = 0; j < 8; ++j) { const f32x4 gg = gr[64 * j]; o[64 * j] = v[j] * r * gg; }
}
template <int NT>
__device__ __forceinline__ void transpose_items(const float* W, int N, const int (&k0)[NT], const int (&n0)[NT], bf16* WT, int Kd, const int (&drow0)[NT], LAS float* scr, int lane, const float* gk) {
    float v[NT][32];
#pragma unroll
    for (int t = 0; t < NT; ++t)
#pragma unroll
        for (int i = 0; i < 32; ++i) v[t][i] = W[(size_t)(k0[t] + 2 * i + (lane >> 5)) * N + n0[t] + (lane & 31)];
#pragma unroll
    for (int t = 0; t < NT; ++t)
#pragma unroll
        for (int i = 0; i < 32; ++i) scr[t * 2112 + (2 * i + (lane >> 5)) * 33 + (lane & 31)] = v[t][i];
    LDS_WAIT(); asm volatile("" ::: "memory");
    const int c = lane & 7;
#pragma unroll
    for (int t = 0; t < NT; ++t) {
        f32x4 ga = {1.f, 1.f, 1.f, 1.f}, gb = {1.f, 1.f, 1.f, 1.f}; if (gk) { ga = *(const f32x4*)(gk + k0[t] + 8 * c); gb = *(const f32x4*)(gk + k0[t] + 8 * c + 4); }
#pragma unroll
        for (int j = 0; j < 4; ++j) { const int n = (lane >> 3) + 8 * j; const LAS float* s = scr + t * 2112 + (8 * c) * 33 + n;
            v4u o; o.x = pk2(s[0 * 33] * ga.x, s[1 * 33] * ga.y); o.y = pk2(s[2 * 33] * ga.z, s[3 * 33] * ga.w); o.z = pk2(s[4 * 33] * gb.x, s[5 * 33] * gb.y); o.w = pk2(s[6 * 33] * gb.z, s[7 * 33] * gb.w);
            *(v4u*)(WT + (size_t)(drow0[t] + n) * Kd + k0[t] + 8 * c) = o; } }
    LDS_WAIT(); asm volatile("" ::: "memory");
}
__device__ __forceinline__ int win_row(int n) {
    if (n < 2048) return n;
    if (n < 3072) return 4096 + (n - 2048);
    if (n < 3584) return 2048 + (n - 3072);
    if (n < 4096) return 2560 + (n - 3584);
    if (n < 4608) return 5120 + (n - 4096);
    if (n < 5120) return 3072 + (n - 4608);
    if (n < 5632) return 3584 + (n - 5120);
    return n;
}
__device__ __forceinline__ void convert_matrix(const float* W, int K, int N, bf16* WT, int kind, int off, LAS float* scr, int gw, int NGW, int lane, const float* gk = nullptr) {
    const int nblk = N / 32, nitems = (K / 64) * nblk;
    int it = gw;
    for (; it + NGW < nitems; it += 2 * NGW) {
        int k0[2], n0[2], dr[2];
#pragma unroll
        for (int t = 0; t < 2; ++t) { const int i2 = it + t * NGW, kb = i2 / nblk, nb = i2 % nblk; k0[t] = 64 * kb; n0[t] = 32 * nb;
            dr[t] = (kind == 0) ? n0[t] + off : (kind == 1) ? (n0[t] >> 7) * 256 + off + (n0[t] & 127) : win_row(n0[t]); }
        transpose_items<2>(W, N, k0, n0, WT, K, dr, scr, lane, gk); }
    if (it < nitems) { const int kb = it / nblk, nb = it % nblk; const int k0[1] = {64 * kb}, n0[1] = {32 * nb};
        const int dr[1] = {(kind == 0) ? n0[0] + off : (kind == 1) ? (n0[0] >> 7) * 256 + off + (n0[0] & 127) : win_row(n0[0])};
        transpose_items<1>(W, N, k0, n0, WT, K, dr, scr, lane, gk); }
}
template <int ROWS, int ROWBYTES, int SB>
__device__ __forceinline__ void lds_fill(LAS unsigned char* dst, const bf16* src, size_t ld, int tid) {
    constexpr int CH = ROWBYTES / 16;
#pragma unroll 4
    for (int i = tid; i < ROWS * CH; i += NWAVES * 64) { const int rr = i / CH, c = i % CH;
        const v4u v = *(const v4u*)((const unsigned char*)(src + (size_t)rr * ld) + c * 16);
        LAS v2u* d = (LAS v2u*)(dst + rr * SB + c * 16); d[0] = (v2u){v.x, v.y}; d[1] = (v2u){v.z, v.w}; }
}
__device__ __forceinline__ void fill_kv_tiles(LAS unsigned char* lds, const bf16* kg, size_t kld, const bf16* vg, size_t vld, int tid) {
    v4u kreg[8], vreg[8];
#pragma unroll
    for (int i = 0; i < 8; ++i) { const int ci = tid + i * 512; kreg[i] = *(const v4u*)(kg + (size_t)(ci >> 4) * kld + (ci & 15) * 8); vreg[i] = *(const v4u*)(vg + (size_t)(ci >> 5) * vld + (ci & 31) * 8); }
#pragma unroll
    for (int i = 0; i < 8; ++i) { const int ci = tid + i * 512;
        LAS v2u* dk = (LAS v2u*)(lds + KS_OFF + (ci >> 4) * KSB + (ci & 15) * 16); dk[0] = (v2u){kreg[i].x, kreg[i].y}; dk[1] = (v2u){kreg[i].z, kreg[i].w};
        LAS v2u* dv = (LAS v2u*)(lds + VS_OFF + (ci >> 5) * VSB + (ci & 31) * 16); dv[0] = (v2u){vreg[i].x, vreg[i].y}; dv[1] = (v2u){vreg[i].z, vreg[i].w}; }
}
__device__ __forceinline__ void load_qfrags(bf16x8 (&qf)[8], const bf16* qrow, int h) {
#pragma unroll
    for (int s = 0; s < 8; ++s) qf[s] = *(const bf16x8*)(qrow + 16 * s + 8 * h);
}
template <bool BIAS, bool CAUSAL>
__device__ __forceinline__ void attn_chunk(const LAS unsigned char* Kc, const LAS unsigned char* Vc, bf16x8 (&qf)[8], f32x16 (&o)[4], float& m, float& l,
                                           const int dist0, const float slope_l2, const int r, const int h, const bf16* qnext = nullptr) {
    constexpr float C = 0.08838834764831845f * 1.4426950408889634f;
    f32x16 st[4];
    bf16x8 kf[3][4];
#pragma unroll
    for (int s = 0; s < 4; ++s) kf[0][s] = *(const LAS bf16x8*)(Kc + r * KSB + s * 32 + h * 16);
#pragma unroll
    for (int s = 0; s < 4; ++s) kf[1][s] = *(const LAS bf16x8*)(Kc + r * KSB + (4 + s) * 32 + h * 16);
#pragma unroll
    for (int hb = 0; hb < 8; ++hb) { const int kt = hb >> 1, s0 = (hb & 1) * 4;
        if (hb < 6) { const int kn = (hb + 2) >> 1, sn = ((hb + 2) & 1) * 4;
#pragma unroll
            for (int s = 0; s < 4; ++s) kf[(hb + 2) % 3][s] = *(const LAS bf16x8*)(Kc + (kn * 32 + r) * KSB + (sn + s) * 32 + h * 16); }
        __builtin_amdgcn_sched_barrier(0);
        if (s0 == 0) {
#pragma unroll
            for (int e = 0; e < 16; ++e) st[kt][e] = 0.f; }
#pragma unroll
        for (int s = 0; s < 4; ++s) st[kt] = MFMA32(kf[hb % 3][s], qf[s0 + s], st[kt]);
        __builtin_amdgcn_sched_barrier(0);
    }
    v2u vlo[3][4], vhi[3][4];
#pragma unroll
    for (int i = 0; i < 4; ++i) { const LAS unsigned char* vp = Vc + r * VSB + ((i >> 1) * 32 + 16 * (i & 1) + 4 * h) * 2; vlo[0][i] = *(const LAS v2u*)vp; vhi[0][i] = *(const LAS v2u*)(vp + 16); }
    __builtin_amdgcn_sched_barrier(0);
    if (qnext != nullptr) load_qfrags(qf, qnext, h);
    int dl = dist0 - 4 * h;
    float sl2 = slope_l2; asm volatile("" : "+v"(sl2), "+v"(dl));
    const float bias0 = -sl2 * (float)dl;
    float mx = -1e30f;
#pragma unroll
    for (int kt = 0; kt < 4; ++kt)
#pragma unroll
        for (int e = 0; e < 16; ++e) { const int kk = kt * 32 + (e & 3) + 8 * (e >> 2);
            float x = st[kt][e] * C;
            if (BIAS) x += __builtin_fmaf(sl2, (float)kk, bias0);
            if (CAUSAL) x = (dl - kk >= 0) ? x : -1e30f;
            st[kt][e] = x; mx = fmaxf(mx, x); }
    mx = pg8::xor32_max(mx);
    const float mn = fmaxf(m, mx), alpha = fexp2(m - mn); m = mn;
    float ps = 0.f;
#pragma unroll
    for (int kt = 0; kt < 4; ++kt)
#pragma unroll
        for (int e = 0; e < 16; ++e) { const float p = fexp2(st[kt][e] - mn); st[kt][e] = p; ps += p; }
    ps = pg8::xor32_sum(ps);
    l = l * alpha + ps;
#pragma unroll
    for (int dt = 0; dt < 4; ++dt) o[dt] = o[dt] * alpha;
    bf16x8 pf[4][2];
#pragma unroll
    for (int kt = 0; kt < 4; ++kt)
#pragma unroll
        for (int sg = 0; sg < 2; ++sg) { v4u w; w.x = pk2(st[kt][8 * sg + 0], st[kt][8 * sg + 1]); w.y = pk2(st[kt][8 * sg + 2], st[kt][8 * sg + 3]);
            w.z = pk2(st[kt][8 * sg + 4], st[kt][8 * sg + 5]); w.w = pk2(st[kt][8 * sg + 6], st[kt][8 * sg + 7]); pf[kt][sg] = as_bf16x8(w); }
#pragma unroll
    for (int b0 = 1; b0 < 2; ++b0)
#pragma unroll
        for (int i = 0; i < 4; ++i) { const int ii = b0 * 4 + i; const LAS unsigned char* vp = Vc + r * VSB + ((ii >> 1) * 32 + 16 * (ii & 1) + 4 * h) * 2; vlo[b0][i] = *(const LAS v2u*)vp; vhi[b0][i] = *(const LAS v2u*)(vp + 16); }
#pragma unroll
    for (int hb = 0; hb < 8; ++hb) { const int dt = hb >> 1, i0 = (hb & 1) * 4;
        if (hb < 6) { const int dn = (hb + 2) >> 1, in0 = ((hb + 2) & 1) * 4;
#pragma unroll
            for (int i = 0; i < 4; ++i) { const int ii = in0 + i; const LAS unsigned char* vp = Vc + (dn * 32 + r) * VSB + ((ii >> 1) * 32 + 16 * (ii & 1) + 4 * h) * 2; vlo[(hb + 2) % 3][i] = *(const LAS v2u*)vp; vhi[(hb + 2) % 3][i] = *(const LAS v2u*)(vp + 16); } }
        __builtin_amdgcn_sched_barrier(0);
#pragma unroll
        for (int i = 0; i < 4; ++i) { const int ii = i0 + i; o[dt] = MFMA32(as_bf16x8((v4u){vlo[hb % 3][i].x, vlo[hb % 3][i].y, vhi[hb % 3][i].x, vhi[hb % 3][i].y}), pf[ii >> 1][ii & 1], o[dt]); }
        __builtin_amdgcn_sched_barrier(0);
    }
}
__device__ __forceinline__ void store_ot_bf16(const f32x16 (&o)[4], float inv, bf16* orow, int h) {
#pragma unroll
    for (int dt = 0; dt < 4; ++dt)
#pragma unroll
        for (int a = 0; a < 4; ++a) { v2u w; w.x = pk2(o[dt][4 * a] * inv, o[dt][4 * a + 1] * inv); w.y = pk2(o[dt][4 * a + 2] * inv, o[dt][4 * a + 3] * inv);
            *(v2u*)(orow + 32 * dt + 8 * a + 4 * h) = w; }
}

__device__ __forceinline__ void store_ot_private(const f32x16 (&o)[4], float inv, bf16* prow, int h) {
#pragma unroll
    for (int dt = 0; dt < 4; ++dt)
#pragma unroll
        for (int hh = 0; hh < 2; ++hh) { v4u w; w.x = pk2(o[dt][8 * hh] * inv, o[dt][8 * hh + 1] * inv); w.y = pk2(o[dt][8 * hh + 2] * inv, o[dt][8 * hh + 3] * inv); w.z = pk2(o[dt][8 * hh + 4] * inv, o[dt][8 * hh + 5] * inv); w.w = pk2(o[dt][8 * hh + 6] * inv, o[dt][8 * hh + 7] * inv);
            *(v4u*)(prow + h * 64 + dt * 16 + hh * 8) = w; }
}
__device__ __forceinline__ void mem_attn_unit(LAS unsigned char* lds, bf16* PM, const bf16* KMl, const bf16* VMTl, int u, int tid_in) {
    int tid = tid_in; asm volatile("" : "+v"(tid));
    const int wave = __builtin_amdgcn_readfirstlane(tid >> 6), lane = tid & 63, r = lane & 31, h = lane >> 5;
    const int qb = u & 63, mh = (u >> 6) & 3, b = u >> 8;
    bf16* qrow = PM + (size_t)(b * T + qb * 256 + wave * 32 + r) * NMAIN + CQM + mh * 128;
    bf16x8 qf[8]; load_qfrags(qf, qrow, h);
    fill_kv_tiles(lds, KMl + (size_t)(b * 256) * 512 + mh * 128, 512, VMTl + (size_t)(mh * 128) * 512 + b * 256, 512, tid);
    LDS_WAIT(); __syncthreads();
    f32x16 o[4]; float m = -1e30f, l = 0.f;
#pragma unroll
    for (int dt = 0; dt < 4; ++dt)
#pragma unroll
        for (int e = 0; e < 16; ++e) o[dt][e] = 0.f;
#pragma unroll 1
    for (int c = 0; c < 2; ++c) attn_chunk<false, false>(lds + KS_OFF + c * 128 * KSB, lds + VS_OFF + c * 256, qf, o, m, l, 0, 0.f, r, h);
    store_ot_bf16(o, __builtin_amdgcn_rcpf(l), qrow, h);
    __syncthreads();
}

#define TOP3_INS(v, j) do { if ((v) > v2) { if ((v) > v1) { v2 = v1; i2 = i1; if ((v) > v0) { v1 = v0; i1 = i0; v0 = (v); i0 = (j); } else { v1 = (v); i1 = (j); } } else { v2 = (v); i2 = (j); } } } while (0)
#define TOP3_INS_TIE(v, j) do { if ((v) > v2 || ((v) == v2 && (j) < i2)) { if ((v) > v1 || ((v) == v1 && (j) < i1)) { v2 = v1; i2 = i1; if ((v) > v0 || ((v) == v0 && (j) < i0)) { v1 = v0; i1 = i0; v0 = (v); i0 = (j); } else { v1 = (v); i1 = (j); } } else { v2 = (v); i2 = (j); } } } while (0)
struct SelPre { f32x4 ka[2], kc[2]; bf16x8 qf[8]; };
__device__ __forceinline__ void moba_sel_load(const bf16* PM, const float* kml, int u, int tid, SelPre& P) {
    const int wave = __builtin_amdgcn_readfirstlane(tid >> 6), lane = tid & 63, r = lane & 31, h = lane >> 5;
    const int blk = u & 63, bh = u >> 6, b = bh >> 3, hd = bh & 7;
    if (blk == 0) return;
    const int t = blk * 256 + wave * 32 + r;
#pragma unroll
    for (int k = 0; k < 2; ++k) { const int it = tid + k * NWAVES * 64, j = it >> 4, d8 = (it & 15) * 8; P.ka[k] = *(const f32x4*)(kml + ((size_t)bh * 64 + j) * 128 + d8); P.kc[k] = *(const f32x4*)(kml + ((size_t)bh * 64 + j) * 128 + d8 + 4); }
    load_qfrags(P.qf, PM + (size_t)(b * T + t) * NMAIN + CQA + hd * 128, h);
}
__device__ __forceinline__ void moba_sel_unit(LAS unsigned char* lds, unsigned* SEL, int u, int tid, const SelPre& P) {
    const int wave = __builtin_amdgcn_readfirstlane(tid >> 6), lane = tid & 63, r = lane & 31, h = lane >> 5;
    const int blk = u & 63, bh = u >> 6;
    const int t = blk * 256 + wave * 32 + r;
    if (blk == 0) { if (h == 0) SEL[(size_t)bh * T + t] = 0x00ffffffu; return; }
    LAS unsigned char* KH = lds, * KL = lds + 64 * KSB;
#pragma unroll
    for (int k = 0; k < 2; ++k) { const int it = tid + k * NWAVES * 64, j = it >> 4, d8 = (it & 15) * 8;
        const f32x4 a = P.ka[k], c = P.kc[k];
        float x[8] = {a.x, a.y, a.z, a.w, c.x, c.y, c.z, c.w}; unsigned hp[4], lp[4];
#pragma unroll
        for (int e = 0; e < 8; ++e) x[e] *= (1.f / 256.f);
#pragma unroll
        for (int e = 0; e < 4; ++e) { hp[e] = pk2(x[2 * e], x[2 * e + 1]); lp[e] = pk2(x[2 * e] - bflo(hp[e]), x[2 * e + 1] - bfhi(hp[e])); }
        LAS v2u* dh = (LAS v2u*)(KH + j * KSB + d8 * 2); LAS v2u* dl = (LAS v2u*)(KL + j * KSB + d8 * 2);
        dh[0] = (v2u){hp[0], hp[1]}; dh[1] = (v2u){hp[2], hp[3]};
        dl[0] = (v2u){lp[0], lp[1]}; dl[1] = (v2u){lp[2], lp[3]}; }
    const bf16x8 (&qf)[8] = P.qf;
    LDS_WAIT(); __syncthreads();
    f32x16 st[2];
#pragma unroll
    for (int jt = 0; jt < 2; ++jt) {
#pragma unroll
        for (int e = 0; e < 16; ++e) st[jt][e] = 0.f;
#pragma unroll
        for (int s = 0; s < 8; ++s) { const bf16x8 kh = *(const LAS bf16x8*)(KH + (jt * 32 + r) * KSB + s * 32 + h * 16), kl = *(const LAS bf16x8*)(KL + (jt * 32 + r) * KSB + s * 32 + h * 16);
            st[jt] = MFMA32(kh, qf[s], st[jt]); st[jt] = MFMA32(kl, qf[s], st[jt]); }
    }
    float v0 = -3e38f, v1 = -3e38f, v2 = -3e38f; int i0 = 255, i1 = 255, i2 = 255;
#pragma unroll
    for (int jt = 0; jt < 2; ++jt)
#pragma unroll
        for (int e = 0; e < 16; ++e) { const int j = jt * 32 + (e & 3) + 8 * (e >> 2) + 4 * h; const float v = (j < blk) ? st[jt][e] : -3e38f; TOP3_INS(v, j); }
    const float p0 = __builtin_bit_cast(float, pg8::xor32_other(__builtin_bit_cast(unsigned, v0), h)), p1 = __builtin_bit_cast(float, pg8::xor32_other(__builtin_bit_cast(unsigned, v1), h)), p2 = __builtin_bit_cast(float, pg8::xor32_other(__builtin_bit_cast(unsigned, v2), h));
    const int q0 = (int)pg8::xor32_other((unsigned)i0, h), q1 = (int)pg8::xor32_other((unsigned)i1, h), q2 = (int)pg8::xor32_other((unsigned)i2, h);
    if (q0 != 255) TOP3_INS_TIE(p0, q0);
    if (q1 != 255) TOP3_INS_TIE(p1, q1);
    if (q2 != 255) TOP3_INS_TIE(p2, q2);
    if (h == 0) SEL[(size_t)bh * T + t] = (unsigned)i0 | ((unsigned)i1 << 8) | ((unsigned)i2 << 16);
    __syncthreads();
}
__device__ __forceinline__ void moba_partial_task(LAS unsigned char* lds, const bf16* PM, const bf16* VT, const unsigned* SEL, bf16* PO, float* ML, int bh, int j, int tid_in) {
    int tid = tid_in; asm volatile("" : "+v"(tid));
    const int wave = __builtin_amdgcn_readfirstlane(tid >> 6), lane = tid & 63, r = lane & 31, h = lane >> 5;
    const int b = bh >> 3, hd = bh & 7;
    const bf16* kg = PM + (size_t)(b * T + 256 * j) * NMAIN + CKA + hd * 128; const bf16* vg = VT + (size_t)(hd * 128) * M + b * T + 256 * j;
    fill_kv_tiles(lds, kg, NMAIN, vg, M, tid);
    LAS unsigned short* list = (LAS unsigned short*)(lds + LIST_OFF); LAS unsigned* wcnt = (LAS unsigned*)(lds + WCNT_OFF);
    const float slope_l2 = 1.4426950408889634f * __builtin_amdgcn_exp2f(-(float)(hd + 1));
#pragma unroll 1
    for (int t_beg = 256 * (j + 1); t_beg < T; t_beg += 8192) {
        const int t_end = (t_beg + 8192 < T) ? t_beg + 8192 : T;
        unsigned slots0 = 0u, slots1 = 0u; int tot = 0; unsigned wsel[16];
#pragma unroll
        for (int it = 0; it < 16; ++it) { const int t = t_beg + wave * 1024 + it * 64 + lane; wsel[it] = SEL[(size_t)bh * T + (t < t_end ? t : t_end - 1)]; }
#pragma unroll
        for (int it = 0; it < 16; ++it) { const int t = t_beg + wave * 1024 + it * 64 + lane; const unsigned w = (t < t_end) ? wsel[it] : 0x00ffffffu;
            const unsigned sl = ((w & 255u) == (unsigned)j) ? 1u : (((w >> 8) & 255u) == (unsigned)j) ? 2u : (((w >> 16) & 255u) == (unsigned)j) ? 3u : 0u;
            if (it < 8) slots0 |= sl << (4 * it); else slots1 |= sl << (4 * (it - 8)); tot += __builtin_popcountll(__ballot(sl != 0u)); }
        if (lane == 0) wcnt[wave] = (unsigned)tot;
        LDS_WAIT(); __syncthreads();
        int off = 0, n = 0;
#pragma unroll
        for (int w = 0; w < NWAVES; ++w) { const int c = (int)wcnt[w]; off += (w < wave) ? c : 0; n += c; }
#pragma unroll
        for (int it = 0; it < 16; ++it) { const unsigned sl = ((it < 8 ? slots0 : slots1) >> (4 * (it & 7))) & 15u; const unsigned long long bal = __ballot(sl != 0u);
            if (sl != 0u) list[off + __builtin_popcountll(bal & ((1ull << lane) - 1ull))] = (unsigned short)((wave * 1024 + it * 64 + lane) | ((sl - 1u) << 13));
            off += __builtin_popcountll(bal); }
        LDS_WAIT(); __syncthreads();
        const int ngroups = (n + 31) >> 5;
        bf16x8 qf[8]; unsigned e = 0u;
        if (wave < ngroups) { const int idx0 = wave * 32 + r; e = list[idx0 < n ? idx0 : n - 1]; load_qfrags(qf, PM + (size_t)(b * T + t_beg + (int)(e & 8191u)) * NMAIN + CQA + hd * 128, h); }
        for (int g = wave; g < ngroups; g += NWAVES) {
            const int idx = g * 32 + r;
            const int t = t_beg + (int)(e & 8191u), slot = (int)(e >> 13);
            unsigned en = 0u; const bool more = (g + NWAVES) < ngroups; const bf16* qnext = nullptr;
            if (more) { const int idn = (g + NWAVES) * 32 + r; en = list[idn < n ? idn : n - 1]; qnext = PM + (size_t)(b * T + t_beg + (int)(en & 8191u)) * NMAIN + CQA + hd * 128; }
            f32x16 o[4]; float m = -1e30f, l = 0.f;
#pragma unroll
            for (int dt = 0; dt < 4; ++dt)
#pragma unroll
                for (int q = 0; q < 16; ++q) o[dt][q] = 0.f;
#pragma unroll 1
            for (int c = 0; c < 2; ++c) attn_chunk<true, false>(lds + KS_OFF + c * 128 * KSB, lds + VS_OFF + c * 256, qf, o, m, l, t - 256 * j - 128 * c, slope_l2, r, h, c == 1 ? qnext : nullptr);
            if (idx < n) { const size_t pi = ((size_t)bh * T + t) * 3 + slot;
                store_ot_private(o, __builtin_amdgcn_rcpf(l), PO + pi * 128, h);
                if (h == 0) { ML[pi * 2] = m; ML[pi * 2 + 1] = l; } }
            e = en;
        }
        __syncthreads();
    }
}
__device__ __forceinline__ void moba_own_unit(LAS unsigned char* lds, bf16* PM, const bf16* VT, const unsigned* SEL, const bf16* PO, const float* ML, int u, int tid_in) {
    int tid = tid_in; asm volatile("" : "+v"(tid));
    const int wave = __builtin_amdgcn_readfirstlane(tid >> 6), lane = tid & 63, r = lane & 31, h = lane >> 5;
    const int blk = u & 63, bh = u >> 6, b = bh >> 3, hd = bh & 7;
    const int tl = wave * 32 + r, t = blk * 256 + tl;
    bf16* qrow = PM + (size_t)(b * T + t) * NMAIN + CQA + hd * 128;
    const unsigned selw = SEL[(size_t)bh * T + t];
    const size_t pi0 = ((size_t)bh * T + t) * 3;
    float mlr[6];
#pragma unroll
    for (int k = 0; k < 6; ++k) mlr[k] = ML[pi0 * 2 + k];
    bf16x8 qf[8]; load_qfrags(qf, qrow, h);
    fill_kv_tiles(lds, PM + (size_t)(b * T + 256 * blk) * NMAIN + CKA + hd * 128, NMAIN, VT + (size_t)(hd * 128) * M + b * T + 256 * blk, M, tid);
    LDS_WAIT(); __syncthreads();
    const float slope_l2 = 1.4426950408889634f * __builtin_amdgcn_exp2f(-(float)(hd + 1));
    f32x16 o[4]; float m = -1e30f, l = 0.f;
#pragma unroll
    for (int dt = 0; dt < 4; ++dt)
#pragma unroll
        for (int q = 0; q < 16; ++q) o[dt][q] = 0.f;
    const int nch = (wave < 4) ? 1 : 2;
#pragma unroll 1
    for (int c = 0; c < nch; ++c) attn_chunk<true, true>(lds + KS_OFF + c * 128 * KSB, lds + VS_OFF + c * 256, qf, o, m, l, tl - 128 * c, slope_l2, r, h);
    v4u pw[3][4][2];
#pragma unroll
    for (int k = 0; k < 3; ++k) { const bool ok = ((selw >> (8 * k)) & 255u) != 255u; const bf16* pr = PO + (pi0 + (ok ? k : 0)) * 128 + h * 64;
#pragma unroll
        for (int dt = 0; dt < 4; ++dt)
#pragma unroll
            for (int hh = 0; hh < 2; ++hh) { const v4u w = *(const v4u*)(pr + dt * 16 + hh * 8); pw[k][dt][hh] = ok ? w : (v4u){0u, 0u, 0u, 0u}; } }
    float mk[3], lk[3]; float mm = m;
#pragma unroll
    for (int k = 0; k < 3; ++k) { const bool ok = ((selw >> (8 * k)) & 255u) != 255u; mk[k] = ok ? mlr[2 * k] : -1e30f; lk[k] = ok ? mlr[2 * k + 1] : 0.f; mm = fmaxf(mm, mk[k]); }
    const float wo = fexp2(m - mm); float den = l * wo;
#pragma unroll
    for (int dt = 0; dt < 4; ++dt) o[dt] = o[dt] * wo;
#pragma unroll
    for (int k = 0; k < 3; ++k) { const bool ok = ((selw >> (8 * k)) & 255u) != 255u; const float wk = lk[k] * fexp2(mk[k] - mm); den += wk;
#pragma unroll
        for (int dt = 0; dt < 4; ++dt)
#pragma unroll
            for (int hh = 0; hh < 2; ++hh) { const v4u w = pw[k][dt][hh]; const float wv = ok ? wk : 0.f;
                o[dt][8 * hh] += wv * bflo(w.x); o[dt][8 * hh + 1] += wv * bfhi(w.x); o[dt][8 * hh + 2] += wv * bflo(w.y); o[dt][8 * hh + 3] += wv * bfhi(w.y);
                o[dt][8 * hh + 4] += wv * bflo(w.z); o[dt][8 * hh + 5] += wv * bfhi(w.z); o[dt][8 * hh + 6] += wv * bflo(w.w); o[dt][8 * hh + 7] += wv * bfhi(w.w); } }
    store_ot_bf16(o, __builtin_amdgcn_rcpf(den), qrow, h);
    __syncthreads();
}
constexpr int HG_G = 0, HG_TOT = 32768, HG_LB = 34816, HG_KT = 36864, HG_KK1 = 55296, HG_QS = 36864, HG_QG = 54272, HG_KD = 71680, HG_KO = 89088, HG_SS = 97792, HG_KK3 = 98816, KTSB = 144;
__device__ __forceinline__ void hgrn_lb_table(LAS unsigned char* lds, const float* lbl  , int layer, int tid) {
    float lb = 0.f; if (layer > 0) lb = fsigmoid(lbl[512 + tid] - lbl[tid]);
    ((LAS float*)(lds + HG_LB))[tid] = lb;
    LDS_WAIT(); __syncthreads();
}
__device__ __forceinline__ void hgrn_gates(LAS unsigned char* lds, int kk_off, const v4u (&fbr)[2], int hh, int tid) {
    LAS float* G = (LAS float*)(lds + HG_G); LAS float* TOT = (LAS float*)(lds + HG_TOT); LAS float* LB = (LAS float*)(lds + HG_LB) + hh * 128; LAS float* KK = (LAS float*)(lds + kk_off);
#pragma unroll
    for (int it = 0; it < 2; ++it) { const int item = tid + it * 512, s = item >> 4, d8 = (item & 15) * 8;
        const unsigned fw[4] = {fbr[it].x, fbr[it].y, fbr[it].z, fbr[it].w}; float lg[8], kv[8];
        const f32x4 lbA = *(const LAS f32x4*)(LB + d8), lbB = *(const LAS f32x4*)(LB + d8 + 4); const float lb8[8] = {lbA.x, lbA.y, lbA.z, lbA.w, lbB.x, lbB.y, lbB.z, lbB.w};
#pragma unroll
        for (int e = 0; e < 8; ++e) { const float x = (e & 1) ? bfhi(fw[e >> 1]) : bflo(fw[e >> 1]); const float lb = lb8[e];
            const float ex = __builtin_amdgcn_exp2f(-1.4426950408889634f * x);
            const float sg = __builtin_amdgcn_rcpf(1.f + ex);
            const float fg = lb + (1.f - lb) * sg; lg[e] = 0.6931471805599453f * __builtin_amdgcn_logf(fmaxf(fg, 1e-20f)); kv[e] = (1.f - lb) * (ex < 1e30f ? ex * sg : 1.f); }
        *(LAS f32x4*)(G + s * 128 + d8) = (f32x4){lg[0], lg[1], lg[2], lg[3]}; *(LAS f32x4*)(G + s * 128 + d8 + 4) = (f32x4){lg[4], lg[5], lg[6], lg[7]};
        *(LAS f32x4*)(KK + s * 128 + d8) = (f32x4){kv[0], kv[1], kv[2], kv[3]}; *(LAS f32x4*)(KK + s * 128 + d8 + 4) = (f32x4){kv[4], kv[5], kv[6], kv[7]}; }
    LDS_WAIT(); __syncthreads();
    { const int d = tid & 127, q = tid >> 7; float gv[16];
#pragma unroll
        for (int s = 0; s < 16; ++s) gv[s] = G[(16 * q + s) * 128 + d];
        float run = 0.f;
#pragma unroll
        for (int s = 0; s < 16; ++s) { run += gv[s]; G[(16 * q + s) * 128 + d] = run; }
        TOT[q * 128 + d] = run; }
    LDS_WAIT(); __syncthreads();
}
__device__ __forceinline__ void hgrn_local_load(const bf16* PM, const bf16* VT, int u, int tid_in, v4u (&fbr)[2], bf16x8 (&va)[4]) {
    int tid = tid_in; asm volatile("" : "+v"(tid));
    const int wave = __builtin_amdgcn_readfirstlane(tid >> 6), lane = tid & 63, r = lane & 31, h = lane >> 5;
    const int c = u & 255, bh = u >> 8, b = bh >> 2, hh = bh & 3;
    const size_t row0 = (size_t)b * T + (size_t)c * 64;
    const int dvt = wave >> 1;
#pragma unroll
    for (int it = 0; it < 2; ++it) { const int item = tid + it * 512; fbr[it] = *(const v4u*)(PM + (row0 + (item >> 4)) * NMAIN + CFB + hh * 128 + (item & 15) * 8); }
    const bf16* vrow = VT + (size_t)(1024 + hh * 128 + dvt * 32 + r) * M + row0;
#pragma unroll
    for (int sg = 0; sg < 4; ++sg) va[sg] = *(const bf16x8*)(vrow + 16 * sg + 8 * h);
}
__device__ __forceinline__ void hgrn_local_unit(LAS unsigned char* lds, bf16* ST, float* DEC, int u, int tid_in, const v4u (&fbr)[2], const bf16x8 (&va)[4]) {
    int tid = tid_in; asm volatile("" : "+v"(tid));
    const int wave = __builtin_amdgcn_readfirstlane(tid >> 6), lane = tid & 63, r = lane & 31, h = lane >> 5;
    const int c = u & 255, bh = u >> 8, hh = bh & 3;
    const int dvt = wave >> 1, dk0 = 2 * (wave & 1);
    hgrn_gates(lds, HG_KK1, fbr, hh, tid);
    LAS float* G = (LAS float*)(lds + HG_G); LAS float* TOT = (LAS float*)(lds + HG_TOT); LAS float* KK = (LAS float*)(lds + HG_KK1);
#pragma unroll
    for (int it = 0; it < 2; ++it) { const int item = tid + it * 512, d = item & 127, s8 = (item >> 7) * 8;
        const float t0 = TOT[d], t1 = TOT[128 + d], t2 = TOT[256 + d], t3 = TOT[384 + d], glast = ((t0 + t1) + t2) + t3;
        const float pre = (s8 >= 48) ? ((t0 + t1) + t2) : (s8 >= 32) ? (t0 + t1) : (s8 >= 16) ? t0 : 0.f;
        float kb[8];
#pragma unroll
        for (int e = 0; e < 8; ++e) kb[e] = KK[(s8 + e) * 128 + d] * fexp(glast - (G[(s8 + e) * 128 + d] + pre));
        *(LAS v4u*)(lds + HG_KT + d * KTSB + s8 * 2) = (v4u){pk2(kb[0], kb[1]), pk2(kb[2], kb[3]), pk2(kb[4], kb[5]), pk2(kb[6], kb[7])};
        if (s8 == 0) DEC[((size_t)bh * 256 + c) * 128 + d] = fexp(glast); }
    LDS_WAIT(); __syncthreads();
    f32x16 acc[2];
#pragma unroll
    for (int e = 0; e < 2; ++e)
#pragma unroll
        for (int q = 0; q < 16; ++q) acc[e][q] = 0.f;
#pragma unroll
    for (int sg = 0; sg < 4; ++sg) {
#pragma unroll
        for (int e = 0; e < 2; ++e) { const bf16x8 bb = *(const LAS bf16x8*)(lds + HG_KT + ((dk0 + e) * 32 + r) * KTSB + (16 * sg + 8 * h) * 2); acc[e] = MFMA32(va[sg], bb, acc[e]); } }
    bf16* stb = ST + ((size_t)bh * 256 + c) * 16384;
#pragma unroll
    for (int e = 0; e < 2; ++e)
#pragma unroll
        for (int q = 0; q < 16; ++q) stb[(size_t)(dvt * 32 + (q & 3) + 8 * (q >> 2) + 4 * h) * 128 + (dk0 + e) * 32 + r] = (bf16)f2bf(acc[e][q]);
    __syncthreads();
}
__device__ __forceinline__ void hgrn_scan(bf16* ST, const float* DEC, int vcu, int G, int tid) {
    for (int e = vcu * 512 + tid; e < 8 * 16384; e += G * 512) { const int bh = e >> 14, rem = e & 16383, dk = e & 127;
        bf16* sp = ST + (size_t)bh * 256 * 16384 + rem; const float* dp = DEC + (size_t)bh * 256 * 128 + dk; float S = 0.f;
#pragma unroll 1
        for (int c0 = 0; c0 < 256; c0 += 32) { float L[32], dc[32];
#pragma unroll
            for (int i = 0; i < 32; ++i) { L[i] = bf2f(sp[(size_t)(c0 + i) * 16384]); dc[i] = dp[(c0 + i) * 128]; }
#pragma unroll
            for (int i = 0; i < 32; ++i) { sp[(size_t)(c0 + i) * 16384] = (bf16)f2bf(S); S = dc[i] * S + L[i]; } } }
}
struct HoutPre { v4u fbr[2], qbr[2]; bf16x8 sa[8]; v2u vlo[2][2], vhi[2][2]; v2u gbr[4]; f32x4 gn[4]; };
__device__ __forceinline__ void hgrn_out_load(const bf16* PM, const bf16* VT, const bf16* ST, const float* gain, int u, int tid_in, HoutPre& P) {
    int tid = tid_in; asm volatile("" : "+v"(tid));
    const int wave = __builtin_amdgcn_readfirstlane(tid >> 6), lane = tid & 63, r = lane & 31, h = lane >> 5;
    const int c = u & 255, bh = u >> 8, b = bh >> 2, hh = bh & 3;
    const size_t row0 = (size_t)b * T + (size_t)c * 64;
    const int dvt = wave & 3, tt = wave >> 2;
#pragma unroll
    for (int it = 0; it < 2; ++it) { const int item = tid + it * 512; const bf16* p = PM + (row0 + (item >> 4)) * NMAIN + hh * 128 + (item & 15) * 8; P.fbr[it] = *(const v4u*)(p + CFB); P.qbr[it] = *(const v4u*)(p + CQB); }
    { const bf16* srow = ST + ((size_t)bh * 256 + c) * 16384 + (size_t)(dvt * 32 + r) * 128;
#pragma unroll
      for (int sg = 0; sg < 8; ++sg) P.sa[sg] = *(const bf16x8*)(srow + 16 * sg + 8 * h); }
    const bf16* vrow = VT + (size_t)(1024 + hh * 128 + dvt * 32 + r) * M + row0;
#pragma unroll
    for (int st = 0; st < 2; ++st)
#pragma unroll
        for (int sg = 0; sg < 2; ++sg) { P.vlo[st][sg] = *(const v2u*)(vrow + st * 32 + 16 * sg + 4 * h); P.vhi[st][sg] = *(const v2u*)(vrow + st * 32 + 16 * sg + 8 + 4 * h); }
    const bf16* orow = PM + (row0 + tt * 32 + r) * NMAIN;
#pragma unroll
    for (int a = 0; a < 4; ++a) { P.gbr[a] = *(const v2u*)(orow + CGB + hh * 128 + dvt * 32 + 8 * a + 4 * h); P.gn[a] = *(const f32x4*)(gain + dvt * 32 + 8 * a + 4 * h); }
}
__device__ __forceinline__ void hgrn_out_unit(LAS unsigned char* lds, bf16* PM, const float* gain  , int u, int tid_in, const HoutPre& P) {
    int tid = tid_in; asm volatile("" : "+v"(tid));
    const int wave = __builtin_amdgcn_readfirstlane(tid >> 6), lane = tid & 63, r = lane & 31, h = lane >> 5;
    const int c = u & 255, bh = u >> 8, b = bh >> 2, hh = bh & 3;
    const size_t row0 = (size_t)b * T + (size_t)c * 64;
    const int dvt = wave & 3, tt = wave >> 2;
    const v4u (&fbr)[2] = P.fbr; const v4u (&qbr)[2] = P.qbr; const bf16x8 (&sa)[8] = P.sa; const v2u (&vlo)[2][2] = P.vlo; const v2u (&vhi)[2][2] = P.vhi; const v2u (&gbr)[4] = P.gbr;
    bf16* orow = PM + (row0 + tt * 32 + r) * NMAIN;
    hgrn_gates(lds, HG_KK3, fbr, hh, tid);
    LAS float* G = (LAS float*)(lds + HG_G); LAS float* TOT = (LAS float*)(lds + HG_TOT); LAS float* KK = (LAS float*)(lds + HG_KK3);
#pragma unroll
    for (int it = 0; it < 2; ++it) { const int item = tid + it * 512, s = item >> 4, d8 = (item & 15) * 8;
        const unsigned qw[4] = {qbr[it].x, qbr[it].y, qbr[it].z, qbr[it].w}; float qs[8], qg[8], kd[8], ko[8];
        const f32x4 kA = *(const LAS f32x4*)(KK + s * 128 + d8), kB = *(const LAS f32x4*)(KK + s * 128 + d8 + 4), gA = *(const LAS f32x4*)(G + s * 128 + d8), gB = *(const LAS f32x4*)(G + s * 128 + d8 + 4);
        const f32x4 t0A = *(const LAS f32x4*)(TOT + d8), t0B = *(const LAS f32x4*)(TOT + d8 + 4), t1A = *(const LAS f32x4*)(TOT + 128 + d8), t1B = *(const LAS f32x4*)(TOT + 128 + d8 + 4), t2A = *(const LAS f32x4*)(TOT + 256 + d8), t2B = *(const LAS f32x4*)(TOT + 256 + d8 + 4);
        const float k8[8] = {kA.x, kA.y, kA.z, kA.w, kB.x, kB.y, kB.z, kB.w}, g8[8] = {gA.x, gA.y, gA.z, gA.w, gB.x, gB.y, gB.z, gB.w};
        const float u0[8] = {t0A.x, t0A.y, t0A.z, t0A.w, t0B.x, t0B.y, t0B.z, t0B.w}, u1[8] = {t1A.x, t1A.y, t1A.z, t1A.w, t1B.x, t1B.y, t1B.z, t1B.w}, u2[8] = {t2A.x, t2A.y, t2A.z, t2A.w, t2B.x, t2B.y, t2B.z, t2B.w};
        const bool s16 = s >= 16, s32 = s >= 32, s48 = s >= 48;
#pragma unroll
        for (int e = 0; e < 8; ++e) { const float qv = (e & 1) ? bfhi(qw[e >> 1]) : bflo(qw[e >> 1]);
            const float k = k8[e], g31 = u0[e] + u1[e];
            const float pre = s48 ? (g31 + u2[e]) : s32 ? g31 : s16 ? u0[e] : 0.f;
            const float gs = g8[e] + pre, gref = s32 ? g31 : 0.f;
            qs[e] = qv * fexp(gs - gref); qg[e] = qv * fexp(gs); kd[e] = k * fexp(fminf(gref - gs, 80.f)); ko[e] = k * fexp(fminf(g31 - gs, 0.f)); }
        *(LAS v4u*)(lds + HG_QS + s * KSB + d8 * 2) = (v4u){pk2(qs[0], qs[1]), pk2(qs[2], qs[3]), pk2(qs[4], qs[5]), pk2(qs[6], qs[7])};
        *(LAS v4u*)(lds + HG_QG + s * KSB + d8 * 2) = (v4u){pk2(qg[0], qg[1]), pk2(qg[2], qg[3]), pk2(qg[4], qg[5]), pk2(qg[6], qg[7])};
        *(LAS v4u*)(lds + HG_KD + s * KSB + d8 * 2) = (v4u){pk2(kd[0], kd[1]), pk2(kd[2], kd[3]), pk2(kd[4], kd[5]), pk2(kd[6], kd[7])};
        if (s < 32) *(LAS v4u*)(lds + HG_KO + s * KSB + d8 * 2) = (v4u){pk2(ko[0], ko[1]), pk2(ko[2], ko[3]), pk2(ko[4], ko[5]), pk2(ko[6], ko[7])}; }
    LDS_WAIT(); __syncthreads();
    f32x16 o;
#pragma unroll
    for (int q = 0; q < 16; ++q) o[q] = 0.f;
#pragma unroll
    for (int sg = 0; sg < 8; ++sg) { const bf16x8 bb = *(const LAS bf16x8*)(lds + HG_QG + (tt * 32 + r) * KSB + (16 * sg + 8 * h) * 2); o = MFMA32(sa[sg], bb, o); }
#pragma unroll
    for (int st = 0; st < 2; ++st) if (st <= tt) {
        f32x16 at;
#pragma unroll
        for (int q = 0; q < 16; ++q) at[q] = 0.f;
        const LAS unsigned char* kbase = (st == tt) ? (lds + HG_KD + (st * 32 + r) * KSB) : (lds + HG_KO + r * KSB);
#pragma unroll
        for (int sg = 0; sg < 8; ++sg) { const bf16x8 a = *(const LAS bf16x8*)(kbase + (16 * sg + 8 * h) * 2), bb = *(const LAS bf16x8*)(lds + HG_QS + (tt * 32 + r) * KSB + (16 * sg + 8 * h) * 2);
            at = MFMA32(a, bb, at); }
        if (st == tt) {
#pragma unroll
            for (int q = 0; q < 16; ++q) at[q] = ((q & 3) + 8 * (q >> 2) + 4 * h <= r) ? at[q] : 0.f; }
#pragma unroll
        for (int sg = 0; sg < 2; ++sg) { const v4u pw = {pk2(at[8 * sg], at[8 * sg + 1]), pk2(at[8 * sg + 2], at[8 * sg + 3]), pk2(at[8 * sg + 4], at[8 * sg + 5]), pk2(at[8 * sg + 6], at[8 * sg + 7])};
            o = MFMA32(as_bf16x8((v4u){vlo[st][sg].x, vlo[st][sg].y, vhi[st][sg].x, vhi[st][sg].y}), as_bf16x8(pw), o); }
    }
    LAS float* SS = (LAS float*)(lds + HG_SS);
    float ss = 0.f;
#pragma unroll
    for (int q = 0; q < 16; ++q) ss += o[q] * o[q];
    ss = pg8::xor32_sum(ss);
    if (h == 0) SS[(tt * 4 + dvt) * 32 + r] = ss;
    LDS_WAIT(); __syncthreads();
    const float tot = (SS[(tt * 4 + 0) * 32 + r] + SS[(tt * 4 + 1) * 32 + r]) + (SS[(tt * 4 + 2) * 32 + r] + SS[(tt * 4 + 3) * 32 + r]);
    const float rr = __builtin_amdgcn_rsqf(tot * (1.f / 128.f) + RMS_EPS);
#pragma unroll
    for (int a = 0; a < 4; ++a) { const int dv0 = dvt * 32 + 8 * a + 4 * h; const f32x4 gn = P.gn[a]; const v2u gb = gbr[a];
        v2u w; w.x = pk2(o[4 * a] * rr * gn.x * bflo(gb.x), o[4 * a + 1] * rr * gn.y * bfhi(gb.x)); w.y = pk2(o[4 * a + 2] * rr * gn.z * bflo(gb.y), o[4 * a + 3] * rr * gn.w * bfhi(gb.y));
        *(v2u*)(orow + CQB + hh * 128 + dv0) = w; }
    __syncthreads();
}
struct Args { const float* in[21]; float* out; unsigned char* ws; int ph_lo, ph_hi; };
enum { IN_X = 0, IN_MEM, IN_F1N, IN_F1W1, IN_F1W3, IN_F1W2, IN_MIXN, IN_WIN, IN_LB, IN_HON, IN_MEMN, IN_WKV, IN_WPA, IN_WPB, IN_WPM, IN_WOUT, IN_F2N, IN_F2W1, IN_F2W3, IN_F2W2, IN_FINN };
constexpr int PH_PER_LAYER = 14, PH_FINAL = DEPTH * PH_PER_LAYER, PH_TOTAL = PH_FINAL + 1;
#ifndef DIS_GEMM
#define GEMM_PHASE(EPI, g, S, E) pg8::gemm_phase<EPI, pg8::StaticOrder, true, true>(lds + RING_OFF, g, S, E)
#else
#define GEMM_PHASE(EPI, g, S, E) do { (void)g; (void)S; (void)E; } while (0)
#endif
#ifdef DIS_G_SWIGLU
#define GEMM_PHASE_SWIGLU(EPI, g, S, E) do { (void)g; (void)S; (void)E; } while (0)
#else
#define GEMM_PHASE_SWIGLU(EPI, g, S, E) GEMM_PHASE(EPI, g, S, E)
#endif
#ifdef DIS_G_KV
#define GEMM_PHASE_KV(EPI, g, S, E) do { (void)g; (void)S; (void)E; } while (0)
#else
#define GEMM_PHASE_KV(EPI, g, S, E) GEMM_PHASE(EPI, g, S, E)
#endif
#ifdef DIS_G_DOWN
#define GEMM_PHASE_DOWN(EPI, g, S, E) do { (void)g; (void)S; (void)E; } while (0)
#else
#define GEMM_PHASE_DOWN(EPI, g, S, E) GEMM_PHASE(EPI, g, S, E)
#endif
#ifdef DIS_G_G3A
#define GEMM_PHASE_G3A(EPI, g, S, E) do { (void)g; (void)S; (void)E; } while (0)
#else
#define GEMM_PHASE_G3A(EPI, g, S, E) GEMM_PHASE(EPI, g, S, E)
#endif
#ifdef DIS_G_G3B
#define GEMM_PHASE_G3B(EPI, g, S, E) do { (void)g; (void)S; (void)E; } while (0)
#else
#define GEMM_PHASE_G3B(EPI, g, S, E) GEMM_PHASE(EPI, g, S, E)
#endif
#ifdef DIS_G_MERGE
#define GEMM_PHASE_MERGE(EPI, g, S, E) do { (void)g; (void)S; (void)E; } while (0)
#else
typedef pg8::MergeOrder<CQA * 2, CQB * 2, CQM * 2, (long)WO_PA, (long)WO_PB, (long)WO_PMM> MergeOrderG4;
#define GEMM_PHASE_MERGE(EPI, g, S, E) pg8::gemm_phase<EPI, MergeOrderG4, true, true>(lds + RING_OFF, g, S, E)
#endif
#ifdef DIS_G_OUT
#define GEMM_PHASE_OUT(EPI, g, S, E) do { (void)g; (void)S; (void)E; } while (0)
#else
#define GEMM_PHASE_OUT(EPI, g, S, E) GEMM_PHASE(EPI, g, S, E)
#endif

__global__ void __launch_bounds__(NWAVES * 64, 2) fwd(Args args) {
    extern __shared__ __attribute__((aligned(16))) unsigned char lds_raw[];
    LAS unsigned char* lds = (LAS unsigned char*)lds_raw;
    const int tid0 = threadIdx.x;
#define PHASE_IDS int tid = tid0; asm volatile("" : "+v"(tid)); const int lane = tid & 63, wave = __builtin_amdgcn_readfirstlane(tid >> 6), gw = vcu * NWAVES + wave; LAS float* scr = (LAS float*)(lds + wave * 19456); (void)lane; (void)gw; (void)scr
    const int G = gridDim.x, bx = blockIdx.x, vcu = (G % 8 == 0) ? (bx % 8) * (G / 8) + bx / 8 : bx;
    volatile LAS unsigned* MISC = (volatile LAS unsigned*)(lds + MISC_OFF);
    for (int u = tid0; u < (LDS_BYTES - MISC_OFF) / 4; u += NWAVES * 64) ((LAS unsigned*)(lds + MISC_OFF))[u] = 0u;
    __syncthreads();
    unsigned char* ws = args.ws;
    XcdBarrier bar = xcd_barrier_post((unsigned*)(ws + WS_CTL) + CW_BAR, MISC + 8);
    const int lo = args.ph_lo, hi = args.ph_hi;
#define RUN(k) (lo <= (k) && (k) < hi)
#define SEAM(k) do { if (RUN(k) && RUN((k) + 1)) xcd_barrier(bar); } while (0)
    float* const out = args.out; const float* const xin = args.in[IN_X];
    float* const RS = (float*)(ws + WS_RS);
    float* const SSQ = (float*)(ws + WS_SSQ);
    bf16* const XB = (bf16*)(ws + WS_R0);
    bf16* const YB = (bf16*)(ws + WS_PG + 192 * MiB);
    bf16* const R0 = (bf16*)(ws + WS_R0); bf16* const PMb = (bf16*)(ws + WS_PM); bf16* const VTb = (bf16*)(ws + WS_VT); bf16* const PGb = (bf16*)(ws + WS_PG);
    bf16* const Wb = (bf16*)(ws + WS_W); bf16* const MEMN = (bf16*)(ws + WS_MEMN); bf16* const WKV = (bf16*)(ws + WS_WKV); bf16* const KMb = (bf16*)(ws + WS_KM); bf16* const VMTb = (bf16*)(ws + WS_VMT);
    const int NGW = G * NWAVES;

#pragma unroll 1
    for (int l = 0; l < DEPTH; ++l) {
        const int pb = l * PH_PER_LAYER;
#pragma unroll 1
        for (int f = 0; f < 2; ++f) {
            const int p0 = pb + (f ? 11 : 0);
#ifndef DIS_THIN
            if (RUN(p0)) {
                PHASE_IDS;
                const float* gn = args.in[f ? IN_F2N : IN_F1N] + (size_t)l * D;
                if (l == 0 && f == 0) { int m = gw;
                    for (; m + NGW < M; m += 2 * NGW) rms_stat_f32_copy_x2(xin + (size_t)m * D, xin + (size_t)(m + NGW) * D, XB + (size_t)m * D, XB + (size_t)(m + NGW) * D, RS + m, RS + m + NGW, lane);
                    if (m < M) { const float r = rms_stat_f32_copy(xin + (size_t)m * D, XB + (size_t)m * D, lane); if (lane == 0) RS[m] = r; } }
                else { for (int m = gw * 64 + lane; m < M; m += NGW * 64) RS[m] = rms_stat_partials(SSQ + (size_t)m * 32); }
                const float* w1 = args.in[f ? IN_F2W1 : IN_F1W1] + (size_t)l * D * DFF; const float* w3 = args.in[f ? IN_F2W3 : IN_F1W3] + (size_t)l * D * DFF; const float* w2 = args.in[f ? IN_F2W2 : IN_F1W2] + (size_t)l * D * DFF;
                convert_matrix(w1, D, DFF, Wb, 1, 0, scr, gw, NGW, lane, gn);
                convert_matrix(w3, D, DFF, Wb, 1, 128, scr, gw, NGW, lane, gn);
                convert_matrix(w2, DFF, D, (bf16*)(ws + WS_W + WO_W2), 0, 0, scr, gw, NGW, lane);
                if (l == 0 && f == 0) {
                    for (int m = gw; m < DEPTH * 512; m += NGW) { const int ll = m >> 9, row = m & 511; rms_row_bf16(args.in[IN_MEM] + (size_t)row * D, args.in[IN_MEMN] + (size_t)ll * D, MEMN + (size_t)m * D, lane); }
                    for (int ll = 0; ll < DEPTH; ++ll) convert_matrix(args.in[IN_WKV] + (size_t)ll * D * 1024, D, 1024, WKV + (size_t)ll * 1024 * D, 0, 0, scr, gw, NGW, lane);
                }
            }
#endif
            SEAM(p0);
            if (RUN(p0 + 1)) {
                { pg8::Gemm g{XB, Wb, M, 2 * DFF, D, D, D}; pg8::StaticOrder S; S.init(M, 2 * DFF, G, bx); pg8::EpiSwiglu E{PGb, DFF, RS}; GEMM_PHASE_SWIGLU(pg8::EpiSwiglu, g, S, E); }
            }
            SEAM(p0 + 1);
            if (RUN(p0 + 2)) { pg8::Gemm g{PGb, (bf16*)(ws + WS_W + WO_W2), M, D, DFF, DFF, DFF}; pg8::StaticOrder S; S.init(M, D, G, bx); pg8::EpiResid E{XB, D, 0.5f, SSQ}; GEMM_PHASE_DOWN(pg8::EpiResid, g, S, E); }
            SEAM(p0 + 2);
            if (f == 0) {
                float* const kml = (float*)(ws + WS_KMEAN) + (size_t)l * 16 * 64 * 128;
                bf16* const POb = (bf16*)(ws + WS_PO); float* const MLb = (float*)(ws + WS_ML); bf16* const STb = (bf16*)(ws + WS_ST); float* const DECb = (float*)(ws + WS_DEC); unsigned* const SELb = (unsigned*)(ws + WS_SEL);
                const float* lbl = args.in[IN_LB];
#ifndef DIS_THIN
                if (RUN(pb + 3)) {
                PHASE_IDS;
                    const float* gn = args.in[IN_MIXN] + (size_t)l * D;
                    for (int m = gw * 64 + lane; m < M; m += NGW * 64) RS[m] = rms_stat_partials(SSQ + (size_t)m * 32);
                    const bool kvwg = (l == 0) && (bx < 32) && ((bx & 7) < 4);
                    if (kvwg) { const int q = bx >> 3, ll = q >> 1, vt = q & 1;
                        const bf16* mn = MEMN + (size_t)ll * 512 * D; const bf16* wk = WKV + (size_t)ll * 1024 * D + (vt ? (size_t)512 * D : 0);
                        pg8::Gemm g{vt ? wk : mn, vt ? mn : wk, 512, 512, D, D, D}; pg8::StaticOrder S; S.init(512, 512, G, bx & 7);
                        pg8::EpiBf16 E{(vt ? VMTb : KMb) + (size_t)ll * 512 * 512, 512, 0u, nullptr, nullptr, nullptr}; GEMM_PHASE_KV(pg8::EpiBf16, g, S, E); }
                    else { int gwc = gw, ngwc = NGW; if (l == 0) { const int below = (bx >= 32) ? 16 : ((bx >> 3) * 4 + ((bx & 7) < 4 ? (bx & 7) : 4)); gwc = (bx - below) * NWAVES + wave; ngwc = (G - 16) * NWAVES; }
                        convert_matrix(args.in[IN_WIN] + (size_t)l * D * NIN, D, NIN, Wb, 2, 0, scr, gwc, ngwc, lane, gn); }
                    convert_matrix(args.in[IN_WPA] + (size_t)l * 1024 * D, 1024, D, (bf16*)(ws + WS_W + WO_PA), 0, 0, scr, gw, NGW, lane);
                    convert_matrix(args.in[IN_WPB] + (size_t)l * 512 * D, 512, D, (bf16*)(ws + WS_W + WO_PB), 0, 0, scr, gw, NGW, lane);
                    convert_matrix(args.in[IN_WPM] + (size_t)l * 512 * D, 512, D, (bf16*)(ws + WS_W + WO_PMM), 0, 0, scr, gw, NGW, lane);
                    convert_matrix(args.in[IN_WOUT] + (size_t)l * D * D, D, D, (bf16*)(ws + WS_W + WO_OUT), 0, 0, scr, gw, NGW, lane);
                }
#endif
                SEAM(pb + 3);
                if (RUN(pb + 4)) {
#pragma unroll 1
                    for (int q = 0; q < 2; ++q) {
                        pg8::Gemm g{q ? Wb + (size_t)NMAIN * D : XB, q ? XB : Wb, q ? NVT : M, q ? M : NMAIN, D, D, D}; pg8::StaticOrder S; S.init(g.M, g.N, G, bx);
                        pg8::EpiBf16 E{q ? VTb : PMb, q ? M : NMAIN, q ? 0u : ((1u << 16) | (1u << 18) | (2u << 24) | (2u << 26)), q ? nullptr : kml, q ? nullptr : RS, q ? RS : nullptr}; GEMM_PHASE_G3A(pg8::EpiBf16, g, S, E); }
                }
                SEAM(pb + 4);
                if (RUN(pb + 5)) {
                PHASE_IDS;
                    #ifndef DIS_LOCAL
                    hgrn_lb_table(lds, lbl, l, tid);
                    { v4u fbr[2] = {}; bf16x8 va[4] = {}; int u = vcu;
                      if (u < 2048) hgrn_local_load(PMb, VTb, u, tid, fbr, va);
#pragma unroll 1
                      for (; u < 2048; u += G) { v4u fbn[2] = {}; bf16x8 van[4] = {}; const bool nx = (u + G) < 2048;
                          if (nx) hgrn_local_load(PMb, VTb, u + G, tid, fbn, van);
                          hgrn_local_unit(lds, STb, DECb, u, tid, fbr, va);
                          if (nx) { fbr[0] = fbn[0]; fbr[1] = fbn[1]; va[0] = van[0]; va[1] = van[1]; va[2] = van[2]; va[3] = van[3]; } } }
#endif
                    #ifndef DIS_SEL
                    { SelPre P = {}; int u = vcu;
                      if (u < 1024) moba_sel_load(PMb, kml, u, tid, P);
#pragma unroll 1
                      for (; u < 1024; u += G) { SelPre Pn = {}; const bool nx = (u + G) < 1024;
                          if (nx) moba_sel_load(PMb, kml, u + G, tid, Pn);
                          moba_sel_unit(lds, SELb, u, tid, P);
                          if (nx) P = Pn; } }
#endif
                    #ifndef DIS_MEM
                    for (int u = vcu; u < 512; u += G) mem_attn_unit(lds, PMb, KMb + (size_t)l * 512 * 512, VMTb + (size_t)l * 512 * 512, u, tid);
#endif
                }
                SEAM(pb + 5);
                if (RUN(pb + 6)) {
                PHASE_IDS;
                    #ifndef DIS_PART
                    {
                        unsigned* qctr = (unsigned*)(ws + WS_CTL) + 12288 + 64 * l; LAS unsigned* qslot = (LAS unsigned*)(lds + WCNT_OFF + 32);
                        for (;;) {
                            if (tid == 0) *qslot = __hip_atomic_fetch_add(qctr, 1u, __ATOMIC_RELAXED, __HIP_MEMORY_SCOPE_AGENT);
                            LDS_WAIT(); __syncthreads();
                            const int u = (int)*qslot;
                            if (u >= 16 * 63) break;
                            moba_partial_task(lds, PMb, VTb, SELb, POb, MLb, u & 15, u >> 4, tid);
                        }
                    }
#endif
                    #ifndef DIS_SCAN
                    hgrn_scan(STb, DECb, vcu, G, tid);
#endif
                }
                SEAM(pb + 6);
                if (RUN(pb + 7)) {
                PHASE_IDS;
                    #ifndef DIS_OWN
                    for (int u = vcu; u < 1024; u += G) moba_own_unit(lds, PMb, VTb, SELb, POb, MLb, u, tid);
#endif
                    #ifndef DIS_HOUT
                    hgrn_lb_table(lds, lbl, l, tid);
                    { HoutPre P = {}; int u = vcu;
                      if (u < 2048) hgrn_out_load(PMb, VTb, STb, args.in[IN_HON] + (size_t)l * 128, u, tid, P);
#pragma unroll 1
                      for (; u < 2048; u += G) { HoutPre Pn = {}; const bool nx = (u + G) < 2048;
                          if (nx) hgrn_out_load(PMb, VTb, STb, args.in[IN_HON] + (size_t)l * 128, u + G, tid, Pn);
                          hgrn_out_unit(lds, PMb, args.in[IN_HON] + (size_t)l * 128, u, tid, P);
                          if (nx) P = Pn; } }
#endif
                }
                SEAM(pb + 7);
                if (RUN(pb + 8)) { pg8::Gemm g{XB, Wb + (size_t)(NMAIN + NVT) * D, M, NGATE, D, D, D}; pg8::StaticOrder S; S.init(M, NGATE, G, bx); pg8::EpiGateU8 E{(unsigned char*)PGb, NGATE, RS}; GEMM_PHASE_G3B(pg8::EpiGateU8, g, S, E); }
                SEAM(pb + 8);
                if (RUN(pb + 9)) {
                    pg8::Gemm g{PMb, (bf16*)(ws + WS_W + WO_PA), M, D, 1024, NMAIN, 1024};
                    MergeOrderG4 S; S.T.init(M, D, G, bx); S.A0 = (const char*)PMb; S.W0 = (const char*)(ws + WS_W);
                    pg8::EpiMergeR E{YB, D, (const unsigned char*)PGb, NGATE}; GEMM_PHASE_MERGE(pg8::EpiMergeR, g, S, E);
                }
                SEAM(pb + 9);
                if (RUN(pb + 10)) { pg8::Gemm g{YB, (bf16*)(ws + WS_W + WO_OUT), M, D, D, D, D}; pg8::StaticOrder S; S.init(M, D, G, bx); pg8::EpiResid E{XB, D, 1.0f, SSQ}; GEMM_PHASE_OUT(pg8::EpiResid, g, S, E); }
                SEAM(pb + 10);
            }
        }
    }
#ifndef DIS_THIN
    if (RUN(PH_FINAL)) { PHASE_IDS; const float* gn = args.in[IN_FINN]; if (M % (4 * NGW) == 0) { for (int m = gw; m < M; m += 4 * NGW) rms_xb_f32_x4(XB + (size_t)m * D, (size_t)NGW * D, gn, out + (size_t)m * D, (size_t)NGW * D, lane); }
        else { for (int m = gw; m < M; m += NGW) rms_xb_f32(XB + (size_t)m * D, gn, out + (size_t)m * D, lane); } }
#endif
#undef RUN
#undef SEAM
}

extern "C" void kernel_launch(void* const* d_in, const int* in_sizes, int n_in, void* d_out, int out_size, void* d_ws, size_t ws_size, hipStream_t stream) {
    static int grid = 0;
    if (grid == 0) {
        if (n_in != 21 || in_sizes[0] != M * D || out_size != M * D || ws_size < WS_END) { fprintf(stderr, "kernel_launch: unexpected shapes (n_in %d, in0 %d, out %d, ws %zu); nothing launched\n", n_in, n_in > 0 ? in_sizes[0] : -1, out_size, ws_size); grid = -1; return; }
        int dev = 0, cus = 0, per_cu = 0;
        if (hipGetDevice(&dev) != hipSuccess || hipDeviceGetAttribute(&cus, hipDeviceAttributeMultiprocessorCount, dev) != hipSuccess) { grid = -1; return; }
        if (hipFuncSetAttribute((const void*)fwd, hipFuncAttributeMaxDynamicSharedMemorySize, LDS_BYTES) != hipSuccess) { fprintf(stderr, "kernel_launch: hipFuncSetAttribute failed\n"); grid = -1; return; }
        if (hipOccupancyMaxActiveBlocksPerMultiprocessor(&per_cu, (const void*)fwd, NWAVES * 64, LDS_BYTES) != hipSuccess || per_cu < 1) fprintf(stderr, "kernel_launch: note: occupancy query reports %d\n", per_cu);
        (void)hipGetLastError();
        grid = cus;
    }
    if (grid < 0) return;
    if (hipMemsetAsync((char*)d_ws + WS_CTL, 0, CTL_ZERO_BYTES, stream) != hipSuccess) return;
    Args a{};
    for (int i = 0; i < 21; ++i) a.in[i] = (const float*)d_in[i];
    a.out = (float*)d_out; a.ws = (unsigned char*)d_ws; a.ph_lo = 0; a.ph_hi = PH_TOTAL;
    hipLaunchKernelGGL(fwd, dim3(grid), dim3(NWAVES * 64), LDS_BYTES, stream, a);
}
```

```cpp
#include <hip/hip_runtime.h>
#include <cstdio>
#include <cstdint>

#define LAS __attribute__((address_space(3)))
#define GAS __attribute__((address_space(1)))
namespace pg8 {
#define PG8_LAS __attribute__((address_space(3)))
typedef unsigned short bf16_t;
typedef short bf16x8 __attribute__((ext_vector_type(8)));
typedef float f32x4 __attribute__((ext_vector_type(4)));
typedef unsigned u32x4 __attribute__((ext_vector_type(4)));
constexpr int BM = 256, BK = 64, HALF = 128, HTB = HALF * BK * 2  , STAGE_BYTES = 8 * HTB, NXCD = 8, WGM = 8;

__host__ __device__ __forceinline__ int lds_byte(int r, int c) { const int st = (r >> 4) * 2 + (c >> 5), rr = r & 15, cc = c & 31, ob = rr * 64 + cc * 2; return st * 1024 + (ob ^ (((ob >> 9) & 1) << 5)); }
__host__ __device__ __forceinline__ void stage_rc(int b, int& R, int& C) { const int st = b / 1024, sb = b % 1024, swz = sb ^ (((sb >> 9) & 1) << 5); R = (st >> 1) * 16 + swz / 64; C = (st & 1) * 32 + (swz % 64) / 2; }
__host__ __device__ __forceinline__ int perm32(int rho) { const int n = rho >> 4, i = rho & 15; return 8 * (i >> 2) + 4 * n + (i & 3); }

struct Unit { int pm, pn, q; };
struct Gemm { const bf16_t* A; const bf16_t* Bt; int M, N, K, lda, ldb; };

struct StaticOrder {
    static constexpr bool VARK = false;
    int nM, nN, nwg, G, c, wgm;
    __host__ __device__ void init(int M, int N, int G_, int c_) { nM = M / BM; nN = N / BM; nwg = nM * nN; G = G_; c = c_; wgm = (nN == 8) ? 4 : WGM; }
    __host__ __device__ bool next(int i, Unit& u) const {
        const long L = (long)i * G + c; if (L >= nwg) return false;
        int wgid = (int)L; { const int q = nwg / NXCD, r = nwg % NXCD, xcd = wgid % NXCD, off = wgid / NXCD; wgid = (xcd < r ? xcd * (q + 1) : r * (q + 1) + (xcd - r) * q) + off; }
        const int nig = wgm * nN, gid = wgid / nig, fm = gid * wgm, gsz = (nM - fm) < wgm ? (nM - fm) : wgm;
        u.pm = fm + ((wgid % nig) % gsz); u.pn = (wgid % nig) / gsz; u.q = 0; return true;
    }
    __device__ __forceinline__ void a_ready(const Unit&) const {}
    __device__ __forceinline__ void done(const Unit&) const {}
};

template <int AO0, int AO1, int AO2, long WO0, long WO1, long WO2>
struct MergeOrder {
    static constexpr bool VARK = true;
    StaticOrder T; const char* A0; const char* W0;
    __device__ __forceinline__ bool next(int i, Unit& u) const { const int r = i / 3; if (!T.next(r, u)) return false; u.q = i - 3 * r; return true; }
    __device__ __forceinline__ void params(const Unit& u, const char*& pA, const char*& pB, int& ldb, int& nt) const {
        const int q = u.q; pA = A0 + (q == 0 ? AO0 : q == 1 ? AO1 : AO2); pB = W0 + (q == 0 ? WO0 : q == 1 ? WO1 : WO2); ldb = (q == 0) ? 1024 : 512; nt = ldb / BK; }
    __device__ __forceinline__ void a_ready(const Unit&) const {}
    __device__ __forceinline__ void done(const Unit&) const {}
};
typedef float f32x2 __attribute__((ext_vector_type(2)));
typedef __bf16 bf16x2_t __attribute__((ext_vector_type(2)));
__device__ __forceinline__ unsigned cvt_pk_bf16(float lo, float hi) { const f32x2 v = {lo, hi}; return __builtin_bit_cast(unsigned, __builtin_convertvector(v, bf16x2_t)); }
__device__ __forceinline__ float fsigmoid(float x) { return __builtin_amdgcn_rcpf(1.0f + __builtin_amdgcn_exp2f(-1.4426950408889634f * x)); }
__device__ __forceinline__ float xor32_sum(float x) { const unsigned u = __builtin_bit_cast(unsigned, x); const auto r = __builtin_amdgcn_permlane32_swap(u, u, false, false); return __builtin_bit_cast(float, (unsigned)r[0]) + __builtin_bit_cast(float, (unsigned)r[1]); }
__device__ __forceinline__ float xor32_max(float x) { const unsigned u = __builtin_bit_cast(unsigned, x); const auto r = __builtin_amdgcn_permlane32_swap(u, u, false, false); return fmaxf(__builtin_bit_cast(float, (unsigned)r[0]), __builtin_bit_cast(float, (unsigned)r[1])); }
__device__ __forceinline__ float xor16_sum(float x) { const unsigned u = __builtin_bit_cast(unsigned, x); const auto r = __builtin_amdgcn_permlane16_swap(u, u, false, false); return __builtin_bit_cast(float, (unsigned)r[0]) + __builtin_bit_cast(float, (unsigned)r[1]); }
__device__ __forceinline__ unsigned xor32_other(unsigned u, int hi_half) { const auto r = __builtin_amdgcn_permlane32_swap(u, u, false, false); return hi_half ? (unsigned)r[0] : (unsigned)r[1]; }
__device__ __forceinline__ float row16_sum(float x) {
    x += __builtin_bit_cast(float, __builtin_amdgcn_mov_dpp(__builtin_bit_cast(int, x), 0xB1, 0xF, 0xF, true));
    x += __builtin_bit_cast(float, __builtin_amdgcn_mov_dpp(__builtin_bit_cast(int, x), 0x4E, 0xF, 0xF, true));
    x += __builtin_bit_cast(float, __builtin_amdgcn_mov_dpp(__builtin_bit_cast(int, x), 0x141, 0xF, 0xF, true));
    x += __builtin_bit_cast(float, __builtin_amdgcn_mov_dpp(__builtin_bit_cast(int, x), 0x140, 0xF, 0xF, true));
    return x;
}
__device__ __forceinline__ float bflo(unsigned w) { return __builtin_bit_cast(float, w << 16); }
__device__ __forceinline__ float bfhi(unsigned w) { return __builtin_bit_cast(float, w & 0xffff0000u); }

struct NoState {};
struct RowScale8 { float r[2][4]; };
struct EpiBf16 {
    static constexpr bool PERM = true, AFTER_DRAIN = false, KEEP = false;
    typedef RowScale8 State;
    __device__ __forceinline__ void load_state(State& st, const Unit& u, int wr, int fr) const {
#pragma unroll
        for (int ai = 0; ai < 2; ++ai)
#pragma unroll
            for (int m = 0; m < 4; ++m) st.r[ai][m] = rs ? rs[u.pm * BM + wr * 64 + fr + ai * HALF + m * 16] : 1.f; }
    bf16_t* O; int ldc; unsigned modes; float* km; const float* rs; const float* cs;
    __device__ __forceinline__ void operator()(const f32x4 (&acc_in)[2][2][4][2], const Unit& u, int wr, int wc, int fr, int fq, const State& st) const {
        const int row0 = u.pm * BM + wr * 64 + fr, col0 = u.pn * BM + wc * 32 + 8 * fq;
        const unsigned mode = (modes >> (2 * (u.pn & 15))) & 3u;
        f32x4 acc[2][2][4][2];
#pragma unroll
        for (int ai = 0; ai < 2; ++ai)
#pragma unroll
            for (int m = 0; m < 4; ++m) { const float r = st.r[ai][m];
#pragma unroll
                for (int bj = 0; bj < 2; ++bj)
#pragma unroll
                    for (int n = 0; n < 2; ++n) acc[ai][bj][m][n] = acc_in[ai][bj][m][n] * r; }
        if (cs) {
#pragma unroll
            for (int bj = 0; bj < 2; ++bj) { const f32x4 c0 = *(const f32x4*)(cs + col0 + bj * HALF), c1 = *(const f32x4*)(cs + col0 + bj * HALF + 4);
#pragma unroll
                for (int ai = 0; ai < 2; ++ai)
#pragma unroll
                    for (int m = 0; m < 4; ++m) { acc[ai][bj][m][0] = acc[ai][bj][m][0] * c0; acc[ai][bj][m][1] = acc[ai][bj][m][1] * c1; } } }
#pragma unroll
        for (int ai = 0; ai < 2; ++ai)
#pragma unroll
            for (int m = 0; m < 4; ++m) { bf16_t* rowp = O + (size_t)(row0 + ai * HALF + m * 16) * ldc + col0;
#pragma unroll
                for (int bj = 0; bj < 2; ++bj) { f32x4 v0 = acc[ai][bj][m][0], v1 = acc[ai][bj][m][1];
                    if (mode != 0u) {
#pragma unroll
                        for (int j = 0; j < 4; ++j) { const float s0 = fsigmoid(v0[j]), s1 = fsigmoid(v1[j]); v0[j] = (mode == 1u) ? v0[j] * s0 : s0; v1[j] = (mode == 1u) ? v1[j] * s1 : s1; } }
                    u32x4 w; w.x = cvt_pk_bf16(v0[0], v0[1]); w.y = cvt_pk_bf16(v0[2], v0[3]); w.z = cvt_pk_bf16(v1[0], v1[1]); w.w = cvt_pk_bf16(v1[2], v1[3]);
                    *(u32x4*)(rowp + bj * HALF) = w; } }
        if (km != nullptr && u.pn >= 4 && u.pn < 8) {
            const int b = u.pm >> 6, blk = u.pm & 63;
#pragma unroll
            for (int bj = 0; bj < 2; ++bj)
#pragma unroll
                for (int n = 0; n < 2; ++n)
#pragma unroll
                    for (int e = 0; e < 4; ++e) {
                        float s = 0.f;
#pragma unroll
                        for (int ai = 0; ai < 2; ++ai)
#pragma unroll
                            for (int m = 0; m < 4; ++m) s += acc[ai][bj][m][n][e];
                        s = row16_sum(s);
                        if (fr == 0) { const int c = (u.pn - 4) * BM + bj * HALF + wc * 32 + 8 * fq + 4 * n + e, hd = c >> 7, d = c & 127;
                            __hip_atomic_fetch_add(km + ((size_t)((b * 8 + hd) * 64 + blk)) * 128 + d, s, __ATOMIC_RELAXED, __HIP_MEMORY_SCOPE_AGENT); }
                    }
        }
    }
};
struct EpiGateU8 {
    static constexpr bool PERM = true, AFTER_DRAIN = false, KEEP = false;
    unsigned char* O; int ldc; const float* rs;
    typedef RowScale8 State;
    __device__ __forceinline__ void load_state(State& st, const Unit& u, int wr, int fr) const {
#pragma unroll
        for (int ai = 0; ai < 2; ++ai)
#pragma unroll
            for (int m = 0; m < 4; ++m) st.r[ai][m] = rs[u.pm * BM + wr * 64 + fr + ai * HALF + m * 16]; }
    __device__ __forceinline__ void operator()(const f32x4 (&acc)[2][2][4][2], const Unit& u, int wr, int wc, int fr, int fq, const State& st) const {
        unsigned char* const tb = O + ((size_t)(u.pm * (ldc / BM) + u.pn) * 8 + (size_t)(wr * 4 + wc)) * 8192;
        const unsigned voff = (unsigned)(fr + 16 * fq) * 16u;
#pragma unroll
        for (int ai = 0; ai < 2; ++ai)
#pragma unroll
            for (int m = 0; m < 4; ++m) { const float rc = -1.4426950408889634f * st.r[ai][m]; unsigned q[2][8];
#pragma unroll
                for (int bj = 0; bj < 2; ++bj) {
#pragma unroll
                    for (int j = 0; j < 4; ++j) { q[bj][j] = (unsigned)fmaxf(__builtin_fmaf(__builtin_amdgcn_rcpf(1.0f + __builtin_amdgcn_exp2f(acc[ai][bj][m][0][j] * rc)), 255.f, 0.5f), 1.f); q[bj][4 + j] = (unsigned)fmaxf(__builtin_fmaf(__builtin_amdgcn_rcpf(1.0f + __builtin_amdgcn_exp2f(acc[ai][bj][m][1][j] * rc)), 255.f, 0.5f), 1.f); } }
                u32x4 w; w.x = q[0][0] | (q[0][1] << 8) | (q[0][2] << 16) | (q[0][3] << 24); w.y = q[0][4] | (q[0][5] << 8) | (q[0][6] << 16) | (q[0][7] << 24);
                w.z = q[1][0] | (q[1][1] << 8) | (q[1][2] << 16) | (q[1][3] << 24); w.w = q[1][4] | (q[1][5] << 8) | (q[1][6] << 16) | (q[1][7] << 24);
                *(u32x4*)(tb + (ai * 4 + m) * 1024 + voff) = w; }
    }
};
struct EpiSwiglu {
    static constexpr bool PERM = true, AFTER_DRAIN = false, KEEP = false;
    bf16_t* O; int ldc; const float* rs;
    typedef RowScale8 State;
    __device__ __forceinline__ void load_state(State& st, const Unit& u, int wr, int fr) const {
#pragma unroll
        for (int ai = 0; ai < 2; ++ai)
#pragma unroll
            for (int m = 0; m < 4; ++m) st.r[ai][m] = rs[u.pm * BM + wr * 64 + fr + ai * HALF + m * 16]; }
    __device__ __forceinline__ void operator()(const f32x4 (&acc)[2][2][4][2], const Unit& u, int wr, int wc, int fr, int fq, const State& st) const {
        const int row0 = u.pm * BM + wr * 64 + fr, col0 = u.pn * HALF + wc * 32 + 8 * fq;
#pragma unroll
        for (int ai = 0; ai < 2; ++ai)
#pragma unroll
            for (int m = 0; m < 4; ++m) { bf16_t* rowp = O + (size_t)(row0 + ai * HALF + m * 16) * ldc + col0; const float r = st.r[ai][m];
                const float rc = -1.4426950408889634f * r, r2 = r * r;
                const f32x4 a0 = acc[ai][0][m][0], a1 = acc[ai][0][m][1];
                const f32x4 p0 = (a0 * acc[ai][1][m][0]) * r2, p1 = (a1 * acc[ai][1][m][1]) * r2, x0 = a0 * rc, x1 = a1 * rc;
                f32x4 h0, h1;
#pragma unroll
                for (int j = 0; j < 4; ++j) { h0[j] = p0[j] * __builtin_amdgcn_rcpf(1.0f + __builtin_amdgcn_exp2f(x0[j])); h1[j] = p1[j] * __builtin_amdgcn_rcpf(1.0f + __builtin_amdgcn_exp2f(x1[j])); }
                u32x4 w; w.x = cvt_pk_bf16(h0[0], h0[1]); w.y = cvt_pk_bf16(h0[2], h0[3]); w.z = cvt_pk_bf16(h1[0], h1[1]); w.w = cvt_pk_bf16(h1[2], h1[3]);
                *(u32x4*)rowp = w; }
    }
};
struct EpiResid {
    static constexpr bool PERM = true, AFTER_DRAIN = false, KEEP = false;
    bf16_t* X; int ld; float scale; float* ssq;
    typedef NoState State;
    __device__ __forceinline__ void load_state(State&, const Unit&, int, int) const {}
    __device__ __forceinline__ void operator()(const f32x4 (&acc)[2][2][4][2], const Unit& u, int wr, int wc, int fr, int fq, const State&) const {
        const int row0 = u.pm * BM + wr * 64 + fr, col0 = u.pn * BM + wc * 32 + 8 * fq;
        u32x4 x[2][4][2];
#pragma unroll
        for (int ai = 0; ai < 2; ++ai)
#pragma unroll
            for (int m = 0; m < 4; ++m)
#pragma unroll
                for (int bj = 0; bj < 2; ++bj) x[ai][m][bj] = *(const u32x4*)(X + (size_t)(row0 + ai * HALF + m * 16) * ld + col0 + bj * HALF);
        asm volatile("" ::: "memory");
#pragma unroll
        for (int ai = 0; ai < 2; ++ai)
#pragma unroll
            for (int m = 0; m < 4; ++m)
            { float sq = 0.f;
#pragma unroll
                for (int bj = 0; bj < 2; ++bj) { const f32x4 v0 = acc[ai][bj][m][0], v1 = acc[ai][bj][m][1]; const u32x4 xx = x[ai][m][bj];
                    u32x4 w;
                    w.x = cvt_pk_bf16(bflo(xx.x) + scale * v0[0], bfhi(xx.x) + scale * v0[1]);
                    w.y = cvt_pk_bf16(bflo(xx.y) + scale * v0[2], bfhi(xx.y) + scale * v0[3]);
                    w.z = cvt_pk_bf16(bflo(xx.z) + scale * v1[0], bfhi(xx.z) + scale * v1[1]);
                    w.w = cvt_pk_bf16(bflo(xx.w) + scale * v1[2], bfhi(xx.w) + scale * v1[3]);
                    *(u32x4*)(X + (size_t)(row0 + ai * HALF + m * 16) * ld + col0 + bj * HALF) = w;
                    const float a0 = bflo(w.x), a1 = bfhi(w.x), a2 = bflo(w.y), a3 = bfhi(w.y), a4 = bflo(w.z), a5 = bfhi(w.z), a6 = bflo(w.w), a7 = bfhi(w.w);
                    sq += ((a0 * a0 + a1 * a1) + (a2 * a2 + a3 * a3)) + ((a4 * a4 + a5 * a5) + (a6 * a6 + a7 * a7)); }
                sq = xor32_sum(xor16_sum(sq));
                if (fq == 0) ssq[(size_t)(row0 + ai * HALF + m * 16) * 32 + u.pn * 4 + wc] = sq; }
        asm volatile("" ::: "memory");
    }
};
struct EpiMerge {
    static constexpr bool PERM = true, AFTER_DRAIN = false, KEEP = false;
    bf16_t* Y; int ldy; const unsigned char* Gt0; int ldg;
    typedef NoState State;
    __device__ __forceinline__ void load_state(State&, const Unit&, int, int) const {}
    __device__ __forceinline__ void operator()(const f32x4 (&acc)[2][2][4][2], const Unit& u, int wr, int wc, int fr, int fq, const State&) const {
        const int row0 = u.pm * BM + wr * 64 + fr, col0 = u.pn * BM + wc * 32 + 8 * fq;
        const unsigned char* Gt = Gt0 + u.q * ldy; const bool first = (u.q == 0);
#pragma unroll
        for (int ai = 0; ai < 2; ++ai) {
            typedef unsigned u32x2v __attribute__((ext_vector_type(2)));
            u32x2v g[4][2]; u32x4 yo[4][2];
#pragma unroll
            for (int m = 0; m < 4; ++m) { const size_t r = (size_t)(row0 + ai * HALF + m * 16);
#pragma unroll
                for (int bj = 0; bj < 2; ++bj) { g[m][bj] = *(const u32x2v*)(Gt + r * ldg + col0 + bj * HALF); yo[m][bj] = (u32x4){0u, 0u, 0u, 0u}; if (!first) yo[m][bj] = *(const u32x4*)(Y + r * ldy + col0 + bj * HALF); } }
            asm volatile("" ::: "memory");
#pragma unroll
            for (int m = 0; m < 4; ++m) { const size_t r = (size_t)(row0 + ai * HALF + m * 16);
#pragma unroll
                for (int bj = 0; bj < 2; ++bj) { const f32x4 v0 = acc[ai][bj][m][0], v1 = acc[ai][bj][m][1]; const u32x2v gg = g[m][bj]; const u32x4 yy = yo[m][bj]; constexpr float Q = 1.f / 255.f;
                    const float g0 = Q * (float)(gg.x & 255u), g1 = Q * (float)((gg.x >> 8) & 255u), g2 = Q * (float)((gg.x >> 16) & 255u), g3 = Q * (float)(gg.x >> 24);
                    const float g4 = Q * (float)(gg.y & 255u), g5 = Q * (float)((gg.y >> 8) & 255u), g6 = Q * (float)((gg.y >> 16) & 255u), g7 = Q * (float)(gg.y >> 24);
                    u32x4 w;
                    w.x = cvt_pk_bf16(bflo(yy.x) + g0 * v0[0], bfhi(yy.x) + g1 * v0[1]);
                    w.y = cvt_pk_bf16(bflo(yy.y) + g2 * v0[2], bfhi(yy.y) + g3 * v0[3]);
                    w.z = cvt_pk_bf16(bflo(yy.z) + g4 * v1[0], bfhi(yy.z) + g5 * v1[1]);
                    w.w = cvt_pk_bf16(bflo(yy.w) + g6 * v1[2], bfhi(yy.w) + g7 * v1[3]);
                    *(u32x4*)(Y + r * ldy + col0 + bj * HALF) = w; } }
            asm volatile("" ::: "memory");
        }
    }
};
struct EpiMergeR {
    static constexpr bool PERM = true, AFTER_DRAIN = false, KEEP = true;
    bf16_t* Y; int ldy; const unsigned char* Gt0; int ldg;
    typedef NoState State;
    __device__ __forceinline__ void load_state(State&, const Unit&, int, int) const {}
    static __device__ __forceinline__ float ub0(unsigned x) { return (float)(x & 255u); }
    static __device__ __forceinline__ float ub1(unsigned x) { return (float)((x >> 8) & 255u); }
    static __device__ __forceinline__ float ub2(unsigned x) { return (float)((x >> 16) & 255u); }
    static __device__ __forceinline__ float ub3(unsigned x) { return (float)(x >> 24); }
    __device__ __forceinline__ void operator()(f32x4 (&acc)[2][2][4][2], const Unit& u, int wr, int wc, int fr, int fq, const State&) const {
        typedef unsigned u32x2v __attribute__((ext_vector_type(2)));
        const int row0 = u.pm * BM + wr * 64 + fr, col0 = u.pn * BM + wc * 32 + 8 * fq;
        const unsigned char* const gp = Gt0 + ((size_t)(u.pm * (ldg / BM) + u.q * (ldy / BM) + u.pn) * 8 + (size_t)(wr * 4 + wc)) * 8192;
        const unsigned voffg = (unsigned)(fr + 16 * fq) * 16u;
        constexpr size_t NEXTQ = (size_t)8 * 65536;
        if (u.q < 2) {
            u32x2v ga[2][4][2], gb[2][4][2];
#pragma unroll
            for (int ai = 0; ai < 2; ++ai)
#pragma unroll
                for (int m = 0; m < 4; ++m) { const u32x4 wa = *(const u32x4*)(gp + (ai * 4 + m) * 1024 + voffg), wb = *(const u32x4*)(gp + NEXTQ + (ai * 4 + m) * 1024 + voffg);
                    ga[ai][m][0] = (u32x2v){wa.x, wa.y}; ga[ai][m][1] = (u32x2v){wa.z, wa.w}; gb[ai][m][0] = (u32x2v){wb.x, wb.y}; gb[ai][m][1] = (u32x2v){wb.z, wb.w}; }
            asm volatile("" ::: "memory");
#pragma unroll
            for (int ai = 0; ai < 2; ++ai)
#pragma unroll
                for (int m = 0; m < 4; ++m)
#pragma unroll
                    for (int bj = 0; bj < 2; ++bj) { const u32x2v a = ga[ai][m][bj], b = gb[ai][m][bj]; f32x4 v0 = acc[ai][bj][m][0], v1 = acc[ai][bj][m][1];
                        v0[0] *= ub0(a.x) * __builtin_amdgcn_rcpf(ub0(b.x)); v0[1] *= ub1(a.x) * __builtin_amdgcn_rcpf(ub1(b.x)); v0[2] *= ub2(a.x) * __builtin_amdgcn_rcpf(ub2(b.x)); v0[3] *= ub3(a.x) * __builtin_amdgcn_rcpf(ub3(b.x));
                        v1[0] *= ub0(a.y) * __builtin_amdgcn_rcpf(ub0(b.y)); v1[1] *= ub1(a.y) * __builtin_amdgcn_rcpf(ub1(b.y)); v1[2] *= ub2(a.y) * __builtin_amdgcn_rcpf(ub2(b.y)); v1[3] *= ub3(a.y) * __builtin_amdgcn_rcpf(ub3(b.y));
                        acc[ai][bj][m][0] = v0; acc[ai][bj][m][1] = v1; }
        } else {
            u32x2v g[2][4][2];
#pragma unroll
            for (int ai = 0; ai < 2; ++ai)
#pragma unroll
                for (int m = 0; m < 4; ++m)
                { const u32x4 wa = *(const u32x4*)(gp + (ai * 4 + m) * 1024 + voffg); g[ai][m][0] = (u32x2v){wa.x, wa.y}; g[ai][m][1] = (u32x2v){wa.z, wa.w}; }
            asm volatile("" ::: "memory");
#pragma unroll
            for (int ai = 0; ai < 2; ++ai)
#pragma unroll
                for (int m = 0; m < 4; ++m)
#pragma unroll
                    for (int bj = 0; bj < 2; ++bj) { const u32x2v gg = g[ai][m][bj]; const f32x4 v0 = acc[ai][bj][m][0], v1 = acc[ai][bj][m][1]; constexpr float Q = 1.f / 255.f;
                        u32x4 w;
                        w.x = cvt_pk_bf16(v0[0] * (Q * ub0(gg.x)), v0[1] * (Q * ub1(gg.x))); w.y = cvt_pk_bf16(v0[2] * (Q * ub2(gg.x)), v0[3] * (Q * ub3(gg.x)));
                        w.z = cvt_pk_bf16(v1[0] * (Q * ub0(gg.y)), v1[1] * (Q * ub1(gg.y))); w.w = cvt_pk_bf16(v1[2] * (Q * ub2(gg.y)), v1[3] * (Q * ub3(gg.y)));
                        *(u32x4*)(Y + (size_t)(row0 + ai * HALF + m * 16) * ldy + col0 + bj * HALF) = w; }
            asm volatile("" ::: "memory");
        }
    }
};
template <bool PERM>
__device__ __forceinline__ void voffb_for(int ldb, unsigned (&v)[2]) {
    int t = threadIdx.x; asm volatile("" : "+v"(t));
#pragma unroll
    for (int i = 0; i < 2; ++i) { int R, C; stage_rc(t * 16 + i * 8192, R, C); const int Rb = PERM ? ((R & ~31) + perm32(R & 31)) : R; v[i] = (unsigned)(Rb * ldb + C) * 2u; }
}
template <class Epi, class Sched, bool ALIGN_EPI = false, bool SP2 = false>
__device__ __forceinline__ void gemm_phase(PG8_LAS unsigned char* lds, const Gemm g, const Sched& S, const Epi& E) {
    int tid_ = threadIdx.x; asm volatile("" : "+v"(tid_));
    const int tid = tid_, wid = __builtin_amdgcn_readfirstlane(tid >> 6), lane = tid & 63, wr = wid >> 2, wc = wid & 3, fr = lane & 15, fq = lane >> 4;
    const int K = g.K; int nt = K / BK;
    unsigned voffA[2], voffB[2];
#pragma unroll
    for (int i = 0; i < 2; ++i) { int R, C; stage_rc(tid * 16 + i * 8192, R, C); const int Rb = Epi::PERM ? ((R & ~31) + perm32(R & 31)) : R;
        voffA[i] = (unsigned)(R * g.lda + C) * 2u; voffB[i] = (unsigned)(Rb * g.ldb + C) * 2u; }
    const size_t kstep = (size_t)(BK * 2);
    const size_t hstepA = (size_t)HALF * g.lda * 2; size_t hstepB = (size_t)HALF * g.ldb * 2;
    const size_t tstepA = 2 * hstepA; const size_t tstepB = 2 * hstepB;
    const unsigned ldsw = (unsigned)wid * 1024u;
    const int aoff = lds_byte(wr * 64 + fr, fq * 8), boff = lds_byte(wc * 32 + fr, fq * 8);
#define PG8_SA(b, h) (((b) * 2 + (h)) * HTB)
#define PG8_SB(b, h) ((4 + (b) * 2 + (h)) * HTB)
#define PG8_STAGE(bufoff, gbase, voff) do { _Pragma("unroll") for (int _i = 0; _i < 2; ++_i) \
        __builtin_amdgcn_global_load_lds((const unsigned*)((const char*)(gbase) + (voff)[_i]), (PG8_LAS unsigned*)(lds + (bufoff) + ldsw + _i * 8192), 16, 0, 0); } while (0)
#define PG8_LDA(dst, b, h) do { _Pragma("unroll") for (int m = 0; m < 4; ++m) _Pragma("unroll") for (int k = 0; k < 2; ++k) dst[m][k] = *(const PG8_LAS bf16x8*)(lds + PG8_SA(b, h) + aoff + m * 2048 + k * 1024); } while (0)
#define PG8_LDB(dst, b, h) do { _Pragma("unroll") for (int n = 0; n < 2; ++n) _Pragma("unroll") for (int k = 0; k < 2; ++k) dst[n][k] = *(const PG8_LAS bf16x8*)(lds + PG8_SB(b, h) + boff + n * 2048 + k * 1024); } while (0)
#define PG8_MMA(ai, bj, At, Bt) do { __builtin_amdgcn_s_setprio(1); _Pragma("unroll") for (int m = 0; m < 4; ++m) _Pragma("unroll") for (int n = 0; n < 2; ++n) _Pragma("unroll") for (int k = 0; k < 2; ++k) \
        acc[ai][bj][m][n] = __builtin_amdgcn_mfma_f32_16x16x32_bf16(Bt[n][k], At[m][k], acc[ai][bj][m][n], 0, 0, 0); __builtin_amdgcn_s_setprio(0); } while (0)
#define PG8_WAIT_V(n) asm volatile("s_waitcnt vmcnt(" #n ")" ::: "memory")
#define PG8_WAIT_L(n) asm volatile("s_waitcnt lgkmcnt(" #n ")" ::: "memory")
#define PG8_BAR __builtin_amdgcn_s_barrier()
#define PG8_SCHED __builtin_amdgcn_sched_barrier(0)
    Unit cur, nxt; int ui = 0;
    if (!S.next(0, cur)) return;
    f32x4 acc[2][2][4][2];
#pragma unroll
    for (int a = 0; a < 2; ++a)
#pragma unroll
        for (int b = 0; b < 2; ++b)
#pragma unroll
            for (int m = 0; m < 4; ++m)
#pragma unroll
                for (int n = 0; n < 2; ++n) acc[a][b][m][n] = (f32x4){0.f, 0.f, 0.f, 0.f};
    bf16x8 At[4][2], B0[2][2], B1[2][2];
    const char* cA = (const char*)g.A + (size_t)cur.pm * tstepA; const char* cB = (const char*)g.Bt + (size_t)cur.pn * tstepB;
    if constexpr (Sched::VARK) { const char* pA; const char* pB; int ldbc; S.params(cur, pA, pB, ldbc, nt); hstepB = (size_t)HALF * ldbc * 2; cA = pA + (size_t)cur.pm * tstepA; cB = pB + (size_t)cur.pn * (2 * hstepB);
        voffb_for<Epi::PERM>(ldbc, voffB); }
    typename Epi::State est; E.load_state(est, cur, wr, fr);
    S.a_ready(cur);
    if constexpr (SP2) {
        PG8_STAGE(PG8_SB(0, 0), cB, voffB); PG8_STAGE(PG8_SB(0, 1), cB + hstepB, voffB); PG8_STAGE(PG8_SA(0, 0), cA, voffA); PG8_STAGE(PG8_SA(0, 1), cA + hstepA, voffA);
        if (wr == 1) PG8_BAR;
        PG8_WAIT_V(2); PG8_BAR;
        PG8_STAGE(PG8_SB(1, 0), cB + kstep, voffB); PG8_STAGE(PG8_SA(1, 0), cA + kstep, voffA); PG8_STAGE(PG8_SB(1, 1), cB + hstepB + kstep, voffB);
        PG8_WAIT_V(6); PG8_BAR;
    } else {
        PG8_STAGE(PG8_SB(0, 0), cB, voffB); PG8_STAGE(PG8_SA(0, 0), cA, voffA); PG8_STAGE(PG8_SB(0, 1), cB + hstepB, voffB); PG8_STAGE(PG8_SA(0, 1), cA + hstepA, voffA);
        if (wr == 1) PG8_BAR;
        PG8_WAIT_V(4); PG8_BAR;
        PG8_STAGE(PG8_SB(1, 0), cB + kstep, voffB); PG8_STAGE(PG8_SA(1, 0), cA + kstep, voffA); PG8_STAGE(PG8_SB(1, 1), cB + hstepB + kstep, voffB);
        PG8_WAIT_V(6); PG8_BAR;
    }
    for (;;) {
        const bool has_next = S.next(ui + 1, nxt);
        const char* nA = has_next ? (const char*)g.A + (size_t)nxt.pm * tstepA : cA; const char* nB = has_next ? (const char*)g.Bt + (size_t)nxt.pn * tstepB : cB;
        unsigned voffBn[2] = {voffB[0], voffB[1]}; size_t hstepBn = hstepB; int ntn = nt;
        if constexpr (Sched::VARK) { if (has_next) { const char* pA; const char* pB; int ldbn; S.params(nxt, pA, pB, ldbn, ntn); hstepBn = (size_t)HALF * ldbn * 2; nA = pA + (size_t)nxt.pm * tstepA; nB = pB + (size_t)nxt.pn * (2 * hstepBn);
            voffb_for<Epi::PERM>(ldbn, voffBn); } }
        for (int t = 0; t < nt; t += 2) {
            const bool last = (t == nt - 2);
            const char* a1 = cA + (size_t)(t + 1) * kstep;
            const char* a2 = last ? nA : cA + (size_t)(t + 2) * kstep; const char* b2 = last ? nB : cB + (size_t)(t + 2) * kstep;
            const char* a3 = a2 + kstep; const char* b3 = b2 + kstep;
            if (last && has_next) S.a_ready(nxt);
            unsigned vBs[2]; size_t hsb;
            if constexpr (Sched::VARK) { vBs[0] = last ? voffBn[0] : voffB[0]; vBs[1] = last ? voffBn[1] : voffB[1]; hsb = last ? hstepBn : hstepB; } else { vBs[0] = voffB[0]; vBs[1] = voffB[1]; hsb = hstepB; }
            if constexpr (SP2) {
            PG8_LDB(B0, 0, 0); PG8_LDB(B1, 0, 1); PG8_SCHED; PG8_LDA(At, 0, 0); PG8_STAGE(PG8_SA(1, 1), a1 + hstepA, voffA);
            PG8_WAIT_V(8); PG8_WAIT_L(0); PG8_BAR; PG8_MMA(0, 0, At, B0); PG8_MMA(0, 1, At, B1); PG8_BAR; PG8_SCHED;
            PG8_LDA(At, 0, 1); PG8_STAGE(PG8_SB(0, 0), b2, vBs); PG8_STAGE(PG8_SB(0, 1), b2 + hsb, vBs); PG8_STAGE(PG8_SA(0, 0), a2, voffA);
            PG8_WAIT_V(8); PG8_WAIT_L(0); PG8_BAR; PG8_MMA(1, 0, At, B0); PG8_MMA(1, 1, At, B1); PG8_BAR; PG8_SCHED;
            PG8_LDB(B0, 1, 0); PG8_LDB(B1, 1, 1); PG8_SCHED; PG8_LDA(At, 1, 0); PG8_STAGE(PG8_SA(0, 1), a2 + hstepA, voffA);
            PG8_WAIT_V(8); PG8_WAIT_L(0); PG8_BAR; PG8_MMA(0, 0, At, B0); PG8_MMA(0, 1, At, B1); PG8_BAR; PG8_SCHED;
            PG8_LDA(At, 1, 1); PG8_STAGE(PG8_SB(1, 0), b3, vBs); PG8_STAGE(PG8_SB(1, 1), b3 + hsb, vBs); PG8_STAGE(PG8_SA(1, 0), a3, voffA);
            PG8_WAIT_V(8); PG8_WAIT_L(0); PG8_BAR; PG8_MMA(1, 0, At, B0); PG8_MMA(1, 1, At, B1); PG8_BAR; PG8_SCHED;
            } else {
            PG8_LDB(B0, 0, 0); PG8_SCHED; PG8_LDA(At, 0, 0); PG8_STAGE(PG8_SA(1, 1), a1 + hstepA, voffA);
            PG8_WAIT_L(8); PG8_BAR; PG8_WAIT_L(0); PG8_MMA(0, 0, At, B0); PG8_BAR; PG8_SCHED;
            PG8_LDB(B1, 0, 1); PG8_STAGE(PG8_SB(0, 0), b2, voffB);
            PG8_BAR; PG8_WAIT_L(0); PG8_MMA(0, 1, At, B1); PG8_BAR;
            PG8_LDA(At, 0, 1); PG8_STAGE(PG8_SA(0, 0), a2, voffA);
            PG8_BAR; PG8_WAIT_L(0); PG8_MMA(1, 0, At, B0); PG8_BAR; PG8_SCHED;
            PG8_STAGE(PG8_SB(0, 1), b2 + hstepB, voffB);
            PG8_WAIT_V(6); PG8_BAR; PG8_MMA(1, 1, At, B1); PG8_BAR;
            PG8_LDB(B0, 1, 0); PG8_SCHED; PG8_LDA(At, 1, 0); PG8_STAGE(PG8_SA(0, 1), a2 + hstepA, voffA);
            PG8_WAIT_L(8); PG8_BAR; PG8_WAIT_L(0); PG8_MMA(0, 0, At, B0); PG8_BAR; PG8_SCHED;
            PG8_LDB(B1, 1, 1); PG8_STAGE(PG8_SB(1, 0), b3, voffB);
            PG8_BAR; PG8_WAIT_L(0); PG8_MMA(0, 1, At, B1); PG8_BAR;
            PG8_LDA(At, 1, 1); PG8_STAGE(PG8_SA(1, 0), a3, voffA);
            PG8_BAR; PG8_WAIT_L(0); PG8_MMA(1, 0, At, B0); PG8_BAR; PG8_SCHED;
            PG8_STAGE(PG8_SB(1, 1), b3 + hstepB, voffB);
            PG8_WAIT_V(6); PG8_BAR; PG8_MMA(1, 1, At, B1); PG8_BAR;
            }
        }
        if constexpr (ALIGN_EPI) { if (wr == 0) PG8_BAR; }
        if constexpr (!Epi::AFTER_DRAIN) { E(acc, cur, wr, wc, fr, fq, est); S.done(cur); }
        if (!has_next) break;
        if (!Epi::KEEP || cur.q == 2) {
#pragma unroll
        for (int a = 0; a < 2; ++a)
#pragma unroll
            for (int b = 0; b < 2; ++b)
#pragma unroll
                for (int m = 0; m < 4; ++m)
#pragma unroll
                    for (int n = 0; n < 2; ++n) acc[a][b][m][n] = (f32x4){0.f, 0.f, 0.f, 0.f};
        }
        cur = nxt; cA = nA; cB = nB; ++ui; E.load_state(est, cur, wr, fr);
        if constexpr (Sched::VARK) { voffB[0] = voffBn[0]; voffB[1] = voffBn[1]; hstepB = hstepBn; nt = ntn; }
        if constexpr (ALIGN_EPI) { if (wr == 1) PG8_BAR; }
    }
    PG8_WAIT_V(0);
    if constexpr (!ALIGN_EPI) { if (wr == 0) PG8_BAR; }
    PG8_BAR;
    if constexpr (Epi::AFTER_DRAIN) { E.fused(acc, cur, wr, wc, fr, fq, lds, wid, lane); S.done(cur); }
#undef PG8_SA
#undef PG8_SB
#undef PG8_STAGE
#undef PG8_LDA
#undef PG8_LDB
#undef PG8_MMA
#undef PG8_WAIT_V
#undef PG8_WAIT_L
#undef PG8_BAR
#undef PG8_SCHED
}
}

typedef unsigned short bf16;
typedef unsigned v4u __attribute__((ext_vector_type(4)));
typedef unsigned v2u __attribute__((ext_vector_type(2)));
typedef float f32x4 __attribute__((ext_vector_type(4)));
typedef float f32x16 __attribute__((ext_vector_type(16)));
typedef short bf16x8 __attribute__((ext_vector_type(8)));
typedef GAS unsigned gu32;
#define RLX_AGENT __ATOMIC_RELAXED, __HIP_MEMORY_SCOPE_AGENT
#define LDS_WAIT() asm volatile("s_waitcnt lgkmcnt(0)" ::: "memory")
#define VM_WAIT() asm volatile("s_waitcnt vmcnt(0)" ::: "memory")
#define MFMA32(a, b, c) __builtin_amdgcn_mfma_f32_32x32x16_bf16((a), (b), (c), 0, 0, 0)
__device__ __forceinline__ unsigned f2bf(float f) { return pg8::cvt_pk_bf16(f, 0.f) & 0xffffu; }
__device__ __forceinline__ unsigned pk2(float lo, float hi) { return pg8::cvt_pk_bf16(lo, hi); }
__device__ __forceinline__ float bf2f(unsigned short b) { return __builtin_bit_cast(float, (unsigned)b << 16); }
using pg8::bflo; using pg8::bfhi; using pg8::fsigmoid;
__device__ __forceinline__ float fexp2(float x) { return __builtin_amdgcn_exp2f(x); }
__device__ __forceinline__ float fexp(float x) { return __builtin_amdgcn_exp2f(1.4426950408889634f * x); }
__device__ __forceinline__ bf16x8 as_bf16x8(v4u v) { return __builtin_bit_cast(bf16x8, v); }

constexpr int BATCH = 2, T = 16384, D = 2048, M = BATCH * T, DFF = 5632, NMEM = 256, DEPTH = 2;
constexpr int NMAIN = 4096, NVT = 1536, NGATE = 6144, NIN = 11776;
constexpr int CQA = 0, CKA = 1024, CQB = 2048, CFB = 2560, CGB = 3072, CQM = 3584;
constexpr int NWAVES = 8;
constexpr float RMS_EPS = 1e-6f;
constexpr size_t MiB = 1u << 20;
constexpr size_t WS_CTL = 0, CTL_ZERO_BYTES = 2 * MiB;
constexpr size_t WS_KMEAN = 1 * MiB;
constexpr size_t WS_R0 = 2 * MiB;
constexpr size_t WS_PM = 130 * MiB;
constexpr size_t WS_VT = 386 * MiB;
constexpr size_t WS_PG = 482 * MiB;
constexpr size_t WS_PO = WS_PG;
constexpr size_t WS_ML = WS_PG + 192 * MiB;
constexpr size_t WS_ST = WS_PG + 200 * MiB;
constexpr size_t WS_DEC = WS_PG + 328 * MiB;
constexpr size_t WS_SEL = WS_PG + 330 * MiB;
constexpr size_t WS_W = 866 * MiB;
constexpr size_t WS_MEMN = 932 * MiB;
constexpr size_t WS_WKV = 936 * MiB;
constexpr size_t WS_KM = 944 * MiB;
constexpr size_t WS_VMT = 945 * MiB;
constexpr size_t WS_RS = 946 * MiB;
constexpr size_t WS_SSQ = 947 * MiB;
constexpr size_t WS_END = 951 * MiB;
constexpr size_t WO_W2 = 44 * MiB, WO_PA = 46 * MiB, WO_PB = 50 * MiB, WO_PMM = 52 * MiB, WO_OUT = 54 * MiB;
constexpr int CW_TMO = 0, CW_BAR = 4096;
constexpr int RING_OFF = 0, RING_BYTES = 131072;
constexpr int SCR_BYTES = 155648;
constexpr int MISC_OFF = SCR_BYTES;
constexpr int LDS_BYTES = 163840;
constexpr int KSB = 272, VSB = 520;
constexpr int KS_OFF = 0, VS_OFF = 256 * KSB  , LIST_OFF = VS_OFF + 128 * VSB  , WCNT_OFF = LIST_OFF + 16384;
static_assert(WCNT_OFF + 64 <= SCR_BYTES, "LDS map");

#define XB_TMO      128
#define XB_XCNT(j)  (256  + 64 * (j))
#define XB_XSUB(j)  (1280 + 64 * (j))
#define XB_XGEN(j)  (2304 + 64 * (j))
#define XB_TOP      3328
#define XB_TOPGEN   3392
#define XCD_BAR_WORDS 3456
#define XB_SPIN_CAP (1u << 18)

__device__ __forceinline__ unsigned xb_ld(unsigned* p)              { return __hip_atomic_load(p, __ATOMIC_RELAXED, __HIP_MEMORY_SCOPE_AGENT); }
__device__ __forceinline__ unsigned xb_add(unsigned* p, unsigned v) { return __hip_atomic_fetch_add(p, v, __ATOMIC_RELAXED, __HIP_MEMORY_SCOPE_AGENT); }
__device__ __forceinline__ unsigned xb_xcc_id() { return (unsigned)__builtin_amdgcn_s_getreg((3 << 11) | 20) & 0xFu; }
#define XB_SPIN(cond, bar) do { unsigned _sp = 0; while (cond) { __builtin_amdgcn_s_sleep(1); \
    if ((++_sp & 255u) == 0u) { if (xb_ld(&(bar)[XB_TMO])) break; if (_sp > XB_SPIN_CAP) { atomicAdd(&(bar)[XB_TMO], 1u); break; } } } } while (0)

struct XcdBarrier {
    unsigned* bar; unsigned x;
    volatile LAS unsigned* st;
};

__device__ __forceinline__ XcdBarrier xcd_barrier_post(unsigned* bar, volatile LAS unsigned* st) {
    XcdBarrier b; b.bar = bar; b.x = xb_xcc_id(); b.st = st;
    if (threadIdx.x == 0) (void)xb_add(&bar[XB_XCNT(b.x)], 1u);
    return b;
}
__device__ __forceinline__ void xcd_barrier_complete(unsigned* bar, unsigned x, unsigned& nloc, unsigned& nx) {
    const unsigned G = gridDim.x * gridDim.y * gridDim.z;
    unsigned sum, cnt, mine, sp = 0u;
    for (;;) {
        sum = 0u; cnt = 0u; mine = 0u;
#pragma unroll
        for (unsigned j = 0; j < 16; ++j) { const unsigned c = xb_ld(&bar[XB_XCNT(j)]); sum += c; cnt += (c > 0u) ? 1u : 0u; mine = (j == x) ? c : mine; }
        if (sum == G) break;
        __builtin_amdgcn_s_sleep(1);
        if ((++sp & 255u) == 0u) { if (xb_ld(&bar[XB_TMO])) break; if (sp > XB_SPIN_CAP) { atomicAdd(&bar[XB_TMO], 1u); break; } }
    }
    nloc = mine > 0u ? mine : 1u; nx = cnt > 0u ? cnt : 1u;
}

__device__ __forceinline__ void xcd_barrier(const XcdBarrier& b) {
    asm volatile("s_waitcnt vmcnt(0)" ::: "memory");
    __syncthreads();
    if (threadIdx.x == 0) {
        unsigned* bar = b.bar;
        __builtin_amdgcn_s_waitcnt(0);
        unsigned nloc = b.st[0], nx = b.st[1];
        if (nloc == 0u) { xcd_barrier_complete(bar, b.x, nloc, nx); b.st[0] = nloc; b.st[1] = nx; }
        const unsigned old = xb_add(&bar[XB_XSUB(b.x)], 1u);
        const unsigned gen = old / nloc;
        if (old + 1u == (gen + 1u) * nloc) {
            __builtin_amdgcn_fence(__ATOMIC_RELEASE, "agent");
            asm volatile("s_waitcnt vmcnt(0)" ::: "memory");
            const unsigned og = xb_add(&bar[XB_TOP], 1u);
            const unsigned tg = og / nx;
            if (og + 1u == (tg + 1u) * nx) xb_add(&bar[XB_TOPGEN], 1u);
            else XB_SPIN(xb_ld(&bar[XB_TOPGEN]) == tg, bar);
            __builtin_amdgcn_fence(__ATOMIC_ACQUIRE, "agent");
            xb_add(&bar[XB_XGEN(b.x)], 1u);
            asm volatile("s_waitcnt vmcnt(0)" ::: "memory");
        } else {
            XB_SPIN(xb_ld(&bar[XB_XGEN(b.x)]) == gen, bar);
            __builtin_amdgcn_fence(__ATOMIC_ACQUIRE, "agent");
            asm volatile("s_waitcnt vmcnt(0)" ::: "memory");
        }
    }
    __syncthreads();
}


__device__ __forceinline__ float wave_sum(float v) {
    return pg8::xor32_sum(pg8::xor16_sum(pg8::row16_sum(v)));
}
__device__ __forceinline__ void rms_row_bf16(const float* xrow, const float* g, bf16* orow, int lane, bf16* xb = nullptr) {
    const f32x4* xr = (const f32x4*)xrow + lane; const f32x4* gr = (const f32x4*)g + lane;
    f32x4 v[8]; float s = 0.f;
#pragma unroll
    for (int j = 0; j < 8; ++j) { v[j] = xr[64 * j]; s += (v[j].x * v[j].x + v[j].y * v[j].y) + (v[j].z * v[j].z + v[j].w * v[j].w); }
    const float r = __builtin_amdgcn_rsqf(wave_sum(s) * (1.f / D) + RMS_EPS);
    v2u* o8 = (v2u*)orow + lane;
#pragma unroll
    for (int j = 0; j < 8; ++j) { const f32x4 gg = gr[64 * j]; v2u w; w.x = pk2(v[j].x * r * gg.x, v[j].y * r * gg.y); w.y = pk2(v[j].z * r * gg.z, v[j].w * r * gg.w); o8[64 * j] = w; }
    if (xb != nullptr) { v2u* x8 = (v2u*)xb + lane;
#pragma unroll
        for (int j = 0; j < 8; ++j) { v2u w; w.x = pk2(v[j].x, v[j].y); w.y = pk2(v[j].z, v[j].w); x8[64 * j] = w; } }
}
__device__ __forceinline__ void rms_xb_bf16(const bf16* xrow, const float* g, bf16* orow, int lane) {
    const v4u* xr = (const v4u*)xrow + lane; const f32x4* gr = (const f32x4*)g + 2 * lane;
    float v[4][8]; float s = 0.f;
#pragma unroll
    for (int j = 0; j < 4; ++j) { const v4u w = xr[64 * j]; v[j][0] = bflo(w.x); v[j][1] = bfhi(w.x); v[j][2] = bflo(w.y); v[j][3] = bfhi(w.y); v[j][4] = bflo(w.z); v[j][5] = bfhi(w.z); v[j][6] = bflo(w.w); v[j][7] = bfhi(w.w);
#pragma unroll
        for (int e = 0; e < 8; ++e) s += v[j][e] * v[j][e]; }
    const float r = __builtin_amdgcn_rsqf(wave_sum(s) * (1.f / D) + RMS_EPS);
    v4u* o = (v4u*)orow + lane;
#pragma unroll
    for (int j = 0; j < 4; ++j) { const f32x4 g0 = gr[128 * j], g1 = gr[128 * j + 1]; v4u w;
        w.x = pk2(v[j][0] * r * g0.x, v[j][1] * r * g0.y); w.y = pk2(v[j][2] * r * g0.z, v[j][3] * r * g0.w); w.z = pk2(v[j][4] * r * g1.x, v[j][5] * r * g1.y); w.w = pk2(v[j][6] * r * g1.z, v[j][7] * r * g1.w); o[64 * j] = w; }
}
__device__ __forceinline__ void rms_xb_f32(const bf16* xrow, const float* g, float* orow, int lane) {
    const v4u* xr = (const v4u*)xrow + lane; const f32x4* gr = (const f32x4*)g + 2 * lane;
    float v[4][8]; float s = 0.f;
#pragma unroll
    for (int j = 0; j < 4; ++j) { const v4u w = xr[64 * j]; v[j][0] = bflo(w.x); v[j][1] = bfhi(w.x); v[j][2] = bflo(w.y); v[j][3] = bfhi(w.y); v[j][4] = bflo(w.z); v[j][5] = bfhi(w.z); v[j][6] = bflo(w.w); v[j][7] = bfhi(w.w);
#pragma unroll
        for (int e = 0; e < 8; ++e) s += v[j][e] * v[j][e]; }
    const float r = __builtin_amdgcn_rsqf(wave_sum(s) * (1.f / D) + RMS_EPS);
    f32x4* o = (f32x4*)orow + 2 * lane;
#pragma unroll
    for (int j = 0; j < 4; ++j) { const f32x4 g0 = gr[128 * j], g1 = gr[128 * j + 1];
        o[128 * j] = (f32x4){v[j][0] * r * g0.x, v[j][1] * r * g0.y, v[j][2] * r * g0.z, v[j][3] * r * g0.w}; o[128 * j + 1] = (f32x4){v[j][4] * r * g1.x, v[j][5] * r * g1.y, v[j][6] * r * g1.z, v[j][7] * r * g1.w}; }
}
__device__ __forceinline__ void rms_xb_f32_x4(const bf16* x0, size_t rstride, const float* g, float* o0, size_t ostride, int lane) {
    v4u w[4][4];
#pragma unroll
    for (int q = 0; q < 4; ++q)
#pragma unroll
        for (int j = 0; j < 4; ++j) w[q][j] = ((const v4u*)(x0 + q * rstride) + lane)[64 * j];
    const f32x4* gr = (const f32x4*)g + 2 * lane;
#pragma unroll
    for (int q = 0; q < 4; ++q) { float v[4][8]; float s = 0.f;
#pragma unroll
        for (int j = 0; j < 4; ++j) { const v4u ww = w[q][j]; v[j][0] = bflo(ww.x); v[j][1] = bfhi(ww.x); v[j][2] = bflo(ww.y); v[j][3] = bfhi(ww.y); v[j][4] = bflo(ww.z); v[j][5] = bfhi(ww.z); v[j][6] = bflo(ww.w); v[j][7] = bfhi(ww.w);
#pragma unroll
            for (int e = 0; e < 8; ++e) s += v[j][e] * v[j][e]; }
        const float r = __builtin_amdgcn_rsqf(wave_sum(s) * (1.f / D) + RMS_EPS);
        f32x4* o = (f32x4*)(o0 + q * ostride) + 2 * lane;
#pragma unroll
        for (int j = 0; j < 4; ++j) { const f32x4 g0 = gr[128 * j], g1 = gr[128 * j + 1];
            o[128 * j] = (f32x4){v[j][0] * r * g0.x, v[j][1] * r * g0.y, v[j][2] * r * g0.z, v[j][3] * r * g0.w}; o[128 * j + 1] = (f32x4){v[j][4] * r * g1.x, v[j][5] * r * g1.y, v[j][6] * r * g1.z, v[j][7] * r * g1.w}; } }
}
__device__ __forceinline__ float rms_stat_xb(const bf16* xrow, int lane) {
    const v4u* xr = (const v4u*)xrow + lane; float s = 0.f;
#pragma unroll
    for (int j = 0; j < 4; ++j) { const v4u w = xr[64 * j]; const float a0 = bflo(w.x), a1 = bfhi(w.x), a2 = bflo(w.y), a3 = bfhi(w.y), a4 = bflo(w.z), a5 = bfhi(w.z), a6 = bflo(w.w), a7 = bfhi(w.w);
        s += ((a0 * a0 + a1 * a1) + (a2 * a2 + a3 * a3)) + ((a4 * a4 + a5 * a5) + (a6 * a6 + a7 * a7)); }
    return __builtin_amdgcn_rsqf(wave_sum(s) * (1.f / D) + RMS_EPS);
}
__device__ __forceinline__ float rms_stat_partials(const float* ssq_row) {
    float s = 0.f;
#pragma unroll
    for (int i = 0; i < 8; ++i) { const f32x4 v = ((const f32x4*)ssq_row)[i]; s += (v.x + v.y) + (v.z + v.w); }
    return __builtin_amdgcn_rsqf(s * (1.f / D) + RMS_EPS);
}
__device__ __forceinline__ float rms_stat_f32_copy(const float* xrow, bf16* xb, int lane) {
    const f32x4* xr = (const f32x4*)xrow + lane; v2u* x8 = (v2u*)xb + lane; float s = 0.f;
#pragma unroll
    for (int j = 0; j < 8; ++j) { const f32x4 v = xr[64 * j]; v2u w; w.x = pk2(v.x, v.y); w.y = pk2(v.z, v.w); x8[64 * j] = w;
        const float a0 = bflo(w.x), a1 = bfhi(w.x), a2 = bflo(w.y), a3 = bfhi(w.y); s += (a0 * a0 + a1 * a1) + (a2 * a2 + a3 * a3); }
    return __builtin_amdgcn_rsqf(wave_sum(s) * (1.f / D) + RMS_EPS);
}
__device__ __forceinline__ void rms_stat_f32_copy_x2(const float* x0, const float* x1, bf16* b0, bf16* b1, float* rs0, float* rs1, int lane) {
    f32x4 va[8], vb[8];
#pragma unroll
    for (int j = 0; j < 8; ++j) { va[j] = ((const f32x4*)x0 + lane)[64 * j]; vb[j] = ((const f32x4*)x1 + lane)[64 * j]; }
    float sa = 0.f, sb = 0.f;
#pragma unroll
    for (int j = 0; j < 8; ++j) { v2u w; w.x = pk2(va[j].x, va[j].y); w.y = pk2(va[j].z, va[j].w); ((v2u*)b0 + lane)[64 * j] = w;
        { const float a0 = bflo(w.x), a1 = bfhi(w.x), a2 = bflo(w.y), a3 = bfhi(w.y); sa += (a0 * a0 + a1 * a1) + (a2 * a2 + a3 * a3); }
        w.x = pk2(vb[j].x, vb[j].y); w.y = pk2(vb[j].z, vb[j].w); ((v2u*)b1 + lane)[64 * j] = w;
        { const float a0 = bflo(w.x), a1 = bfhi(w.x), a2 = bflo(w.y), a3 = bfhi(w.y); sb += (a0 * a0 + a1 * a1) + (a2 * a2 + a3 * a3); } }
    const float ra = __builtin_amdgcn_rsqf(wave_sum(sa) * (1.f / D) + RMS_EPS), rb = __builtin_amdgcn_rsqf(wave_sum(sb) * (1.f / D) + RMS_EPS);
    if (lane == 0) { *rs0 = ra; *rs1 = rb; }
}
__device__ __forceinline__ void rms_row_f32(const float* xrow, const float* g, float* orow, int lane) {
    const f32x4* xr = (const f32x4*)xrow + lane; const f32x4* gr = (const f32x4*)g + lane;
    f32x4 v[8]; float s = 0.f;
#pragma unroll
    for (int j = 0; j < 8; ++j) { v[j] = xr[64 * j]; s += (v[j].x * v[j].x + v[j].y * v[j].y) + (v[j].z * v[j].z + v[j].w * v[j].w); }
    const float r = __builtin_amdgcn_rsqf(wave_sum(s) * (1.f / D) + RMS_EPS);
    f32x4* o = (f32x4*)orow + lane;
#pragma unroll
    for (int j = 0; j < 8; ++j) { const f32x4 gg = gr[64 * j]; o[64 * j] = v[j] * r * gg; }
}
template <int NT>
__device__ __forceinline__ void transpose_items(const float* W, int N, const int (&k0)[NT], const int (&n0)[NT], bf16* WT, int Kd, const int (&drow0)[NT], LAS float* scr, int lane, const float* gk) {
    float v[NT][32];
#pragma unroll
    for (int t = 0; t < NT; ++t)
#pragma unroll
        for (int i = 0; i < 32; ++i) v[t][i] = W[(size_t)(k0[t] + 2 * i + (lane >> 5)) * N + n0[t] + (lane & 31)];
#pragma unroll
    for (int t = 0; t < NT; ++t)
#pragma unroll
        for (int i = 0; i < 32; ++i) scr[t * 2112 + (2 * i + (lane >> 5)) * 33 + (lane & 31)] = v[t][i];
    LDS_WAIT(); asm volatile("" ::: "memory");
    const int c = lane & 7;
#pragma unroll
    for (int t = 0; t < NT; ++t) {
        f32x4 ga = {1.f, 1.f, 1.f, 1.f}, gb = {1.f, 1.f, 1.f, 1.f}; if (gk) { ga = *(const f32x4*)(gk + k0[t] + 8 * c); gb = *(const f32x4*)(gk + k0[t] + 8 * c + 4); }
#pragma unroll
        for (int j = 0; j < 4; ++j) { const int n = (lane >> 3) + 8 * j; const LAS float* s = scr + t * 2112 + (8 * c) * 33 + n;
            v4u o; o.x = pk2(s[0 * 33] * ga.x, s[1 * 33] * ga.y); o.y = pk2(s[2 * 33] * ga.z, s[3 * 33] * ga.w); o.z = pk2(s[4 * 33] * gb.x, s[5 * 33] * gb.y); o.w = pk2(s[6 * 33] * gb.z, s[7 * 33] * gb.w);
            *(v4u*)(WT + (size_t)(drow0[t] + n) * Kd + k0[t] + 8 * c) = o; } }
    LDS_WAIT(); asm volatile("" ::: "memory");
}
__device__ __forceinline__ int win_row(int n) {
    if (n < 2048) return n;
    if (n < 3072) return 4096 + (n - 2048);
    if (n < 3584) return 2048 + (n - 3072);
    if (n < 4096) return 2560 + (n - 3584);
    if (n < 4608) return 5120 + (n - 4096);
    if (n < 5120) return 3072 + (n - 4608);
    if (n < 5632) return 3584 + (n - 5120);
    return n;
}
__device__ __forceinline__ void convert_matrix(const float* W, int K, int N, bf16* WT, int kind, int off, LAS float* scr, int gw, int NGW, int lane, const float* gk = nullptr) {
    const int nblk = N / 32, nitems = (K / 64) * nblk;
    int it = gw;
    for (; it + NGW < nitems; it += 2 * NGW) {
        int k0[2], n0[2], dr[2];
#pragma unroll
        for (int t = 0; t < 2; ++t) { const int i2 = it + t * NGW, kb = i2 / nblk, nb = i2 % nblk; k0[t] = 64 * kb; n0[t] = 32 * nb;
            dr[t] = (kind == 0) ? n0[t] + off : (kind == 1) ? (n0[t] >> 7) * 256 + off + (n0[t] & 127) : win_row(n0[t]); }
        transpose_items<2>(W, N, k0, n0, WT, K, dr, scr, lane, gk); }
    if (it < nitems) { const int kb = it / nblk, nb = it % nblk; const int k0[1] = {64 * kb}, n0[1] = {32 * nb};
        const int dr[1] = {(kind == 0) ? n0[0] + off : (kind == 1) ? (n0[0] >> 7) * 256 + off + (n0[0] & 127) : win_row(n0[0])};
        transpose_items<1>(W, N, k0, n0, WT, K, dr, scr, lane, gk); }
}
template <int ROWS, int ROWBYTES, int SB>
__device__ __forceinline__ void lds_fill(LAS unsigned char* dst, const bf16* src, size_t ld, int tid) {
    constexpr int CH = ROWBYTES / 16;
#pragma unroll 4
    for (int i = tid; i < ROWS * CH; i += NWAVES * 64) { const int rr = i / CH, c = i % CH;
        const v4u v = *(const v4u*)((const unsigned char*)(src + (size_t)rr * ld) + c * 16);
        LAS v2u* d = (LAS v2u*)(dst + rr * SB + c * 16); d[0] = (v2u){v.x, v.y}; d[1] = (v2u){v.z, v.w}; }
}
__device__ __forceinline__ void fill_kv_tiles(LAS unsigned char* lds, const bf16* kg, size_t kld, const bf16* vg, size_t vld, int tid) {
    v4u kreg[8], vreg[8];
#pragma unroll
    for (int i = 0; i < 8; ++i) { const int ci = tid + i * 512; kreg[i] = *(const v4u*)(kg + (size_t)(ci >> 4) * kld + (ci & 15) * 8); vreg[i] = *(const v4u*)(vg + (size_t)(ci >> 5) * vld + (ci & 31) * 8); }
#pragma unroll
    for (int i = 0; i < 8; ++i) { const int ci = tid + i * 512;
        LAS v2u* dk = (LAS v2u*)(lds + KS_OFF + (ci >> 4) * KSB + (ci & 15) * 16); dk[0] = (v2u){kreg[i].x, kreg[i].y}; dk[1] = (v2u){kreg[i].z, kreg[i].w};
        LAS v2u* dv = (LAS v2u*)(lds + VS_OFF + (ci >> 5) * VSB + (ci & 31) * 16); dv[0] = (v2u){vreg[i].x, vreg[i].y}; dv[1] = (v2u){vreg[i].z, vreg[i].w}; }
}
__device__ __forceinline__ void load_qfrags(bf16x8 (&qf)[8], const bf16* qrow, int h) {
#pragma unroll
    for (int s = 0; s < 8; ++s) qf[s] = *(const bf16x8*)(qrow + 16 * s + 8 * h);
}
template <bool BIAS, bool CAUSAL>
__device__ __forceinline__ void attn_chunk(const LAS unsigned char* Kc, const LAS unsigned char* Vc, bf16x8 (&qf)[8], f32x16 (&o)[4], float& m, float& l,
                                           const int dist0, const float slope_l2, const int r, const int h, const bf16* qnext = nullptr) {
    constexpr float C = 0.08838834764831845f * 1.4426950408889634f;
    f32x16 st[4];
    bf16x8 kf[3][4];
#pragma unroll
    for (int s = 0; s < 4; ++s) kf[0][s] = *(const LAS bf16x8*)(Kc + r * KSB + s * 32 + h * 16);
#pragma unroll
    for (int s = 0; s < 4; ++s) kf[1][s] = *(const LAS bf16x8*)(Kc + r * KSB + (4 + s) * 32 + h * 16);
#pragma unroll
    for (int hb = 0; hb < 8; ++hb) { const int kt = hb >> 1, s0 = (hb & 1) * 4;
        if (hb < 6) { const int kn = (hb + 2) >> 1, sn = ((hb + 2) & 1) * 4;
#pragma unroll
            for (int s = 0; s < 4; ++s) kf[(hb + 2) % 3][s] = *(const LAS bf16x8*)(Kc + (kn * 32 + r) * KSB + (sn + s) * 32 + h * 16); }
        __builtin_amdgcn_sched_barrier(0);
        if (s0 == 0) {
#pragma unroll
            for (int e = 0; e < 16; ++e) st[kt][e] = 0.f; }
#pragma unroll
        for (int s = 0; s < 4; ++s) st[kt] = MFMA32(kf[hb % 3][s], qf[s0 + s], st[kt]);
        __builtin_amdgcn_sched_barrier(0);
    }
    v2u vlo[3][4], vhi[3][4];
#pragma unroll
    for (int i = 0; i < 4; ++i) { const LAS unsigned char* vp = Vc + r * VSB + ((i >> 1) * 32 + 16 * (i & 1) + 4 * h) * 2; vlo[0][i] = *(const LAS v2u*)vp; vhi[0][i] = *(const LAS v2u*)(vp + 16); }
    __builtin_amdgcn_sched_barrier(0);
    if (qnext != nullptr) load_qfrags(qf, qnext, h);
    int dl = dist0 - 4 * h;
    float sl2 = slope_l2; asm volatile("" : "+v"(sl2), "+v"(dl));
    const float bias0 = -sl2 * (float)dl;
    float mx = -1e30f;
#pragma unroll
    for (int kt = 0; kt < 4; ++kt)
#pragma unroll
        for (int e = 0; e < 16; ++e) { const int kk = kt * 32 + (e & 3) + 8 * (e >> 2);
            float x = st[kt][e] * C;
            if (BIAS) x += __builtin_fmaf(sl2, (float)kk, bias0);
            if (CAUSAL) x = (dl - kk >= 0) ? x : -1e30f;
            st[kt][e] = x; mx = fmaxf(mx, x); }
    mx = pg8::xor32_max(mx);
    const float mn = fmaxf(m, mx), alpha = fexp2(m - mn); m = mn;
    float ps = 0.f;
#pragma unroll
    for (int kt = 0; kt < 4; ++kt)
#pragma unroll
        for (int e = 0; e < 16; ++e) { const float p = fexp2(st[kt][e] - mn); st[kt][e] = p; ps += p; }
    ps = pg8::xor32_sum(ps);
    l = l * alpha + ps;
#pragma unroll
    for (int dt = 0; dt < 4; ++dt) o[dt] = o[dt] * alpha;
    bf16x8 pf[4][2];
#pragma unroll
    for (int kt = 0; kt < 4; ++kt)
#pragma unroll
        for (int sg = 0; sg < 2; ++sg) { v4u w; w.x = pk2(st[kt][8 * sg + 0], st[kt][8 * sg + 1]); w.y = pk2(st[kt][8 * sg + 2], st[kt][8 * sg + 3]);
            w.z = pk2(st[kt][8 * sg + 4], st[kt][8 * sg + 5]); w.w = pk2(st[kt][8 * sg + 6], st[kt][8 * sg + 7]); pf[kt][sg] = as_bf16x8(w); }
#pragma unroll
    for (int b0 = 1; b0 < 2; ++b0)
#pragma unroll
        for (int i = 0; i < 4; ++i) { const int ii = b0 * 4 + i; const LAS unsigned char* vp = Vc + r * VSB + ((ii >> 1) * 32 + 16 * (ii & 1) + 4 * h) * 2; vlo[b0][i] = *(const LAS v2u*)vp; vhi[b0][i] = *(const LAS v2u*)(vp + 16); }
#pragma unroll
    for (int hb = 0; hb < 8; ++hb) { const int dt = hb >> 1, i0 = (hb & 1) * 4;
        if (hb < 6) { const int dn = (hb + 2) >> 1, in0 = ((hb + 2) & 1) * 4;
#pragma unroll
            for (int i = 0; i < 4; ++i) { const int ii = in0 + i; const LAS unsigned char* vp = Vc + (dn * 32 + r) * VSB + ((ii >> 1) * 32 + 16 * (ii & 1) + 4 * h) * 2; vlo[(hb + 2) % 3][i] = *(const LAS v2u*)vp; vhi[(hb + 2) % 3][i] = *(const LAS v2u*)(vp + 16); } }
        __builtin_amdgcn_sched_barrier(0);
#pragma unroll
        for (int i = 0; i < 4; ++i) { const int ii = i0 + i; o[dt] = MFMA32(as_bf16x8((v4u){vlo[hb % 3][i].x, vlo[hb % 3][i].y, vhi[hb % 3][i].x, vhi[hb % 3][i].y}), pf[ii >> 1][ii & 1], o[dt]); }
        __builtin_amdgcn_sched_barrier(0);
    }
}
__device__ __forceinline__ void store_ot_bf16(const f32x16 (&o)[4], float inv, bf16* orow, int h) {
#pragma unroll
    for (int dt = 0; dt < 4; ++dt)
#pragma unroll
        for (int a = 0; a < 4; ++a) { v2u w; w.x = pk2(o[dt][4 * a] * inv, o[dt][4 * a + 1] * inv); w.y = pk2(o[dt][4 * a + 2] * inv, o[dt][4 * a + 3] * inv);
            *(v2u*)(orow + 32 * dt + 8 * a + 4 * h) = w; }
}

__device__ __forceinline__ void store_ot_private(const f32x16 (&o)[4], float inv, bf16* prow, int h) {
#pragma unroll
    for (int dt = 0; dt < 4; ++dt)
#pragma unroll
        for (int hh = 0; hh < 2; ++hh) { v4u w; w.x = pk2(o[dt][8 * hh] * inv, o[dt][8 * hh + 1] * inv); w.y = pk2(o[dt][8 * hh + 2] * inv, o[dt][8 * hh + 3] * inv); w.z = pk2(o[dt][8 * hh + 4] * inv, o[dt][8 * hh + 5] * inv); w.w = pk2(o[dt][8 * hh + 6] * inv, o[dt][8 * hh + 7] * inv);
            *(v4u*)(prow + h * 64 + dt * 16 + hh * 8) = w; }
}
__device__ __forceinline__ void mem_attn_unit(LAS unsigned char* lds, bf16* PM, const bf16* KMl, const bf16* VMTl, int u, int tid_in) {
    int tid = tid_in; asm volatile("" : "+v"(tid));
    const int wave = __builtin_amdgcn_readfirstlane(tid >> 6), lane = tid & 63, r = lane & 31, h = lane >> 5;
    const int qb = u & 63, mh = (u >> 6) & 3, b = u >> 8;
    bf16* qrow = PM + (size_t)(b * T + qb * 256 + wave * 32 + r) * NMAIN + CQM + mh * 128;
    bf16x8 qf[8]; load_qfrags(qf, qrow, h);
    fill_kv_tiles(lds, KMl + (size_t)(b * 256) * 512 + mh * 128, 512, VMTl + (size_t)(mh * 128) * 512 + b * 256, 512, tid);
    LDS_WAIT(); __syncthreads();
    f32x16 o[4]; float m = -1e30f, l = 0.f;
#pragma unroll
    for (int dt = 0; dt < 4; ++dt)
#pragma unroll
        for (int e = 0; e < 16; ++e) o[dt][e] = 0.f;
#pragma unroll 1
    for (int c = 0; c < 2; ++c) attn_chunk<false, false>(lds + KS_OFF + c * 128 * KSB, lds + VS_OFF + c * 256, qf, o, m, l, 0, 0.f, r, h);
    store_ot_bf16(o, __builtin_amdgcn_rcpf(l), qrow, h);
    __syncthreads();
}

#define TOP3_INS(v, j) do { if ((v) > v2) { if ((v) > v1) { v2 = v1; i2 = i1; if ((v) > v0) { v1 = v0; i1 = i0; v0 = (v); i0 = (j); } else { v1 = (v); i1 = (j); } } else { v2 = (v); i2 = (j); } } } while (0)
#define TOP3_INS_TIE(v, j) do { if ((v) > v2 || ((v) == v2 && (j) < i2)) { if ((v) > v1 || ((v) == v1 && (j) < i1)) { v2 = v1; i2 = i1; if ((v) > v0 || ((v) == v0 && (j) < i0)) { v1 = v0; i1 = i0; v0 = (v); i0 = (j); } else { v1 = (v); i1 = (j); } } else { v2 = (v); i2 = (j); } } } while (0)
__device__ __forceinline__ void moba_sel_unit(LAS unsigned char* lds, const bf16* PM, const float* kml, unsigned* SEL, int u, int tid) {
    const int wave = __builtin_amdgcn_readfirstlane(tid >> 6), lane = tid & 63, r = lane & 31, h = lane >> 5;
    const int blk = u & 63, bh = u >> 6, b = bh >> 3, hd = bh & 7;
    const int t = blk * 256 + wave * 32 + r;
    if (blk == 0) { if (h == 0) SEL[(size_t)bh * T + t] = 0x00ffffffu; return; }
    LAS unsigned char* KH = lds, * KL = lds + 64 * KSB;
    for (int it = tid; it < 64 * 16; it += NWAVES * 64) { const int j = it >> 4, d8 = (it & 15) * 8;
        const f32x4 a = *(const f32x4*)(kml + ((size_t)bh * 64 + j) * 128 + d8), c = *(const f32x4*)(kml + ((size_t)bh * 64 + j) * 128 + d8 + 4);
        float x[8] = {a.x, a.y, a.z, a.w, c.x, c.y, c.z, c.w}; unsigned hp[4], lp[4];
#pragma unroll
        for (int e = 0; e < 8; ++e) x[e] *= (1.f / 256.f);
#pragma unroll
        for (int e = 0; e < 4; ++e) { hp[e] = pk2(x[2 * e], x[2 * e + 1]); lp[e] = pk2(x[2 * e] - bflo(hp[e]), x[2 * e + 1] - bfhi(hp[e])); }
        LAS v2u* dh = (LAS v2u*)(KH + j * KSB + d8 * 2); LAS v2u* dl = (LAS v2u*)(KL + j * KSB + d8 * 2);
        dh[0] = (v2u){hp[0], hp[1]}; dh[1] = (v2u){hp[2], hp[3]};
        dl[0] = (v2u){lp[0], lp[1]}; dl[1] = (v2u){lp[2], lp[3]}; }
    bf16x8 qf[8]; load_qfrags(qf, PM + (size_t)(b * T + t) * NMAIN + CQA + hd * 128, h);
    LDS_WAIT(); __syncthreads();
    f32x16 st[2];
#pragma unroll
    for (int jt = 0; jt < 2; ++jt) {
#pragma unroll
        for (int e = 0; e < 16; ++e) st[jt][e] = 0.f;
#pragma unroll
        for (int s = 0; s < 8; ++s) { const bf16x8 kh = *(const LAS bf16x8*)(KH + (jt * 32 + r) * KSB + s * 32 + h * 16), kl = *(const LAS bf16x8*)(KL + (jt * 32 + r) * KSB + s * 32 + h * 16);
            st[jt] = MFMA32(kh, qf[s], st[jt]); st[jt] = MFMA32(kl, qf[s], st[jt]); }
    }
    float v0 = -3e38f, v1 = -3e38f, v2 = -3e38f; int i0 = 255, i1 = 255, i2 = 255;
#pragma unroll
    for (int jt = 0; jt < 2; ++jt)
#pragma unroll
        for (int e = 0; e < 16; ++e) { const int j = jt * 32 + (e & 3) + 8 * (e >> 2) + 4 * h; const float v = (j < blk) ? st[jt][e] : -3e38f; TOP3_INS(v, j); }
    const float p0 = __builtin_bit_cast(float, pg8::xor32_other(__builtin_bit_cast(unsigned, v0), h)), p1 = __builtin_bit_cast(float, pg8::xor32_other(__builtin_bit_cast(unsigned, v1), h)), p2 = __builtin_bit_cast(float, pg8::xor32_other(__builtin_bit_cast(unsigned, v2), h));
    const int q0 = (int)pg8::xor32_other((unsigned)i0, h), q1 = (int)pg8::xor32_other((unsigned)i1, h), q2 = (int)pg8::xor32_other((unsigned)i2, h);
    if (q0 != 255) TOP3_INS_TIE(p0, q0);
    if (q1 != 255) TOP3_INS_TIE(p1, q1);
    if (q2 != 255) TOP3_INS_TIE(p2, q2);
    if (h == 0) SEL[(size_t)bh * T + t] = (unsigned)i0 | ((unsigned)i1 << 8) | ((unsigned)i2 << 16);
    __syncthreads();
}
__device__ __forceinline__ void moba_partial_task(LAS unsigned char* lds, const bf16* PM, const bf16* VT, const unsigned* SEL, bf16* PO, float* ML, int bh, int j, int tid_in) {
    int tid = tid_in; asm volatile("" : "+v"(tid));
    const int wave = __builtin_amdgcn_readfirstlane(tid >> 6), lane = tid & 63, r = lane & 31, h = lane >> 5;
    const int b = bh >> 3, hd = bh & 7;
    const bf16* kg = PM + (size_t)(b * T + 256 * j) * NMAIN + CKA + hd * 128; const bf16* vg = VT + (size_t)(hd * 128) * M + b * T + 256 * j;
    fill_kv_tiles(lds, kg, NMAIN, vg, M, tid);
    LAS unsigned short* list = (LAS unsigned short*)(lds + LIST_OFF); LAS unsigned* wcnt = (LAS unsigned*)(lds + WCNT_OFF);
    const float slope_l2 = 1.4426950408889634f * __builtin_amdgcn_exp2f(-(float)(hd + 1));
#pragma unroll 1
    for (int t_beg = 256 * (j + 1); t_beg < T; t_beg += 8192) {
        const int t_end = (t_beg + 8192 < T) ? t_beg + 8192 : T;
        unsigned slots0 = 0u, slots1 = 0u; int tot = 0; unsigned wsel[16];
#pragma unroll
        for (int it = 0; it < 16; ++it) { const int t = t_beg + wave * 1024 + it * 64 + lane; wsel[it] = SEL[(size_t)bh * T + (t < t_end ? t : t_end - 1)]; }
#pragma unroll
        for (int it = 0; it < 16; ++it) { const int t = t_beg + wave * 1024 + it * 64 + lane; const unsigned w = (t < t_end) ? wsel[it] : 0x00ffffffu;
            const unsigned sl = ((w & 255u) == (unsigned)j) ? 1u : (((w >> 8) & 255u) == (unsigned)j) ? 2u : (((w >> 16) & 255u) == (unsigned)j) ? 3u : 0u;
            if (it < 8) slots0 |= sl << (4 * it); else slots1 |= sl << (4 * (it - 8)); tot += __builtin_popcountll(__ballot(sl != 0u)); }
        if (lane == 0) wcnt[wave] = (unsigned)tot;
        LDS_WAIT(); __syncthreads();
        int off = 0, n = 0;
#pragma unroll
        for (int w = 0; w < NWAVES; ++w) { const int c = (int)wcnt[w]; off += (w < wave) ? c : 0; n += c; }
#pragma unroll
        for (int it = 0; it < 16; ++it) { const unsigned sl = ((it < 8 ? slots0 : slots1) >> (4 * (it & 7))) & 15u; const unsigned long long bal = __ballot(sl != 0u);
            if (sl != 0u) list[off + __builtin_popcountll(bal & ((1ull << lane) - 1ull))] = (unsigned short)((wave * 1024 + it * 64 + lane) | ((sl - 1u) << 13));
            off += __builtin_popcountll(bal); }
        LDS_WAIT(); __syncthreads();
        const int ngroups = (n + 31) >> 5;
        bf16x8 qf[8]; unsigned e = 0u;
        if (wave < ngroups) { const int idx0 = wave * 32 + r; e = list[idx0 < n ? idx0 : n - 1]; load_qfrags(qf, PM + (size_t)(b * T + t_beg + (int)(e & 8191u)) * NMAIN + CQA + hd * 128, h); }
        for (int g = wave; g < ngroups; g += NWAVES) {
            const int idx = g * 32 + r;
            const int t = t_beg + (int)(e & 8191u), slot = (int)(e >> 13);
            unsigned en = 0u; const bool more = (g + NWAVES) < ngroups; const bf16* qnext = nullptr;
            if (more) { const int idn = (g + NWAVES) * 32 + r; en = list[idn < n ? idn : n - 1]; qnext = PM + (size_t)(b * T + t_beg + (int)(en & 8191u)) * NMAIN + CQA + hd * 128; }
            f32x16 o[4]; float m = -1e30f, l = 0.f;
#pragma unroll
            for (int dt = 0; dt < 4; ++dt)
#pragma unroll
                for (int q = 0; q < 16; ++q) o[dt][q] = 0.f;
#pragma unroll 1
            for (int c = 0; c < 2; ++c) attn_chunk<true, false>(lds + KS_OFF + c * 128 * KSB, lds + VS_OFF + c * 256, qf, o, m, l, t - 256 * j - 128 * c, slope_l2, r, h, c == 1 ? qnext : nullptr);
            if (idx < n) { const size_t pi = ((size_t)bh * T + t) * 3 + slot;
                store_ot_private(o, __builtin_amdgcn_rcpf(l), PO + pi * 128, h);
                if (h == 0) { ML[pi * 2] = m; ML[pi * 2 + 1] = l; } }
            e = en;
        }
        __syncthreads();
    }
}
__device__ __forceinline__ void moba_own_unit(LAS unsigned char* lds, bf16* PM, const bf16* VT, const unsigned* SEL, const bf16* PO, const float* ML, int u, int tid_in) {
    int tid = tid_in; asm volatile("" : "+v"(tid));
    const int wave = __builtin_amdgcn_readfirstlane(tid >> 6), lane = tid & 63, r = lane & 31, h = lane >> 5;
    const int blk = u & 63, bh = u >> 6, b = bh >> 3, hd = bh & 7;
    const int tl = wave * 32 + r, t = blk * 256 + tl;
    bf16* qrow = PM + (size_t)(b * T + t) * NMAIN + CQA + hd * 128;
    const unsigned selw = SEL[(size_t)bh * T + t];
    const size_t pi0 = ((size_t)bh * T + t) * 3;
    float mlr[6];
#pragma unroll
    for (int k = 0; k < 6; ++k) mlr[k] = ML[pi0 * 2 + k];
    bf16x8 qf[8]; load_qfrags(qf, qrow, h);
    fill_kv_tiles(lds, PM + (size_t)(b * T + 256 * blk) * NMAIN + CKA + hd * 128, NMAIN, VT + (size_t)(hd * 128) * M + b * T + 256 * blk, M, tid);
    LDS_WAIT(); __syncthreads();
    const float slope_l2 = 1.4426950408889634f * __builtin_amdgcn_exp2f(-(float)(hd + 1));
    f32x16 o[4]; float m = -1e30f, l = 0.f;
#pragma unroll
    for (int dt = 0; dt < 4; ++dt)
#pragma unroll
        for (int q = 0; q < 16; ++q) o[dt][q] = 0.f;
    const int nch = (wave < 4) ? 1 : 2;
#pragma unroll 1
    for (int c = 0; c < nch; ++c) attn_chunk<true, true>(lds + KS_OFF + c * 128 * KSB, lds + VS_OFF + c * 256, qf, o, m, l, tl - 128 * c, slope_l2, r, h);
    v4u pw[3][4][2];
#pragma unroll
    for (int k = 0; k < 3; ++k) { const bool ok = ((selw >> (8 * k)) & 255u) != 255u; const bf16* pr = PO + (pi0 + (ok ? k : 0)) * 128 + h * 64;
#pragma unroll
        for (int dt = 0; dt < 4; ++dt)
#pragma unroll
            for (int hh = 0; hh < 2; ++hh) { const v4u w = *(const v4u*)(pr + dt * 16 + hh * 8); pw[k][dt][hh] = ok ? w : (v4u){0u, 0u, 0u, 0u}; } }
    float mk[3], lk[3]; float mm = m;
#pragma unroll
    for (int k = 0; k < 3; ++k) { const bool ok = ((selw >> (8 * k)) & 255u) != 255u; mk[k] = ok ? mlr[2 * k] : -1e30f; lk[k] = ok ? mlr[2 * k + 1] : 0.f; mm = fmaxf(mm, mk[k]); }
    const float wo = fexp2(m - mm); float den = l * wo;
#pragma unroll
    for (int dt = 0; dt < 4; ++dt) o[dt] = o[dt] * wo;
#pragma unroll
    for (int k = 0; k < 3; ++k) { const bool ok = ((selw >> (8 * k)) & 255u) != 255u; const float wk = lk[k] * fexp2(mk[k] - mm); den += wk;
#pragma unroll
        for (int dt = 0; dt < 4; ++dt)
#pragma unroll
            for (int hh = 0; hh < 2; ++hh) { const v4u w = pw[k][dt][hh]; const float wv = ok ? wk : 0.f;
                o[dt][8 * hh] += wv * bflo(w.x); o[dt][8 * hh + 1] += wv * bfhi(w.x); o[dt][8 * hh + 2] += wv * bflo(w.y); o[dt][8 * hh + 3] += wv * bfhi(w.y);
                o[dt][8 * hh + 4] += wv * bflo(w.z); o[dt][8 * hh + 5] += wv * bfhi(w.z); o[dt][8 * hh + 6] += wv * bflo(w.w); o[dt][8 * hh + 7] += wv * bfhi(w.w); } }
    store_ot_bf16(o, __builtin_amdgcn_rcpf(den), qrow, h);
    __syncthreads();
}
constexpr int HG_G = 0, HG_TOT = 32768, HG_LB = 34816, HG_KT = 36864, HG_KK1 = 55296, HG_QS = 36864, HG_QG = 54272, HG_KD = 71680, HG_KO = 89088, HG_SS = 97792, HG_KK3 = 98816, KTSB = 144;
__device__ __forceinline__ void hgrn_lb_table(LAS unsigned char* lds, const float* lbl  , int layer, int tid) {
    float lb = 0.f; if (layer > 0) lb = fsigmoid(lbl[512 + tid] - lbl[tid]);
    ((LAS float*)(lds + HG_LB))[tid] = lb;
    LDS_WAIT(); __syncthreads();
}
__device__ __forceinline__ void hgrn_gates(LAS unsigned char* lds, int kk_off, const v4u (&fbr)[2], int hh, int tid) {
    LAS float* G = (LAS float*)(lds + HG_G); LAS float* TOT = (LAS float*)(lds + HG_TOT); LAS float* LB = (LAS float*)(lds + HG_LB) + hh * 128; LAS float* KK = (LAS float*)(lds + kk_off);
#pragma unroll
    for (int it = 0; it < 2; ++it) { const int item = tid + it * 512, s = item >> 4, d8 = (item & 15) * 8;
        const unsigned fw[4] = {fbr[it].x, fbr[it].y, fbr[it].z, fbr[it].w}; float lg[8], kv[8];
        const f32x4 lbA = *(const LAS f32x4*)(LB + d8), lbB = *(const LAS f32x4*)(LB + d8 + 4); const float lb8[8] = {lbA.x, lbA.y, lbA.z, lbA.w, lbB.x, lbB.y, lbB.z, lbB.w};
#pragma unroll
        for (int e = 0; e < 8; ++e) { const float x = (e & 1) ? bfhi(fw[e >> 1]) : bflo(fw[e >> 1]); const float lb = lb8[e];
            const float ex = __builtin_amdgcn_exp2f(-1.4426950408889634f * x);
            const float sg = __builtin_amdgcn_rcpf(1.f + ex);
            const float fg = lb + (1.f - lb) * sg; lg[e] = 0.6931471805599453f * __builtin_amdgcn_logf(fmaxf(fg, 1e-20f)); kv[e] = (1.f - lb) * (ex < 1e30f ? ex * sg : 1.f); }
        *(LAS f32x4*)(G + s * 128 + d8) = (f32x4){lg[0], lg[1], lg[2], lg[3]}; *(LAS f32x4*)(G + s * 128 + d8 + 4) = (f32x4){lg[4], lg[5], lg[6], lg[7]};
        *(LAS f32x4*)(KK + s * 128 + d8) = (f32x4){kv[0], kv[1], kv[2], kv[3]}; *(LAS f32x4*)(KK + s * 128 + d8 + 4) = (f32x4){kv[4], kv[5], kv[6], kv[7]}; }
    LDS_WAIT(); __syncthreads();
    { const int d = tid & 127, q = tid >> 7; float gv[16];
#pragma unroll
        for (int s = 0; s < 16; ++s) gv[s] = G[(16 * q + s) * 128 + d];
        float run = 0.f;
#pragma unroll
        for (int s = 0; s < 16; ++s) { run += gv[s]; G[(16 * q + s) * 128 + d] = run; }
        TOT[q * 128 + d] = run; }
    LDS_WAIT(); __syncthreads();
}
__device__ __forceinline__ void hgrn_local_load(const bf16* PM, const bf16* VT, int u, int tid_in, v4u (&fbr)[2], bf16x8 (&va)[4]) {
    int tid = tid_in; asm volatile("" : "+v"(tid));
    const int wave = __builtin_amdgcn_readfirstlane(tid >> 6), lane = tid & 63, r = lane & 31, h = lane >> 5;
    const int c = u & 255, bh = u >> 8, b = bh >> 2, hh = bh & 3;
    const size_t row0 = (size_t)b * T + (size_t)c * 64;
    const int dvt = wave >> 1;
#pragma unroll
    for (int it = 0; it < 2; ++it) { const int item = tid + it * 512; fbr[it] = *(const v4u*)(PM + (row0 + (item >> 4)) * NMAIN + CFB + hh * 128 + (item & 15) * 8); }
    const bf16* vrow = VT + (size_t)(1024 + hh * 128 + dvt * 32 + r) * M + row0;
#pragma unroll
    for (int sg = 0; sg < 4; ++sg) va[sg] = *(const bf16x8*)(vrow + 16 * sg + 8 * h);
}
__device__ __forceinline__ void hgrn_local_unit(LAS unsigned char* lds, bf16* ST, float* DEC, int u, int tid_in, const v4u (&fbr)[2], const bf16x8 (&va)[4]) {
    int tid = tid_in; asm volatile("" : "+v"(tid));
    const int wave = __builtin_amdgcn_readfirstlane(tid >> 6), lane = tid & 63, r = lane & 31, h = lane >> 5;
    const int c = u & 255, bh = u >> 8, hh = bh & 3;
    const int dvt = wave >> 1, dk0 = 2 * (wave & 1);
    hgrn_gates(lds, HG_KK1, fbr, hh, tid);
    LAS float* G = (LAS float*)(lds + HG_G); LAS float* TOT = (LAS float*)(lds + HG_TOT); LAS float* KK = (LAS float*)(lds + HG_KK1);
#pragma unroll
    for (int it = 0; it < 2; ++it) { const int item = tid + it * 512, d = item & 127, s8 = (item >> 7) * 8;
        const float t0 = TOT[d], t1 = TOT[128 + d], t2 = TOT[256 + d], t3 = TOT[384 + d], glast = ((t0 + t1) + t2) + t3;
        const float pre = (s8 >= 48) ? ((t0 + t1) + t2) : (s8 >= 32) ? (t0 + t1) : (s8 >= 16) ? t0 : 0.f;
        float kb[8];
#pragma unroll
        for (int e = 0; e < 8; ++e) kb[e] = KK[(s8 + e) * 128 + d] * fexp(glast - (G[(s8 + e) * 128 + d] + pre));
        *(LAS v4u*)(lds + HG_KT + d * KTSB + s8 * 2) = (v4u){pk2(kb[0], kb[1]), pk2(kb[2], kb[3]), pk2(kb[4], kb[5]), pk2(kb[6], kb[7])};
        if (s8 == 0) DEC[((size_t)bh * 256 + c) * 128 + d] = fexp(glast); }
    LDS_WAIT(); __syncthreads();
    f32x16 acc[2];
#pragma unroll
    for (int e = 0; e < 2; ++e)
#pragma unroll
        for (int q = 0; q < 16; ++q) acc[e][q] = 0.f;
#pragma unroll
    for (int sg = 0; sg < 4; ++sg) {
#pragma unroll
        for (int e = 0; e < 2; ++e) { const bf16x8 bb = *(const LAS bf16x8*)(lds + HG_KT + ((dk0 + e) * 32 + r) * KTSB + (16 * sg + 8 * h) * 2); acc[e] = MFMA32(va[sg], bb, acc[e]); } }
    bf16* stb = ST + ((size_t)bh * 256 + c) * 16384;
#pragma unroll
    for (int e = 0; e < 2; ++e)
#pragma unroll
        for (int q = 0; q < 16; ++q) stb[(size_t)(dvt * 32 + (q & 3) + 8 * (q >> 2) + 4 * h) * 128 + (dk0 + e) * 32 + r] = (bf16)f2bf(acc[e][q]);
}
__device__ __forceinline__ void hgrn_scan(bf16* ST, const float* DEC, int vcu, int G, int tid) {
    for (int e = vcu * 512 + tid; e < 8 * 16384; e += G * 512) { const int bh = e >> 14, rem = e & 16383, dk = e & 127;
        bf16* sp = ST + (size_t)bh * 256 * 16384 + rem; const float* dp = DEC + (size_t)bh * 256 * 128 + dk; float S = 0.f;
#pragma unroll 1
        for (int c0 = 0; c0 < 256; c0 += 32) { float L[32], dc[32];
#pragma unroll
            for (int i = 0; i < 32; ++i) { L[i] = bf2f(sp[(size_t)(c0 + i) * 16384]); dc[i] = dp[(c0 + i) * 128]; }
#pragma unroll
            for (int i = 0; i < 32; ++i) { sp[(size_t)(c0 + i) * 16384] = (bf16)f2bf(S); S = dc[i] * S + L[i]; } } }
}
struct HoutPre { v4u fbr[2], qbr[2]; bf16x8 sa[8]; v2u vlo[2][2], vhi[2][2]; v2u gbr[4]; };
__device__ __forceinline__ void hgrn_out_load(const bf16* PM, const bf16* VT, const bf16* ST, int u, int tid_in, HoutPre& P) {
    int tid = tid_in; asm volatile("" : "+v"(tid));
    const int wave = __builtin_amdgcn_readfirstlane(tid >> 6), lane = tid & 63, r = lane & 31, h = lane >> 5;
    const int c = u & 255, bh = u >> 8, b = bh >> 2, hh = bh & 3;
    const size_t row0 = (size_t)b * T + (size_t)c * 64;
    const int dvt = wave & 3, tt = wave >> 2;
#pragma unroll
    for (int it = 0; it < 2; ++it) { const int item = tid + it * 512; const bf16* p = PM + (row0 + (item >> 4)) * NMAIN + hh * 128 + (item & 15) * 8; P.fbr[it] = *(const v4u*)(p + CFB); P.qbr[it] = *(const v4u*)(p + CQB); }
    { const bf16* srow = ST + ((size_t)bh * 256 + c) * 16384 + (size_t)(dvt * 32 + r) * 128;
#pragma unroll
      for (int sg = 0; sg < 8; ++sg) P.sa[sg] = *(const bf16x8*)(srow + 16 * sg + 8 * h); }
    const bf16* vrow = VT + (size_t)(1024 + hh * 128 + dvt * 32 + r) * M + row0;
#pragma unroll
    for (int st = 0; st < 2; ++st)
#pragma unroll
        for (int sg = 0; sg < 2; ++sg) { P.vlo[st][sg] = *(const v2u*)(vrow + st * 32 + 16 * sg + 4 * h); P.vhi[st][sg] = *(const v2u*)(vrow + st * 32 + 16 * sg + 8 + 4 * h); }
    const bf16* orow = PM + (row0 + tt * 32 + r) * NMAIN;
#pragma unroll
    for (int a = 0; a < 4; ++a) P.gbr[a] = *(const v2u*)(orow + CGB + hh * 128 + dvt * 32 + 8 * a + 4 * h);
}
__device__ __forceinline__ void hgrn_out_unit(LAS unsigned char* lds, bf16* PM, const float* gain  , int u, int tid_in, const HoutPre& P) {
    int tid = tid_in; asm volatile("" : "+v"(tid));
    const int wave = __builtin_amdgcn_readfirstlane(tid >> 6), lane = tid & 63, r = lane & 31, h = lane >> 5;
    const int c = u & 255, bh = u >> 8, b = bh >> 2, hh = bh & 3;
    const size_t row0 = (size_t)b * T + (size_t)c * 64;
    const int dvt = wave & 3, tt = wave >> 2;
    const v4u (&fbr)[2] = P.fbr; const v4u (&qbr)[2] = P.qbr; const bf16x8 (&sa)[8] = P.sa; const v2u (&vlo)[2][2] = P.vlo; const v2u (&vhi)[2][2] = P.vhi; const v2u (&gbr)[4] = P.gbr;
    bf16* orow = PM + (row0 + tt * 32 + r) * NMAIN;
    hgrn_gates(lds, HG_KK3, fbr, hh, tid);
    LAS float* G = (LAS float*)(lds + HG_G); LAS float* TOT = (LAS float*)(lds + HG_TOT); LAS float* KK = (LAS float*)(lds + HG_KK3);
#pragma unroll
    for (int it = 0; it < 2; ++it) { const int item = tid + it * 512, s = item >> 4, d8 = (item & 15) * 8;
        const unsigned qw[4] = {qbr[it].x, qbr[it].y, qbr[it].z, qbr[it].w}; float qs[8], qg[8], kd[8], ko[8];
        const f32x4 kA = *(const LAS f32x4*)(KK + s * 128 + d8), kB = *(const LAS f32x4*)(KK + s * 128 + d8 + 4), gA = *(const LAS f32x4*)(G + s * 128 + d8), gB = *(const LAS f32x4*)(G + s * 128 + d8 + 4);
        const f32x4 t0A = *(const LAS f32x4*)(TOT + d8), t0B = *(const LAS f32x4*)(TOT + d8 + 4), t1A = *(const LAS f32x4*)(TOT + 128 + d8), t1B = *(const LAS f32x4*)(TOT + 128 + d8 + 4), t2A = *(const LAS f32x4*)(TOT + 256 + d8), t2B = *(const LAS f32x4*)(TOT + 256 + d8 + 4);
        const float k8[8] = {kA.x, kA.y, kA.z, kA.w, kB.x, kB.y, kB.z, kB.w}, g8[8] = {gA.x, gA.y, gA.z, gA.w, gB.x, gB.y, gB.z, gB.w};
        const float u0[8] = {t0A.x, t0A.y, t0A.z, t0A.w, t0B.x, t0B.y, t0B.z, t0B.w}, u1[8] = {t1A.x, t1A.y, t1A.z, t1A.w, t1B.x, t1B.y, t1B.z, t1B.w}, u2[8] = {t2A.x, t2A.y, t2A.z, t2A.w, t2B.x, t2B.y, t2B.z, t2B.w};
        const bool s16 = s >= 16, s32 = s >= 32, s48 = s >= 48;
#pragma unroll
        for (int e = 0; e < 8; ++e) { const float qv = (e & 1) ? bfhi(qw[e >> 1]) : bflo(qw[e >> 1]);
            const float k = k8[e], g31 = u0[e] + u1[e];
            const float pre = s48 ? (g31 + u2[e]) : s32 ? g31 : s16 ? u0[e] : 0.f;
            const float gs = g8[e] + pre, gref = s32 ? g31 : 0.f;
            qs[e] = qv * fexp(gs - gref); qg[e] = qv * fexp(gs); kd[e] = k * fexp(fminf(gref - gs, 80.f)); ko[e] = k * fexp(fminf(g31 - gs, 0.f)); }
        *(LAS v4u*)(lds + HG_QS + s * KSB + d8 * 2) = (v4u){pk2(qs[0], qs[1]), pk2(qs[2], qs[3]), pk2(qs[4], qs[5]), pk2(qs[6], qs[7])};
        *(LAS v4u*)(lds + HG_QG + s * KSB + d8 * 2) = (v4u){pk2(qg[0], qg[1]), pk2(qg[2], qg[3]), pk2(qg[4], qg[5]), pk2(qg[6], qg[7])};
        *(LAS v4u*)(lds + HG_KD + s * KSB + d8 * 2) = (v4u){pk2(kd[0], kd[1]), pk2(kd[2], kd[3]), pk2(kd[4], kd[5]), pk2(kd[6], kd[7])};
        if (s < 32) *(LAS v4u*)(lds + HG_KO + s * KSB + d8 * 2) = (v4u){pk2(ko[0], ko[1]), pk2(ko[2], ko[3]), pk2(ko[4], ko[5]), pk2(ko[6], ko[7])}; }
    LDS_WAIT(); __syncthreads();
    f32x16 o;
#pragma unroll
    for (int q = 0; q < 16; ++q) o[q] = 0.f;
#pragma unroll
    for (int sg = 0; sg < 8; ++sg) { const bf16x8 bb = *(const LAS bf16x8*)(lds + HG_QG + (tt * 32 + r) * KSB + (16 * sg + 8 * h) * 2); o = MFMA32(sa[sg], bb, o); }
#pragma unroll
    for (int st = 0; st < 2; ++st) if (st <= tt) {
        f32x16 at;
#pragma unroll
        for (int q = 0; q < 16; ++q) at[q] = 0.f;
        const LAS unsigned char* kbase = (st == tt) ? (lds + HG_KD + (st * 32 + r) * KSB) : (lds + HG_KO + r * KSB);
#pragma unroll
        for (int sg = 0; sg < 8; ++sg) { const bf16x8 a = *(const LAS bf16x8*)(kbase + (16 * sg + 8 * h) * 2), bb = *(const LAS bf16x8*)(lds + HG_QS + (tt * 32 + r) * KSB + (16 * sg + 8 * h) * 2);
            at = MFMA32(a, bb, at); }
        if (st == tt) {
#pragma unroll
            for (int q = 0; q < 16; ++q) at[q] = ((q & 3) + 8 * (q >> 2) + 4 * h <= r) ? at[q] : 0.f; }
#pragma unroll
        for (int sg = 0; sg < 2; ++sg) { const v4u pw = {pk2(at[8 * sg], at[8 * sg + 1]), pk2(at[8 * sg + 2], at[8 * sg + 3]), pk2(at[8 * sg + 4], at[8 * sg + 5]), pk2(at[8 * sg + 6], at[8 * sg + 7])};
            o = MFMA32(as_bf16x8((v4u){vlo[st][sg].x, vlo[st][sg].y, vhi[st][sg].x, vhi[st][sg].y}), as_bf16x8(pw), o); }
    }
    LAS float* SS = (LAS float*)(lds + HG_SS);
    float ss = 0.f;
#pragma unroll
    for (int q = 0; q < 16; ++q) ss += o[q] * o[q];
    ss = pg8::xor32_sum(ss);
    if (h == 0) SS[(tt * 4 + dvt) * 32 + r] = ss;
    LDS_WAIT(); __syncthreads();
    const float tot = (SS[(tt * 4 + 0) * 32 + r] + SS[(tt * 4 + 1) * 32 + r]) + (SS[(tt * 4 + 2) * 32 + r] + SS[(tt * 4 + 3) * 32 + r]);
    const float rr = __builtin_amdgcn_rsqf(tot * (1.f / 128.f) + RMS_EPS);
#pragma unroll
    for (int a = 0; a < 4; ++a) { const int dv0 = dvt * 32 + 8 * a + 4 * h; const f32x4 gn = *(const f32x4*)(gain + dv0); const v2u gb = gbr[a];
        v2u w; w.x = pk2(o[4 * a] * rr * gn.x * bflo(gb.x), o[4 * a + 1] * rr * gn.y * bfhi(gb.x)); w.y = pk2(o[4 * a + 2] * rr * gn.z * bflo(gb.y), o[4 * a + 3] * rr * gn.w * bfhi(gb.y));
        *(v2u*)(orow + CQB + hh * 128 + dv0) = w; }
}
struct Args { const float* in[21]; float* out; unsigned char* ws; int ph_lo, ph_hi; };
enum { IN_X = 0, IN_MEM, IN_F1N, IN_F1W1, IN_F1W3, IN_F1W2, IN_MIXN, IN_WIN, IN_LB, IN_HON, IN_MEMN, IN_WKV, IN_WPA, IN_WPB, IN_WPM, IN_WOUT, IN_F2N, IN_F2W1, IN_F2W3, IN_F2W2, IN_FINN };
constexpr int PH_PER_LAYER = 14, PH_FINAL = DEPTH * PH_PER_LAYER, PH_TOTAL = PH_FINAL + 1;
#ifndef DIS_GEMM
#define GEMM_PHASE(EPI, g, S, E) pg8::gemm_phase<EPI, pg8::StaticOrder, true, true>(lds + RING_OFF, g, S, E)
#else
#define GEMM_PHASE(EPI, g, S, E) do { (void)g; (void)S; (void)E; } while (0)
#endif
#ifdef DIS_G_SWIGLU
#define GEMM_PHASE_SWIGLU(EPI, g, S, E) do { (void)g; (void)S; (void)E; } while (0)
#else
#define GEMM_PHASE_SWIGLU(EPI, g, S, E) GEMM_PHASE(EPI, g, S, E)
#endif
#ifdef DIS_G_KV
#define GEMM_PHASE_KV(EPI, g, S, E) do { (void)g; (void)S; (void)E; } while (0)
#else
#define GEMM_PHASE_KV(EPI, g, S, E) GEMM_PHASE(EPI, g, S, E)
#endif
#ifdef DIS_G_DOWN
#define GEMM_PHASE_DOWN(EPI, g, S, E) do { (void)g; (void)S; (void)E; } while (0)
#else
#define GEMM_PHASE_DOWN(EPI, g, S, E) GEMM_PHASE(EPI, g, S, E)
#endif
#ifdef DIS_G_G3A
#define GEMM_PHASE_G3A(EPI, g, S, E) do { (void)g; (void)S; (void)E; } while (0)
#else
#define GEMM_PHASE_G3A(EPI, g, S, E) GEMM_PHASE(EPI, g, S, E)
#endif
#ifdef DIS_G_G3B
#define GEMM_PHASE_G3B(EPI, g, S, E) do { (void)g; (void)S; (void)E; } while (0)
#else
#define GEMM_PHASE_G3B(EPI, g, S, E) GEMM_PHASE(EPI, g, S, E)
#endif
#ifdef DIS_G_MERGE
#define GEMM_PHASE_MERGE(EPI, g, S, E) do { (void)g; (void)S; (void)E; } while (0)
#else
typedef pg8::MergeOrder<CQA * 2, CQB * 2, CQM * 2, (long)WO_PA, (long)WO_PB, (long)WO_PMM> MergeOrderG4;
#define GEMM_PHASE_MERGE(EPI, g, S, E) pg8::gemm_phase<EPI, MergeOrderG4, true, true>(lds + RING_OFF, g, S, E)
#endif
#ifdef DIS_G_OUT
#define GEMM_PHASE_OUT(EPI, g, S, E) do { (void)g; (void)S; (void)E; } while (0)
#else
#define GEMM_PHASE_OUT(EPI, g, S, E) GEMM_PHASE(EPI, g, S, E)
#endif

__global__ void __launch_bounds__(NWAVES * 64, 2) fwd(Args args) {
    extern __shared__ __attribute__((aligned(16))) unsigned char lds_raw[];
    LAS unsigned char* lds = (LAS unsigned char*)lds_raw;
    const int tid0 = threadIdx.x;
#define PHASE_IDS int tid = tid0; asm volatile("" : "+v"(tid)); const int lane = tid & 63, wave = __builtin_amdgcn_readfirstlane(tid >> 6), gw = vcu * NWAVES + wave; LAS float* scr = (LAS float*)(lds + wave * 19456); (void)lane; (void)gw; (void)scr
    const int G = gridDim.x, bx = blockIdx.x, vcu = (G % 8 == 0) ? (bx % 8) * (G / 8) + bx / 8 : bx;
    volatile LAS unsigned* MISC = (volatile LAS unsigned*)(lds + MISC_OFF);
    for (int u = tid0; u < (LDS_BYTES - MISC_OFF) / 4; u += NWAVES * 64) ((LAS unsigned*)(lds + MISC_OFF))[u] = 0u;
    __syncthreads();
    unsigned char* ws = args.ws;
    XcdBarrier bar = xcd_barrier_post((unsigned*)(ws + WS_CTL) + CW_BAR, MISC + 8);
    const int lo = args.ph_lo, hi = args.ph_hi;
#define RUN(k) (lo <= (k) && (k) < hi)
#define SEAM(k) do { if (RUN(k) && RUN((k) + 1)) xcd_barrier(bar); } while (0)
    float* const out = args.out; const float* const xin = args.in[IN_X];
    float* const RS = (float*)(ws + WS_RS);
    float* const SSQ = (float*)(ws + WS_SSQ);
    bf16* const XB = (bf16*)(ws + WS_R0);
    bf16* const YB = (bf16*)(ws + WS_PG + 192 * MiB);
    bf16* const R0 = (bf16*)(ws + WS_R0); bf16* const PMb = (bf16*)(ws + WS_PM); bf16* const VTb = (bf16*)(ws + WS_VT); bf16* const PGb = (bf16*)(ws + WS_PG);
    bf16* const Wb = (bf16*)(ws + WS_W); bf16* const MEMN = (bf16*)(ws + WS_MEMN); bf16* const WKV = (bf16*)(ws + WS_WKV); bf16* const KMb = (bf16*)(ws + WS_KM); bf16* const VMTb = (bf16*)(ws + WS_VMT);
    const int NGW = G * NWAVES;

#pragma unroll 1
    for (int l = 0; l < DEPTH; ++l) {
        const int pb = l * PH_PER_LAYER;
#pragma unroll 1
        for (int f = 0; f < 2; ++f) {
            const int p0 = pb + (f ? 11 : 0);
#ifndef DIS_THIN
            if (RUN(p0)) {
                PHASE_IDS;
                const float* gn = args.in[f ? IN_F2N : IN_F1N] + (size_t)l * D;
                if (l == 0 && f == 0) { int m = gw;
                    for (; m + NGW < M; m += 2 * NGW) rms_stat_f32_copy_x2(xin + (size_t)m * D, xin + (size_t)(m + NGW) * D, XB + (size_t)m * D, XB + (size_t)(m + NGW) * D, RS + m, RS + m + NGW, lane);
                    if (m < M) { const float r = rms_stat_f32_copy(xin + (size_t)m * D, XB + (size_t)m * D, lane); if (lane == 0) RS[m] = r; } }
                else { for (int m = gw * 64 + lane; m < M; m += NGW * 64) RS[m] = rms_stat_partials(SSQ + (size_t)m * 32); }
                const float* w1 = args.in[f ? IN_F2W1 : IN_F1W1] + (size_t)l * D * DFF; const float* w3 = args.in[f ? IN_F2W3 : IN_F1W3] + (size_t)l * D * DFF; const float* w2 = args.in[f ? IN_F2W2 : IN_F1W2] + (size_t)l * D * DFF;
                convert_matrix(w1, D, DFF, Wb, 1, 0, scr, gw, NGW, lane, gn);
                convert_matrix(w3, D, DFF, Wb, 1, 128, scr, gw, NGW, lane, gn);
                convert_matrix(w2, DFF, D, (bf16*)(ws + WS_W + WO_W2), 0, 0, scr, gw, NGW, lane);
                if (l == 0 && f == 0) {
                    for (int m = gw; m < DEPTH * 512; m += NGW) { const int ll = m >> 9, row = m & 511; rms_row_bf16(args.in[IN_MEM] + (size_t)row * D, args.in[IN_MEMN] + (size_t)ll * D, MEMN + (size_t)m * D, lane); }
                    for (int ll = 0; ll < DEPTH; ++ll) convert_matrix(args.in[IN_WKV] + (size_t)ll * D * 1024, D, 1024, WKV + (size_t)ll * 1024 * D, 0, 0, scr, gw, NGW, lane);
                }
            }
#endif
            SEAM(p0);
            if (RUN(p0 + 1)) {
                { pg8::Gemm g{XB, Wb, M, 2 * DFF, D, D, D}; pg8::StaticOrder S; S.init(M, 2 * DFF, G, bx); pg8::EpiSwiglu E{PGb, DFF, RS}; GEMM_PHASE_SWIGLU(pg8::EpiSwiglu, g, S, E); }
            }
            SEAM(p0 + 1);
            if (RUN(p0 + 2)) { pg8::Gemm g{PGb, (bf16*)(ws + WS_W + WO_W2), M, D, DFF, DFF, DFF}; pg8::StaticOrder S; S.init(M, D, G, bx); pg8::EpiResid E{XB, D, 0.5f, SSQ}; GEMM_PHASE_DOWN(pg8::EpiResid, g, S, E); }
            SEAM(p0 + 2);
            if (f == 0) {
                float* const kml = (float*)(ws + WS_KMEAN) + (size_t)l * 16 * 64 * 128;
                bf16* const POb = (bf16*)(ws + WS_PO); float* const MLb = (float*)(ws + WS_ML); bf16* const STb = (bf16*)(ws + WS_ST); float* const DECb = (float*)(ws + WS_DEC); unsigned* const SELb = (unsigned*)(ws + WS_SEL);
                const float* lbl = args.in[IN_LB];
#ifndef DIS_THIN
                if (RUN(pb + 3)) {
                PHASE_IDS;
                    const float* gn = args.in[IN_MIXN] + (size_t)l * D;
                    for (int m = gw * 64 + lane; m < M; m += NGW * 64) RS[m] = rms_stat_partials(SSQ + (size_t)m * 32);
                    const bool kvwg = (l == 0) && (bx < 32) && ((bx & 7) < 4);
                    if (kvwg) { const int q = bx >> 3, ll = q >> 1, vt = q & 1;
                        const bf16* mn = MEMN + (size_t)ll * 512 * D; const bf16* wk = WKV + (size_t)ll * 1024 * D + (vt ? (size_t)512 * D : 0);
                        pg8::Gemm g{vt ? wk : mn, vt ? mn : wk, 512, 512, D, D, D}; pg8::StaticOrder S; S.init(512, 512, G, bx & 7);
                        pg8::EpiBf16 E{(vt ? VMTb : KMb) + (size_t)ll * 512 * 512, 512, 0u, nullptr, nullptr, nullptr}; GEMM_PHASE_KV(pg8::EpiBf16, g, S, E); }
                    else { int gwc = gw, ngwc = NGW; if (l == 0) { const int below = (bx >= 32) ? 16 : ((bx >> 3) * 4 + ((bx & 7) < 4 ? (bx & 7) : 4)); gwc = (bx - below) * NWAVES + wave; ngwc = (G - 16) * NWAVES; }
                        convert_matrix(args.in[IN_WIN] + (size_t)l * D * NIN, D, NIN, Wb, 2, 0, scr, gwc, ngwc, lane, gn); }
                    convert_matrix(args.in[IN_WPA] + (size_t)l * 1024 * D, 1024, D, (bf16*)(ws + WS_W + WO_PA), 0, 0, scr, gw, NGW, lane);
                    convert_matrix(args.in[IN_WPB] + (size_t)l * 512 * D, 512, D, (bf16*)(ws + WS_W + WO_PB), 0, 0, scr, gw, NGW, lane);
                    convert_matrix(args.in[IN_WPM] + (size_t)l * 512 * D, 512, D, (bf16*)(ws + WS_W + WO_PMM), 0, 0, scr, gw, NGW, lane);
                    convert_matrix(args.in[IN_WOUT] + (size_t)l * D * D, D, D, (bf16*)(ws + WS_W + WO_OUT), 0, 0, scr, gw, NGW, lane);
                }
#endif
                SEAM(pb + 3);
                if (RUN(pb + 4)) {
#pragma unroll 1
                    for (int q = 0; q < 2; ++q) {
                        pg8::Gemm g{q ? Wb + (size_t)NMAIN * D : XB, q ? XB : Wb, q ? NVT : M, q ? M : NMAIN, D, D, D}; pg8::StaticOrder S; S.init(g.M, g.N, G, bx);
                        pg8::EpiBf16 E{q ? VTb : PMb, q ? M : NMAIN, q ? 0u : ((1u << 16) | (1u << 18) | (2u << 24) | (2u << 26)), q ? nullptr : kml, q ? nullptr : RS, q ? RS : nullptr}; GEMM_PHASE_G3A(pg8::EpiBf16, g, S, E); }
                }
                SEAM(pb + 4);
                if (RUN(pb + 5)) {
                PHASE_IDS;
                    #ifndef DIS_LOCAL
                    hgrn_lb_table(lds, lbl, l, tid);
                    { v4u fbr[2] = {}; bf16x8 va[4] = {}; int u = vcu;
                      if (u < 2048) hgrn_local_load(PMb, VTb, u, tid, fbr, va);
#pragma unroll 1
                      for (; u < 2048; u += G) { v4u fbn[2] = {}; bf16x8 van[4] = {}; const bool nx = (u + G) < 2048;
                          if (nx) hgrn_local_load(PMb, VTb, u + G, tid, fbn, van);
                          hgrn_local_unit(lds, STb, DECb, u, tid, fbr, va);
                          if (nx) { fbr[0] = fbn[0]; fbr[1] = fbn[1]; va[0] = van[0]; va[1] = van[1]; va[2] = van[2]; va[3] = van[3]; } }
                      __syncthreads(); }
#endif
                    #ifndef DIS_SEL
                    for (int u = vcu; u < 1024; u += G) moba_sel_unit(lds, PMb, kml, SELb, u, tid);
#endif
                    #ifndef DIS_MEM
                    for (int u = vcu; u < 512; u += G) mem_attn_unit(lds, PMb, KMb + (size_t)l * 512 * 512, VMTb + (size_t)l * 512 * 512, u, tid);
#endif
                }
                SEAM(pb + 5);
                if (RUN(pb + 6)) {
                PHASE_IDS;
                    #ifndef DIS_PART
                    {
                        unsigned* qctr = (unsigned*)(ws + WS_CTL) + 12288 + 64 * l; LAS unsigned* qslot = (LAS unsigned*)(lds + WCNT_OFF + 32);
                        for (;;) {
                            if (tid == 0) *qslot = __hip_atomic_fetch_add(qctr, 1u, __ATOMIC_RELAXED, __HIP_MEMORY_SCOPE_AGENT);
                            LDS_WAIT(); __syncthreads();
                            const int u = (int)*qslot;
                            if (u >= 16 * 63) break;
                            moba_partial_task(lds, PMb, VTb, SELb, POb, MLb, u & 15, u >> 4, tid);
                        }
                    }
#endif
                    #ifndef DIS_SCAN
                    hgrn_scan(STb, DECb, vcu, G, tid);
#endif
                }
                SEAM(pb + 6);
                if (RUN(pb + 7)) {
                PHASE_IDS;
                    #ifndef DIS_OWN
                    for (int u = vcu; u < 1024; u += G) moba_own_unit(lds, PMb, VTb, SELb, POb, MLb, u, tid);
#endif
                    #ifndef DIS_HOUT
                    hgrn_lb_table(lds, lbl, l, tid);
                    { HoutPre P = {}; int u = vcu;
                      if (u < 2048) hgrn_out_load(PMb, VTb, STb, u, tid, P);
#pragma unroll 1
                      for (; u < 2048; u += G) { HoutPre Pn = {}; const bool nx = (u + G) < 2048;
                          if (nx) hgrn_out_load(PMb, VTb, STb, u + G, tid, Pn);
                          hgrn_out_unit(lds, PMb, args.in[IN_HON] + (size_t)l * 128, u, tid, P);
                          if (nx) P = Pn; }
                      __syncthreads(); }
#endif
                }
                SEAM(pb + 7);
                if (RUN(pb + 8)) { pg8::Gemm g{XB, Wb + (size_t)(NMAIN + NVT) * D, M, NGATE, D, D, D}; pg8::StaticOrder S; S.init(M, NGATE, G, bx); pg8::EpiGateU8 E{(unsigned char*)PGb, NGATE, RS}; GEMM_PHASE_G3B(pg8::EpiGateU8, g, S, E); }
                SEAM(pb + 8);
                if (RUN(pb + 9)) {
                    pg8::Gemm g{PMb, (bf16*)(ws + WS_W + WO_PA), M, D, 1024, NMAIN, 1024};
                    MergeOrderG4 S; S.T.init(M, D, G, bx); S.A0 = (const char*)PMb; S.W0 = (const char*)(ws + WS_W);
                    pg8::EpiMergeR E{YB, D, (const unsigned char*)PGb, NGATE}; GEMM_PHASE_MERGE(pg8::EpiMergeR, g, S, E);
                }
                SEAM(pb + 9);
                if (RUN(pb + 10)) { pg8::Gemm g{YB, (bf16*)(ws + WS_W + WO_OUT), M, D, D, D, D}; pg8::StaticOrder S; S.init(M, D, G, bx); pg8::EpiResid E{XB, D, 1.0f, SSQ}; GEMM_PHASE_OUT(pg8::EpiResid, g, S, E); }
                SEAM(pb + 10);
            }
        }
    }
#ifndef DIS_THIN
    if (RUN(PH_FINAL)) { PHASE_IDS; const float* gn = args.in[IN_FINN]; if (M % (4 * NGW) == 0) { for (int m = gw; m < M; m += 4 * NGW) rms_xb_f32_x4(XB + (size_t)m * D, (size_t)NGW * D, gn, out + (size_t)m * D, (size_t)NGW * D, lane); }
        else { for (int m = gw; m < M; m += NGW) rms_xb_f32(XB + (size_t)m * D, gn, out + (size_t)m * D, lane); } }
#endif
#undef RUN
#undef SEAM
}

extern "C" void kernel_launch(void* const* d_in, const int* in_sizes, int n_in, void* d_out, int out_size, void* d_ws, size_t ws_size, hipStream_t stream) {
    static int grid = 0;
    if (grid == 0) {
        if (n_in != 21 || in_sizes[0] != M * D || out_size != M * D || ws_size < WS_END) { fprintf(stderr, "kernel_launch: unexpected shapes (n_in %d, in0 %d, out %d, ws %zu); nothing launched\n", n_in, n_in > 0 ? in_sizes[0] : -1, out_size, ws_size); grid = -1; return; }
        int dev = 0, cus = 0, per_cu = 0;
        if (hipGetDevice(&dev) != hipSuccess || hipDeviceGetAttribute(&cus, hipDeviceAttributeMultiprocessorCount, dev) != hipSuccess) { grid = -1; return; }
        if (hipFuncSetAttribute((const void*)fwd, hipFuncAttributeMaxDynamicSharedMemorySize, LDS_BYTES) != hipSuccess) { fprintf(stderr, "kernel_launch: hipFuncSetAttribute failed\n"); grid = -1; return; }
        if (hipOccupancyMaxActiveBlocksPerMultiprocessor(&per_cu, (const void*)fwd, NWAVES * 64, LDS_BYTES) != hipSuccess || per_cu < 1) fprintf(stderr, "kernel_launch: note: occupancy query reports %d\n", per_cu);
        (void)hipGetLastError();
        grid = cus;
    }
    if (grid < 0) return;
    if (hipMemsetAsync((char*)d_ws + WS_CTL, 0, CTL_ZERO_BYTES, stream) != hipSuccess) return;
    Args a{};
    for (int i = 0; i < 21; ++i) a.in[i] = (const float*)d_in[i];
    a.out = (float*)d_out; a.ws = (unsigned char*)d_ws; a.ph_lo = 0; a.ph_hi = PH_TOTAL;
    hipLaunchKernelGGL(fwd, dim3(grid), dim3(NWAVES * 64), LDS_BYTES, stream, a);
}
```

```cpp
#include <hip/hip_runtime.h>
#include <cstdio>
#include <cstdint>

#define LAS __attribute__((address_space(3)))
#define GAS __attribute__((address_space(1)))
namespace pg8 {
#define PG8_LAS __attribute__((address_space(3)))
typedef unsigned short bf16_t;
typedef short bf16x8 __attribute__((ext_vector_type(8)));
typedef float f32x4 __attribute__((ext_vector_type(4)));
typedef unsigned u32x4 __attribute__((ext_vector_type(4)));
constexpr int BM = 256, BK = 64, HALF = 128, HTB = HALF * BK * 2  , STAGE_BYTES = 8 * HTB, NXCD = 8, WGM = 8;

__host__ __device__ __forceinline__ int lds_byte(int r, int c) { const int st = (r >> 4) * 2 + (c >> 5), rr = r & 15, cc = c & 31, ob = rr * 64 + cc * 2; return st * 1024 + (ob ^ (((ob >> 9) & 1) << 5)); }
__host__ __device__ __forceinline__ void stage_rc(int b, int& R, int& C) { const int st = b / 1024, sb = b % 1024, swz = sb ^ (((sb >> 9) & 1) << 5); R = (st >> 1) * 16 + swz / 64; C = (st & 1) * 32 + (swz % 64) / 2; }
__host__ __device__ __forceinline__ int perm32(int rho) { const int n = rho >> 4, i = rho & 15; return 8 * (i >> 2) + 4 * n + (i & 3); }

struct Unit { int pm, pn, q; };
struct Gemm { const bf16_t* A; const bf16_t* Bt; int M, N, K, lda, ldb; };

struct StaticOrder {
    static constexpr bool VARK = false;
    int nM, nN, nwg, G, c, wgm;
    __host__ __device__ void init(int M, int N, int G_, int c_) { nM = M / BM; nN = N / BM; nwg = nM * nN; G = G_; c = c_; wgm = (nN == 8) ? 4 : WGM; }
    __host__ __device__ bool next(int i, Unit& u) const {
        const long L = (long)i * G + c; if (L >= nwg) return false;
        int wgid = (int)L; { const int q = nwg / NXCD, r = nwg % NXCD, xcd = wgid % NXCD, off = wgid / NXCD; wgid = (xcd < r ? xcd * (q + 1) : r * (q + 1) + (xcd - r) * q) + off; }
        const int nig = wgm * nN, gid = wgid / nig, fm = gid * wgm, gsz = (nM - fm) < wgm ? (nM - fm) : wgm;
        u.pm = fm + ((wgid % nig) % gsz); u.pn = (wgid % nig) / gsz; u.q = 0; return true;
    }
    __device__ __forceinline__ void a_ready(const Unit&) const {}
    __device__ __forceinline__ void done(const Unit&) const {}
};

template <int AO0, int AO1, int AO2, long WO0, long WO1, long WO2>
struct MergeOrder {
    static constexpr bool VARK = true;
    StaticOrder T; const char* A0; const char* W0;
    __device__ __forceinline__ bool next(int i, Unit& u) const { const int r = i / 3; if (!T.next(r, u)) return false; u.q = i - 3 * r; return true; }
    __device__ __forceinline__ void params(const Unit& u, const char*& pA, const char*& pB, int& ldb, int& nt) const {
        const int q = u.q; pA = A0 + (q == 0 ? AO0 : q == 1 ? AO1 : AO2); pB = W0 + (q == 0 ? WO0 : q == 1 ? WO1 : WO2); ldb = (q == 0) ? 1024 : 512; nt = ldb / BK; }
    __device__ __forceinline__ void a_ready(const Unit&) const {}
    __device__ __forceinline__ void done(const Unit&) const {}
};
typedef float f32x2 __attribute__((ext_vector_type(2)));
typedef __bf16 bf16x2_t __attribute__((ext_vector_type(2)));
__device__ __forceinline__ unsigned cvt_pk_bf16(float lo, float hi) { const f32x2 v = {lo, hi}; return __builtin_bit_cast(unsigned, __builtin_convertvector(v, bf16x2_t)); }
__device__ __forceinline__ float fsigmoid(float x) { return __builtin_amdgcn_rcpf(1.0f + __builtin_amdgcn_exp2f(-1.4426950408889634f * x)); }
__device__ __forceinline__ float xor32_sum(float x) { const unsigned u = __builtin_bit_cast(unsigned, x); const auto r = __builtin_amdgcn_permlane32_swap(u, u, false, false); return __builtin_bit_cast(float, (unsigned)r[0]) + __builtin_bit_cast(float, (unsigned)r[1]); }
__device__ __forceinline__ float xor32_max(float x) { const unsigned u = __builtin_bit_cast(unsigned, x); const auto r = __builtin_amdgcn_permlane32_swap(u, u, false, false); return fmaxf(__builtin_bit_cast(float, (unsigned)r[0]), __builtin_bit_cast(float, (unsigned)r[1])); }
__device__ __forceinline__ float xor16_sum(float x) { const unsigned u = __builtin_bit_cast(unsigned, x); const auto r = __builtin_amdgcn_permlane16_swap(u, u, false, false); return __builtin_bit_cast(float, (unsigned)r[0]) + __builtin_bit_cast(float, (unsigned)r[1]); }
__device__ __forceinline__ unsigned xor32_other(unsigned u, int hi_half) { const auto r = __builtin_amdgcn_permlane32_swap(u, u, false, false); return hi_half ? (unsigned)r[0] : (unsigned)r[1]; }
__device__ __forceinline__ float row16_sum(float x) {
    x += __builtin_bit_cast(float, __builtin_amdgcn_mov_dpp(__builtin_bit_cast(int, x), 0xB1, 0xF, 0xF, true));
    x += __builtin_bit_cast(float, __builtin_amdgcn_mov_dpp(__builtin_bit_cast(int, x), 0x4E, 0xF, 0xF, true));
    x += __builtin_bit_cast(float, __builtin_amdgcn_mov_dpp(__builtin_bit_cast(int, x), 0x141, 0xF, 0xF, true));
    x += __builtin_bit_cast(float, __builtin_amdgcn_mov_dpp(__builtin_bit_cast(int, x), 0x140, 0xF, 0xF, true));
    return x;
}
__device__ __forceinline__ float bflo(unsigned w) { return __builtin_bit_cast(float, w << 16); }
__device__ __forceinline__ float bfhi(unsigned w) { return __builtin_bit_cast(float, w & 0xffff0000u); }

struct NoState {};
struct RowScale8 { float r[2][4]; };
struct EpiBf16 {
    static constexpr bool PERM = true, AFTER_DRAIN = false, KEEP = false;
    typedef RowScale8 State;
    __device__ __forceinline__ void load_state(State& st, const Unit& u, int wr, int fr) const {
#pragma unroll
        for (int ai = 0; ai < 2; ++ai)
#pragma unroll
            for (int m = 0; m < 4; ++m) st.r[ai][m] = rs ? rs[u.pm * BM + wr * 64 + fr + ai * HALF + m * 16] : 1.f; }
    bf16_t* O; int ldc; unsigned modes; float* km; const float* rs; const float* cs;
    __device__ __forceinline__ void operator()(const f32x4 (&acc_in)[2][2][4][2], const Unit& u, int wr, int wc, int fr, int fq, const State& st) const {
        const int row0 = u.pm * BM + wr * 64 + fr, col0 = u.pn * BM + wc * 32 + 8 * fq;
        const unsigned mode = (modes >> (2 * (u.pn & 15))) & 3u;
        f32x4 acc[2][2][4][2];
#pragma unroll
        for (int ai = 0; ai < 2; ++ai)
#pragma unroll
            for (int m = 0; m < 4; ++m) { const float r = st.r[ai][m];
#pragma unroll
                for (int bj = 0; bj < 2; ++bj)
#pragma unroll
                    for (int n = 0; n < 2; ++n) acc[ai][bj][m][n] = acc_in[ai][bj][m][n] * r; }
        if (cs) {
#pragma unroll
            for (int bj = 0; bj < 2; ++bj) { const f32x4 c0 = *(const f32x4*)(cs + col0 + bj * HALF), c1 = *(const f32x4*)(cs + col0 + bj * HALF + 4);
#pragma unroll
                for (int ai = 0; ai < 2; ++ai)
#pragma unroll
                    for (int m = 0; m < 4; ++m) { acc[ai][bj][m][0] = acc[ai][bj][m][0] * c0; acc[ai][bj][m][1] = acc[ai][bj][m][1] * c1; } } }
#pragma unroll
        for (int ai = 0; ai < 2; ++ai)
#pragma unroll
            for (int m = 0; m < 4; ++m) { bf16_t* rowp = O + (size_t)(row0 + ai * HALF + m * 16) * ldc + col0;
#pragma unroll
                for (int bj = 0; bj < 2; ++bj) { f32x4 v0 = acc[ai][bj][m][0], v1 = acc[ai][bj][m][1];
                    if (mode != 0u) {
#pragma unroll
                        for (int j = 0; j < 4; ++j) { const float s0 = fsigmoid(v0[j]), s1 = fsigmoid(v1[j]); v0[j] = (mode == 1u) ? v0[j] * s0 : s0; v1[j] = (mode == 1u) ? v1[j] * s1 : s1; } }
                    u32x4 w; w.x = cvt_pk_bf16(v0[0], v0[1]); w.y = cvt_pk_bf16(v0[2], v0[3]); w.z = cvt_pk_bf16(v1[0], v1[1]); w.w = cvt_pk_bf16(v1[2], v1[3]);
                    *(u32x4*)(rowp + bj * HALF) = w; } }
        if (km != nullptr && u.pn >= 4 && u.pn < 8) {
            const int b = u.pm >> 6, blk = u.pm & 63;
#pragma unroll
            for (int bj = 0; bj < 2; ++bj)
#pragma unroll
                for (int n = 0; n < 2; ++n)
#pragma unroll
                    for (int e = 0; e < 4; ++e) {
                        float s = 0.f;
#pragma unroll
                        for (int ai = 0; ai < 2; ++ai)
#pragma unroll
                            for (int m = 0; m < 4; ++m) s += acc[ai][bj][m][n][e];
                        s = row16_sum(s);
                        if (fr == 0) { const int c = (u.pn - 4) * BM + bj * HALF + wc * 32 + 8 * fq + 4 * n + e, hd = c >> 7, d = c & 127;
                            __hip_atomic_fetch_add(km + ((size_t)((b * 8 + hd) * 64 + blk)) * 128 + d, s, __ATOMIC_RELAXED, __HIP_MEMORY_SCOPE_AGENT); }
                    }
        }
    }
};
struct EpiGateU8 {
    static constexpr bool PERM = true, AFTER_DRAIN = false, KEEP = false;
    unsigned char* O; int ldc; const float* rs;
    typedef RowScale8 State;
    __device__ __forceinline__ void load_state(State& st, const Unit& u, int wr, int fr) const {
#pragma unroll
        for (int ai = 0; ai < 2; ++ai)
#pragma unroll
            for (int m = 0; m < 4; ++m) st.r[ai][m] = rs[u.pm * BM + wr * 64 + fr + ai * HALF + m * 16]; }
    __device__ __forceinline__ void operator()(const f32x4 (&acc)[2][2][4][2], const Unit& u, int wr, int wc, int fr, int fq, const State& st) const {
        unsigned char* const tb = O + ((size_t)(u.pm * (ldc / BM) + u.pn) * 8 + (size_t)(wr * 4 + wc)) * 8192;
        const unsigned voff = (unsigned)(fr + 16 * fq) * 16u;
#pragma unroll
        for (int ai = 0; ai < 2; ++ai)
#pragma unroll
            for (int m = 0; m < 4; ++m) { const float rc = -1.4426950408889634f * st.r[ai][m]; unsigned q[2][8];
#pragma unroll
                for (int bj = 0; bj < 2; ++bj) {
#pragma unroll
                    for (int j = 0; j < 4; ++j) { q[bj][j] = (unsigned)fmaxf(__builtin_fmaf(__builtin_amdgcn_rcpf(1.0f + __builtin_amdgcn_exp2f(acc[ai][bj][m][0][j] * rc)), 255.f, 0.5f), 1.f); q[bj][4 + j] = (unsigned)fmaxf(__builtin_fmaf(__builtin_amdgcn_rcpf(1.0f + __builtin_amdgcn_exp2f(acc[ai][bj][m][1][j] * rc)), 255.f, 0.5f), 1.f); } }
                u32x4 w; w.x = q[0][0] | (q[0][1] << 8) | (q[0][2] << 16) | (q[0][3] << 24); w.y = q[0][4] | (q[0][5] << 8) | (q[0][6] << 16) | (q[0][7] << 24);
                w.z = q[1][0] | (q[1][1] << 8) | (q[1][2] << 16) | (q[1][3] << 24); w.w = q[1][4] | (q[1][5] << 8) | (q[1][6] << 16) | (q[1][7] << 24);
                *(u32x4*)(tb + (ai * 4 + m) * 1024 + voff) = w; }
    }
};
struct EpiSwiglu {
    static constexpr bool PERM = true, AFTER_DRAIN = false, KEEP = false;
    bf16_t* O; int ldc; const float* rs;
    typedef RowScale8 State;
    __device__ __forceinline__ void load_state(State& st, const Unit& u, int wr, int fr) const {
#pragma unroll
        for (int ai = 0; ai < 2; ++ai)
#pragma unroll
            for (int m = 0; m < 4; ++m) st.r[ai][m] = rs[u.pm * BM + wr * 64 + fr + ai * HALF + m * 16]; }
    __device__ __forceinline__ void operator()(const f32x4 (&acc)[2][2][4][2], const Unit& u, int wr, int wc, int fr, int fq, const State& st) const {
        const int row0 = u.pm * BM + wr * 64 + fr, col0 = u.pn * HALF + wc * 32 + 8 * fq;
#pragma unroll
        for (int ai = 0; ai < 2; ++ai)
#pragma unroll
            for (int m = 0; m < 4; ++m) { bf16_t* rowp = O + (size_t)(row0 + ai * HALF + m * 16) * ldc + col0; const float r = st.r[ai][m];
                const float rc = -1.4426950408889634f * r, r2 = r * r;
                const f32x4 a0 = acc[ai][0][m][0], a1 = acc[ai][0][m][1];
                const f32x4 p0 = (a0 * acc[ai][1][m][0]) * r2, p1 = (a1 * acc[ai][1][m][1]) * r2, x0 = a0 * rc, x1 = a1 * rc;
                f32x4 h0, h1;
#pragma unroll
                for (int j = 0; j < 4; ++j) { h0[j] = p0[j] * __builtin_amdgcn_rcpf(1.0f + __builtin_amdgcn_exp2f(x0[j])); h1[j] = p1[j] * __builtin_amdgcn_rcpf(1.0f + __builtin_amdgcn_exp2f(x1[j])); }
                u32x4 w; w.x = cvt_pk_bf16(h0[0], h0[1]); w.y = cvt_pk_bf16(h0[2], h0[3]); w.z = cvt_pk_bf16(h1[0], h1[1]); w.w = cvt_pk_bf16(h1[2], h1[3]);
                *(u32x4*)rowp = w; }
    }
};
struct EpiResid {
    static constexpr bool PERM = true, AFTER_DRAIN = false, KEEP = false;
    bf16_t* X; int ld; float scale; float* ssq;
    typedef NoState State;
    __device__ __forceinline__ void load_state(State&, const Unit&, int, int) const {}
    __device__ __forceinline__ void operator()(const f32x4 (&acc)[2][2][4][2], const Unit& u, int wr, int wc, int fr, int fq, const State&) const {
        const int row0 = u.pm * BM + wr * 64 + fr, col0 = u.pn * BM + wc * 32 + 8 * fq;
        u32x4 x[2][4][2];
#pragma unroll
        for (int ai = 0; ai < 2; ++ai)
#pragma unroll
            for (int m = 0; m < 4; ++m)
#pragma unroll
                for (int bj = 0; bj < 2; ++bj) x[ai][m][bj] = *(const u32x4*)(X + (size_t)(row0 + ai * HALF + m * 16) * ld + col0 + bj * HALF);
        asm volatile("" ::: "memory");
#pragma unroll
        for (int ai = 0; ai < 2; ++ai)
#pragma unroll
            for (int m = 0; m < 4; ++m)
            { float sq = 0.f;
#pragma unroll
                for (int bj = 0; bj < 2; ++bj) { const f32x4 v0 = acc[ai][bj][m][0], v1 = acc[ai][bj][m][1]; const u32x4 xx = x[ai][m][bj];
                    u32x4 w;
                    w.x = cvt_pk_bf16(bflo(xx.x) + scale * v0[0], bfhi(xx.x) + scale * v0[1]);
                    w.y = cvt_pk_bf16(bflo(xx.y) + scale * v0[2], bfhi(xx.y) + scale * v0[3]);
                    w.z = cvt_pk_bf16(bflo(xx.z) + scale * v1[0], bfhi(xx.z) + scale * v1[1]);
                    w.w = cvt_pk_bf16(bflo(xx.w) + scale * v1[2], bfhi(xx.w) + scale * v1[3]);
                    *(u32x4*)(X + (size_t)(row0 + ai * HALF + m * 16) * ld + col0 + bj * HALF) = w;
                    const float a0 = bflo(w.x), a1 = bfhi(w.x), a2 = bflo(w.y), a3 = bfhi(w.y), a4 = bflo(w.z), a5 = bfhi(w.z), a6 = bflo(w.w), a7 = bfhi(w.w);
                    sq += ((a0 * a0 + a1 * a1) + (a2 * a2 + a3 * a3)) + ((a4 * a4 + a5 * a5) + (a6 * a6 + a7 * a7)); }
                sq = xor32_sum(xor16_sum(sq));
                if (fq == 0) ssq[(size_t)(row0 + ai * HALF + m * 16) * 32 + u.pn * 4 + wc] = sq; }
        asm volatile("" ::: "memory");
    }
};
struct EpiMerge {
    static constexpr bool PERM = true, AFTER_DRAIN = false, KEEP = false;
    bf16_t* Y; int ldy; const unsigned char* Gt0; int ldg;
    typedef NoState State;
    __device__ __forceinline__ void load_state(State&, const Unit&, int, int) const {}
    __device__ __forceinline__ void operator()(const f32x4 (&acc)[2][2][4][2], const Unit& u, int wr, int wc, int fr, int fq, const State&) const {
        const int row0 = u.pm * BM + wr * 64 + fr, col0 = u.pn * BM + wc * 32 + 8 * fq;
        const unsigned char* Gt = Gt0 + u.q * ldy; const bool first = (u.q == 0);
#pragma unroll
        for (int ai = 0; ai < 2; ++ai) {
            typedef unsigned u32x2v __attribute__((ext_vector_type(2)));
            u32x2v g[4][2]; u32x4 yo[4][2];
#pragma unroll
            for (int m = 0; m < 4; ++m) { const size_t r = (size_t)(row0 + ai * HALF + m * 16);
#pragma unroll
                for (int bj = 0; bj < 2; ++bj) { g[m][bj] = *(const u32x2v*)(Gt + r * ldg + col0 + bj * HALF); yo[m][bj] = (u32x4){0u, 0u, 0u, 0u}; if (!first) yo[m][bj] = *(const u32x4*)(Y + r * ldy + col0 + bj * HALF); } }
            asm volatile("" ::: "memory");
#pragma unroll
            for (int m = 0; m < 4; ++m) { const size_t r = (size_t)(row0 + ai * HALF + m * 16);
#pragma unroll
                for (int bj = 0; bj < 2; ++bj) { const f32x4 v0 = acc[ai][bj][m][0], v1 = acc[ai][bj][m][1]; const u32x2v gg = g[m][bj]; const u32x4 yy = yo[m][bj]; constexpr float Q = 1.f / 255.f;
                    const float g0 = Q * (float)(gg.x & 255u), g1 = Q * (float)((gg.x >> 8) & 255u), g2 = Q * (float)((gg.x >> 16) & 255u), g3 = Q * (float)(gg.x >> 24);
                    const float g4 = Q * (float)(gg.y & 255u), g5 = Q * (float)((gg.y >> 8) & 255u), g6 = Q * (float)((gg.y >> 16) & 255u), g7 = Q * (float)(gg.y >> 24);
                    u32x4 w;
                    w.x = cvt_pk_bf16(bflo(yy.x) + g0 * v0[0], bfhi(yy.x) + g1 * v0[1]);
                    w.y = cvt_pk_bf16(bflo(yy.y) + g2 * v0[2], bfhi(yy.y) + g3 * v0[3]);
                    w.z = cvt_pk_bf16(bflo(yy.z) + g4 * v1[0], bfhi(yy.z) + g5 * v1[1]);
                    w.w = cvt_pk_bf16(bflo(yy.w) + g6 * v1[2], bfhi(yy.w) + g7 * v1[3]);
                    *(u32x4*)(Y + r * ldy + col0 + bj * HALF) = w; } }
            asm volatile("" ::: "memory");
        }
    }
};
struct EpiMergeR {
    static constexpr bool PERM = true, AFTER_DRAIN = false, KEEP = true;
    bf16_t* Y; int ldy; const unsigned char* Gt0; int ldg;
    typedef NoState State;
    __device__ __forceinline__ void load_state(State&, const Unit&, int, int) const {}
    static __device__ __forceinline__ float ub0(unsigned x) { return (float)(x & 255u); }
    static __device__ __forceinline__ float ub1(unsigned x) { return (float)((x >> 8) & 255u); }
    static __device__ __forceinline__ float ub2(unsigned x) { return (float)((x >> 16) & 255u); }
    static __device__ __forceinline__ float ub3(unsigned x) { return (float)(x >> 24); }
    __device__ __forceinline__ void operator()(f32x4 (&acc)[2][2][4][2], const Unit& u, int wr, int wc, int fr, int fq, const State&) const {
        typedef unsigned u32x2v __attribute__((ext_vector_type(2)));
        const int row0 = u.pm * BM + wr * 64 + fr, col0 = u.pn * BM + wc * 32 + 8 * fq;
        const unsigned char* const gp = Gt0 + ((size_t)(u.pm * (ldg / BM) + u.q * (ldy / BM) + u.pn) * 8 + (size_t)(wr * 4 + wc)) * 8192;
        const unsigned voffg = (unsigned)(fr + 16 * fq) * 16u;
        constexpr size_t NEXTQ = (size_t)8 * 65536;
        if (u.q < 2) {
            u32x2v ga[2][4][2], gb[2][4][2];
#pragma unroll
            for (int ai = 0; ai < 2; ++ai)
#pragma unroll
                for (int m = 0; m < 4; ++m) { const u32x4 wa = *(const u32x4*)(gp + (ai * 4 + m) * 1024 + voffg), wb = *(const u32x4*)(gp + NEXTQ + (ai * 4 + m) * 1024 + voffg);
                    ga[ai][m][0] = (u32x2v){wa.x, wa.y}; ga[ai][m][1] = (u32x2v){wa.z, wa.w}; gb[ai][m][0] = (u32x2v){wb.x, wb.y}; gb[ai][m][1] = (u32x2v){wb.z, wb.w}; }
            asm volatile("" ::: "memory");
#pragma unroll
            for (int ai = 0; ai < 2; ++ai)
#pragma unroll
                for (int m = 0; m < 4; ++m)
#pragma unroll
                    for (int bj = 0; bj < 2; ++bj) { const u32x2v a = ga[ai][m][bj], b = gb[ai][m][bj]; f32x4 v0 = acc[ai][bj][m][0], v1 = acc[ai][bj][m][1];
                        v0[0] *= ub0(a.x) * __builtin_amdgcn_rcpf(ub0(b.x)); v0[1] *= ub1(a.x) * __builtin_amdgcn_rcpf(ub1(b.x)); v0[2] *= ub2(a.x) * __builtin_amdgcn_rcpf(ub2(b.x)); v0[3] *= ub3(a.x) * __builtin_amdgcn_rcpf(ub3(b.x));
                        v1[0] *= ub0(a.y) * __builtin_amdgcn_rcpf(ub0(b.y)); v1[1] *= ub1(a.y) * __builtin_amdgcn_rcpf(ub1(b.y)); v1[2] *= ub2(a.y) * __builtin_amdgcn_rcpf(ub2(b.y)); v1[3] *= ub3(a.y) * __builtin_amdgcn_rcpf(ub3(b.y));
                        acc[ai][bj][m][0] = v0; acc[ai][bj][m][1] = v1; }
        } else {
            u32x2v g[2][4][2];
#pragma unroll
            for (int ai = 0; ai < 2; ++ai)
#pragma unroll
                for (int m = 0; m < 4; ++m)
                { const u32x4 wa = *(const u32x4*)(gp + (ai * 4 + m) * 1024 + voffg); g[ai][m][0] = (u32x2v){wa.x, wa.y}; g[ai][m][1] = (u32x2v){wa.z, wa.w}; }
            asm volatile("" ::: "memory");
#pragma unroll
            for (int ai = 0; ai < 2; ++ai)
#pragma unroll
                for (int m = 0; m < 4; ++m)
#pragma unroll
                    for (int bj = 0; bj < 2; ++bj) { const u32x2v gg = g[ai][m][bj]; const f32x4 v0 = acc[ai][bj][m][0], v1 = acc[ai][bj][m][1]; constexpr float Q = 1.f / 255.f;
                        u32x4 w;
                        w.x = cvt_pk_bf16(v0[0] * (Q * ub0(gg.x)), v0[1] * (Q * ub1(gg.x))); w.y = cvt_pk_bf16(v0[2] * (Q * ub2(gg.x)), v0[3] * (Q * ub3(gg.x)));
                        w.z = cvt_pk_bf16(v1[0] * (Q * ub0(gg.y)), v1[1] * (Q * ub1(gg.y))); w.w = cvt_pk_bf16(v1[2] * (Q * ub2(gg.y)), v1[3] * (Q * ub3(gg.y)));
                        *(u32x4*)(Y + (size_t)(row0 + ai * HALF + m * 16) * ldy + col0 + bj * HALF) = w; }
            asm volatile("" ::: "memory");
        }
    }
};
template <bool PERM>
__device__ __forceinline__ void voffb_for(int ldb, unsigned (&v)[2]) {
    int t = threadIdx.x; asm volatile("" : "+v"(t));
#pragma unroll
    for (int i = 0; i < 2; ++i) { int R, C; stage_rc(t * 16 + i * 8192, R, C); const int Rb = PERM ? ((R & ~31) + perm32(R & 31)) : R; v[i] = (unsigned)(Rb * ldb + C) * 2u; }
}
template <class Epi, class Sched, bool ALIGN_EPI = false, bool SP2 = false>
__device__ __forceinline__ void gemm_phase(PG8_LAS unsigned char* lds, const Gemm g, const Sched& S, const Epi& E) {
    int tid_ = threadIdx.x; asm volatile("" : "+v"(tid_));
    const int tid = tid_, wid = __builtin_amdgcn_readfirstlane(tid >> 6), lane = tid & 63, wr = wid >> 2, wc = wid & 3, fr = lane & 15, fq = lane >> 4;
    const int K = g.K; int nt = K / BK;
    unsigned voffA[2], voffB[2];
#pragma unroll
    for (int i = 0; i < 2; ++i) { int R, C; stage_rc(tid * 16 + i * 8192, R, C); const int Rb = Epi::PERM ? ((R & ~31) + perm32(R & 31)) : R;
        voffA[i] = (unsigned)(R * g.lda + C) * 2u; voffB[i] = (unsigned)(Rb * g.ldb + C) * 2u; }
    const size_t kstep = (size_t)(BK * 2);
    const size_t hstepA = (size_t)HALF * g.lda * 2; size_t hstepB = (size_t)HALF * g.ldb * 2;
    const size_t tstepA = 2 * hstepA; const size_t tstepB = 2 * hstepB;
    const unsigned ldsw = (unsigned)wid * 1024u;
    const int aoff = lds_byte(wr * 64 + fr, fq * 8), boff = lds_byte(wc * 32 + fr, fq * 8);
#define PG8_SA(b, h) (((b) * 2 + (h)) * HTB)
#define PG8_SB(b, h) ((4 + (b) * 2 + (h)) * HTB)
#define PG8_STAGE(bufoff, gbase, voff) do { _Pragma("unroll") for (int _i = 0; _i < 2; ++_i) \
        __builtin_amdgcn_global_load_lds((const unsigned*)((const char*)(gbase) + (voff)[_i]), (PG8_LAS unsigned*)(lds + (bufoff) + ldsw + _i * 8192), 16, 0, 0); } while (0)
#define PG8_LDA(dst, b, h) do { _Pragma("unroll") for (int m = 0; m < 4; ++m) _Pragma("unroll") for (int k = 0; k < 2; ++k) dst[m][k] = *(const PG8_LAS bf16x8*)(lds + PG8_SA(b, h) + aoff + m * 2048 + k * 1024); } while (0)
#define PG8_LDB(dst, b, h) do { _Pragma("unroll") for (int n = 0; n < 2; ++n) _Pragma("unroll") for (int k = 0; k < 2; ++k) dst[n][k] = *(const PG8_LAS bf16x8*)(lds + PG8_SB(b, h) + boff + n * 2048 + k * 1024); } while (0)
#define PG8_MMA(ai, bj, At, Bt) do { __builtin_amdgcn_s_setprio(1); _Pragma("unroll") for (int m = 0; m < 4; ++m) _Pragma("unroll") for (int n = 0; n < 2; ++n) _Pragma("unroll") for (int k = 0; k < 2; ++k) \
        acc[ai][bj][m][n] = __builtin_amdgcn_mfma_f32_16x16x32_bf16(Bt[n][k], At[m][k], acc[ai][bj][m][n], 0, 0, 0); __builtin_amdgcn_s_setprio(0); } while (0)
#define PG8_WAIT_V(n) asm volatile("s_waitcnt vmcnt(" #n ")" ::: "memory")
#define PG8_WAIT_L(n) asm volatile("s_waitcnt lgkmcnt(" #n ")" ::: "memory")
#define PG8_BAR __builtin_amdgcn_s_barrier()
#define PG8_SCHED __builtin_amdgcn_sched_barrier(0)
    Unit cur, nxt; int ui = 0;
    if (!S.next(0, cur)) return;
    f32x4 acc[2][2][4][2];
#pragma unroll
    for (int a = 0; a < 2; ++a)
#pragma unroll
        for (int b = 0; b < 2; ++b)
#pragma unroll
            for (int m = 0; m < 4; ++m)
#pragma unroll
                for (int n = 0; n < 2; ++n) acc[a][b][m][n] = (f32x4){0.f, 0.f, 0.f, 0.f};
    bf16x8 At[4][2], B0[2][2], B1[2][2];
    const char* cA = (const char*)g.A + (size_t)cur.pm * tstepA; const char* cB = (const char*)g.Bt + (size_t)cur.pn * tstepB;
    if constexpr (Sched::VARK) { const char* pA; const char* pB; int ldbc; S.params(cur, pA, pB, ldbc, nt); hstepB = (size_t)HALF * ldbc * 2; cA = pA + (size_t)cur.pm * tstepA; cB = pB + (size_t)cur.pn * (2 * hstepB);
        voffb_for<Epi::PERM>(ldbc, voffB); }
    typename Epi::State est; E.load_state(est, cur, wr, fr);
    S.a_ready(cur);
    if constexpr (SP2) {
        PG8_STAGE(PG8_SB(0, 0), cB, voffB); PG8_STAGE(PG8_SB(0, 1), cB + hstepB, voffB); PG8_STAGE(PG8_SA(0, 0), cA, voffA); PG8_STAGE(PG8_SA(0, 1), cA + hstepA, voffA);
        if (wr == 1) PG8_BAR;
        PG8_WAIT_V(2); PG8_BAR;
        PG8_STAGE(PG8_SB(1, 0), cB + kstep, voffB); PG8_STAGE(PG8_SA(1, 0), cA + kstep, voffA); PG8_STAGE(PG8_SB(1, 1), cB + hstepB + kstep, voffB);
        PG8_WAIT_V(6); PG8_BAR;
    } else {
        PG8_STAGE(PG8_SB(0, 0), cB, voffB); PG8_STAGE(PG8_SA(0, 0), cA, voffA); PG8_STAGE(PG8_SB(0, 1), cB + hstepB, voffB); PG8_STAGE(PG8_SA(0, 1), cA + hstepA, voffA);
        if (wr == 1) PG8_BAR;
        PG8_WAIT_V(4); PG8_BAR;
        PG8_STAGE(PG8_SB(1, 0), cB + kstep, voffB); PG8_STAGE(PG8_SA(1, 0), cA + kstep, voffA); PG8_STAGE(PG8_SB(1, 1), cB + hstepB + kstep, voffB);
        PG8_WAIT_V(6); PG8_BAR;
    }
    for (;;) {
        const bool has_next = S.next(ui + 1, nxt);
        const char* nA = has_next ? (const char*)g.A + (size_t)nxt.pm * tstepA : cA; const char* nB = has_next ? (const char*)g.Bt + (size_t)nxt.pn * tstepB : cB;
        unsigned voffBn[2] = {voffB[0], voffB[1]}; size_t hstepBn = hstepB; int ntn = nt;
        if constexpr (Sched::VARK) { if (has_next) { const char* pA; const char* pB; int ldbn; S.params(nxt, pA, pB, ldbn, ntn); hstepBn = (size_t)HALF * ldbn * 2; nA = pA + (size_t)nxt.pm * tstepA; nB = pB + (size_t)nxt.pn * (2 * hstepBn);
            voffb_for<Epi::PERM>(ldbn, voffBn); } }
        for (int t = 0; t < nt; t += 2) {
            const bool last = (t == nt - 2);
            const char* a1 = cA + (size_t)(t + 1) * kstep;
            const char* a2 = last ? nA : cA + (size_t)(t + 2) * kstep; const char* b2 = last ? nB : cB + (size_t)(t + 2) * kstep;
            const char* a3 = a2 + kstep; const char* b3 = b2 + kstep;
            if (last && has_next) S.a_ready(nxt);
            unsigned vBs[2]; size_t hsb;
            if constexpr (Sched::VARK) { vBs[0] = last ? voffBn[0] : voffB[0]; vBs[1] = last ? voffBn[1] : voffB[1]; hsb = last ? hstepBn : hstepB; } else { vBs[0] = voffB[0]; vBs[1] = voffB[1]; hsb = hstepB; }
            if constexpr (SP2) {
            PG8_LDB(B0, 0, 0); PG8_LDB(B1, 0, 1); PG8_SCHED; PG8_LDA(At, 0, 0); PG8_STAGE(PG8_SA(1, 1), a1 + hstepA, voffA);
            PG8_WAIT_V(8); PG8_WAIT_L(0); PG8_BAR; PG8_MMA(0, 0, At, B0); PG8_MMA(0, 1, At, B1); PG8_BAR; PG8_SCHED;
            PG8_LDA(At, 0, 1); PG8_STAGE(PG8_SB(0, 0), b2, vBs); PG8_STAGE(PG8_SB(0, 1), b2 + hsb, vBs); PG8_STAGE(PG8_SA(0, 0), a2, voffA);
            PG8_WAIT_V(8); PG8_WAIT_L(0); PG8_BAR; PG8_MMA(1, 0, At, B0); PG8_MMA(1, 1, At, B1); PG8_BAR; PG8_SCHED;
            PG8_LDB(B0, 1, 0); PG8_LDB(B1, 1, 1); PG8_SCHED; PG8_LDA(At, 1, 0); PG8_STAGE(PG8_SA(0, 1), a2 + hstepA, voffA);
            PG8_WAIT_V(8); PG8_WAIT_L(0); PG8_BAR; PG8_MMA(0, 0, At, B0); PG8_MMA(0, 1, At, B1); PG8_BAR; PG8_SCHED;
            PG8_LDA(At, 1, 1); PG8_STAGE(PG8_SB(1, 0), b3, vBs); PG8_STAGE(PG8_SB(1, 1), b3 + hsb, vBs); PG8_STAGE(PG8_SA(1, 0), a3, voffA);
            PG8_WAIT_V(8); PG8_WAIT_L(0); PG8_BAR; PG8_MMA(1, 0, At, B0); PG8_MMA(1, 1, At, B1); PG8_BAR; PG8_SCHED;
            } else {
            PG8_LDB(B0, 0, 0); PG8_SCHED; PG8_LDA(At, 0, 0); PG8_STAGE(PG8_SA(1, 1), a1 + hstepA, voffA);
            PG8_WAIT_L(8); PG8_BAR; PG8_WAIT_L(0); PG8_MMA(0, 0, At, B0); PG8_BAR; PG8_SCHED;
            PG8_LDB(B1, 0, 1); PG8_STAGE(PG8_SB(0, 0), b2, voffB);
            PG8_BAR; PG8_WAIT_L(0); PG8_MMA(0, 1, At, B1); PG8_BAR;
            PG8_LDA(At, 0, 1); PG8_STAGE(PG8_SA(0, 0), a2, voffA);
            PG8_BAR; PG8_WAIT_L(0); PG8_MMA(1, 0, At, B0); PG8_BAR; PG8_SCHED;
            PG8_STAGE(PG8_SB(0, 1), b2 + hstepB, voffB);
            PG8_WAIT_V(6); PG8_BAR; PG8_MMA(1, 1, At, B1); PG8_BAR;
            PG8_LDB(B0, 1, 0); PG8_SCHED; PG8_LDA(At, 1, 0); PG8_STAGE(PG8_SA(0, 1), a2 + hstepA, voffA);
            PG8_WAIT_L(8); PG8_BAR; PG8_WAIT_L(0); PG8_MMA(0, 0, At, B0); PG8_BAR; PG8_SCHED;
            PG8_LDB(B1, 1, 1); PG8_STAGE(PG8_SB(1, 0), b3, voffB);
            PG8_BAR; PG8_WAIT_L(0); PG8_MMA(0, 1, At, B1); PG8_BAR;
            PG8_LDA(At, 1, 1); PG8_STAGE(PG8_SA(1, 0), a3, voffA);
            PG8_BAR; PG8_WAIT_L(0); PG8_MMA(1, 0, At, B0); PG8_BAR; PG8_SCHED;
            PG8_STAGE(PG8_SB(1, 1), b3 + hstepB, voffB);
            PG8_WAIT_V(6); PG8_BAR; PG8_MMA(1, 1, At, B1); PG8_BAR;
            }
        }
        if constexpr (ALIGN_EPI) { if (wr == 0) PG8_BAR; }
        if constexpr (!Epi::AFTER_DRAIN) { E(acc, cur, wr, wc, fr, fq, est); S.done(cur); }
        if (!has_next) break;
        if (!Epi::KEEP || cur.q == 2) {
#pragma unroll
        for (int a = 0; a < 2; ++a)
#pragma unroll
            for (int b = 0; b < 2; ++b)
#pragma unroll
                for (int m = 0; m < 4; ++m)
#pragma unroll
                    for (int n = 0; n < 2; ++n) acc[a][b][m][n] = (f32x4){0.f, 0.f, 0.f, 0.f};
        }
        cur = nxt; cA = nA; cB = nB; ++ui; E.load_state(est, cur, wr, fr);
        if constexpr (Sched::VARK) { voffB[0] = voffBn[0]; voffB[1] = voffBn[1]; hstepB = hstepBn; nt = ntn; }
        if constexpr (ALIGN_EPI) { if (wr == 1) PG8_BAR; }
    }
    PG8_WAIT_V(0);
    if constexpr (!ALIGN_EPI) { if (wr == 0) PG8_BAR; }
    PG8_BAR;
    if constexpr (Epi::AFTER_DRAIN) { E.fused(acc, cur, wr, wc, fr, fq, lds, wid, lane); S.done(cur); }
#undef PG8_SA
#undef PG8_SB
#undef PG8_STAGE
#undef PG8_LDA
#undef PG8_LDB
#undef PG8_MMA
#undef PG8_WAIT_V
#undef PG8_WAIT_L
#undef PG8_BAR
#undef PG8_SCHED
}
}

typedef unsigned short bf16;
typedef unsigned v4u __attribute__((ext_vector_type(4)));
typedef unsigned v2u __attribute__((ext_vector_type(2)));
typedef float f32x4 __attribute__((ext_vector_type(4)));
typedef float f32x16 __attribute__((ext_vector_type(16)));
typedef short bf16x8 __attribute__((ext_vector_type(8)));
typedef GAS unsigned gu32;
#define RLX_AGENT __ATOMIC_RELAXED, __HIP_MEMORY_SCOPE_AGENT
#define LDS_WAIT() asm volatile("s_waitcnt lgkmcnt(0)" ::: "memory")
#define VM_WAIT() asm volatile("s_waitcnt vmcnt(0)" ::: "memory")
#define MFMA32(a, b, c) __builtin_amdgcn_mfma_f32_32x32x16_bf16((a), (b), (c), 0, 0, 0)
__device__ __forceinline__ unsigned f2bf(float f) { return pg8::cvt_pk_bf16(f, 0.f) & 0xffffu; }
__device__ __forceinline__ unsigned pk2(float lo, float hi) { return pg8::cvt_pk_bf16(lo, hi); }
__device__ __forceinline__ float bf2f(unsigned short b) { return __builtin_bit_cast(float, (unsigned)b << 16); }
using pg8::bflo; using pg8::bfhi; using pg8::fsigmoid;
__device__ __forceinline__ float fexp2(float x) { return __builtin_amdgcn_exp2f(x); }
__device__ __forceinline__ float fexp(float x) { return __builtin_amdgcn_exp2f(1.4426950408889634f * x); }
__device__ __forceinline__ bf16x8 as_bf16x8(v4u v) { return __builtin_bit_cast(bf16x8, v); }

constexpr int BATCH = 2, T = 16384, D = 2048, M = BATCH * T, DFF = 5632, NMEM = 256, DEPTH = 2;
constexpr int NMAIN = 4096, NVT = 1536, NGATE = 6144, NIN = 11776;
constexpr int CQA = 0, CKA = 1024, CQB = 2048, CFB = 2560, CGB = 3072, CQM = 3584;
constexpr int NWAVES = 8;
constexpr float RMS_EPS = 1e-6f;
constexpr size_t MiB = 1u << 20;
constexpr size_t WS_CTL = 0, CTL_ZERO_BYTES = 2 * MiB;
constexpr size_t WS_KMEAN = 1 * MiB;
constexpr size_t WS_R0 = 2 * MiB;
constexpr size_t WS_PM = 130 * MiB;
constexpr size_t WS_VT = 386 * MiB;
constexpr size_t WS_PG = 482 * MiB;
constexpr size_t WS_PO = WS_PG;
constexpr size_t WS_ML = WS_PG + 192 * MiB;
constexpr size_t WS_ST = WS_PG + 200 * MiB;
constexpr size_t WS_DEC = WS_PG + 328 * MiB;
constexpr size_t WS_SEL = WS_PG + 330 * MiB;
constexpr size_t WS_W = 866 * MiB;
constexpr size_t WS_MEMN = 932 * MiB;
constexpr size_t WS_WKV = 936 * MiB;
constexpr size_t WS_KM = 944 * MiB;
constexpr size_t WS_VMT = 945 * MiB;
constexpr size_t WS_RS = 946 * MiB;
constexpr size_t WS_SSQ = 947 * MiB;
constexpr size_t WS_END = 951 * MiB;
constexpr size_t WO_W2 = 44 * MiB, WO_PA = 46 * MiB, WO_PB = 50 * MiB, WO_PMM = 52 * MiB, WO_OUT = 54 * MiB;
constexpr int CW_TMO = 0, CW_BAR = 4096;
constexpr int RING_OFF = 0, RING_BYTES = 131072;
constexpr int SCR_BYTES = 155648;
constexpr int MISC_OFF = SCR_BYTES;
constexpr int LDS_BYTES = 163840;
constexpr int KSB = 272, VSB = 520;
constexpr int KS_OFF = 0, VS_OFF = 256 * KSB  , LIST_OFF = VS_OFF + 128 * VSB  , WCNT_OFF = LIST_OFF + 16384;
static_assert(WCNT_OFF + 64 <= SCR_BYTES, "LDS map");

#define XB_TMO      128
#define XB_XCNT(j)  (256  + 64 * (j))
#define XB_XSUB(j)  (1280 + 64 * (j))
#define XB_XGEN(j)  (2304 + 64 * (j))
#define XB_TOP      3328
#define XB_TOPGEN   3392
#define XCD_BAR_WORDS 3456
#define XB_SPIN_CAP (1u << 18)

__device__ __forceinline__ unsigned xb_ld(unsigned* p)              { return __hip_atomic_load(p, __ATOMIC_RELAXED, __HIP_MEMORY_SCOPE_AGENT); }
__device__ __forceinline__ unsigned xb_add(unsigned* p, unsigned v) { return __hip_atomic_fetch_add(p, v, __ATOMIC_RELAXED, __HIP_MEMORY_SCOPE_AGENT); }
__device__ __forceinline__ unsigned xb_xcc_id() { return (unsigned)__builtin_amdgcn_s_getreg((3 << 11) | 20) & 0xFu; }
#define XB_SPIN(cond, bar) do { unsigned _sp = 0; while (cond) { __builtin_amdgcn_s_sleep(1); \
    if ((++_sp & 255u) == 0u) { if (xb_ld(&(bar)[XB_TMO])) break; if (_sp > XB_SPIN_CAP) { atomicAdd(&(bar)[XB_TMO], 1u); break; } } } } while (0)

struct XcdBarrier {
    unsigned* bar; unsigned x;
    volatile LAS unsigned* st;
};

__device__ __forceinline__ XcdBarrier xcd_barrier_post(unsigned* bar, volatile LAS unsigned* st) {
    XcdBarrier b; b.bar = bar; b.x = xb_xcc_id(); b.st = st;
    if (threadIdx.x == 0) (void)xb_add(&bar[XB_XCNT(b.x)], 1u);
    return b;
}
__device__ __forceinline__ void xcd_barrier_complete(unsigned* bar, unsigned x, unsigned& nloc, unsigned& nx) {
    const unsigned G = gridDim.x * gridDim.y * gridDim.z;
    unsigned sum, cnt, mine, sp = 0u;
    for (;;) {
        sum = 0u; cnt = 0u; mine = 0u;
#pragma unroll
        for (unsigned j = 0; j < 16; ++j) { const unsigned c = xb_ld(&bar[XB_XCNT(j)]); sum += c; cnt += (c > 0u) ? 1u : 0u; mine = (j == x) ? c : mine; }
        if (sum == G) break;
        __builtin_amdgcn_s_sleep(1);
        if ((++sp & 255u) == 0u) { if (xb_ld(&bar[XB_TMO])) break; if (sp > XB_SPIN_CAP) { atomicAdd(&bar[XB_TMO], 1u); break; } }
    }
    nloc = mine > 0u ? mine : 1u; nx = cnt > 0u ? cnt : 1u;
}

__device__ __forceinline__ void xcd_barrier(const XcdBarrier& b) {
    asm volatile("s_waitcnt vmcnt(0)" ::: "memory");
    __syncthreads();
    if (threadIdx.x == 0) {
        unsigned* bar = b.bar;
        __builtin_amdgcn_s_waitcnt(0);
        unsigned nloc = b.st[0], nx = b.st[1];
        if (nloc == 0u) { xcd_barrier_complete(bar, b.x, nloc, nx); b.st[0] = nloc; b.st[1] = nx; }
        const unsigned old = xb_add(&bar[XB_XSUB(b.x)], 1u);
        const unsigned gen = old / nloc;
        if (old + 1u == (gen + 1u) * nloc) {
            __builtin_amdgcn_fence(__ATOMIC_RELEASE, "agent");
            asm volatile("s_waitcnt vmcnt(0)" ::: "memory");
            const unsigned og = xb_add(&bar[XB_TOP], 1u);
            const unsigned tg = og / nx;
            if (og + 1u == (tg + 1u) * nx) xb_add(&bar[XB_TOPGEN], 1u);
            else XB_SPIN(xb_ld(&bar[XB_TOPGEN]) == tg, bar);
            __builtin_amdgcn_fence(__ATOMIC_ACQUIRE, "agent");
            xb_add(&bar[XB_XGEN(b.x)], 1u);
            asm volatile("s_waitcnt vmcnt(0)" ::: "memory");
        } else {
            XB_SPIN(xb_ld(&bar[XB_XGEN(b.x)]) == gen, bar);
            __builtin_amdgcn_fence(__ATOMIC_ACQUIRE, "agent");
            asm volatile("s_waitcnt vmcnt(0)" ::: "memory");
        }
    }
    __syncthreads();
}


__device__ __forceinline__ float wave_sum(float v) {
    return pg8::xor32_sum(pg8::xor16_sum(pg8::row16_sum(v)));
}
__device__ __forceinline__ void rms_row_bf16(const float* xrow, const float* g, bf16* orow, int lane, bf16* xb = nullptr) {
    const f32x4* xr = (const f32x4*)xrow + lane; const f32x4* gr = (const f32x4*)g + lane;
    f32x4 v[8]; float s = 0.f;
#pragma unroll
    for (int j = 0; j < 8; ++j) { v[j] = xr[64 * j]; s += (v[j].x * v[j].x + v[j].y * v[j].y) + (v[j].z * v[j].z + v[j].w * v[j].w); }
    const float r = __builtin_amdgcn_rsqf(wave_sum(s) * (1.f / D) + RMS_EPS);
    v2u* o8 = (v2u*)orow + lane;
#pragma unroll
    for (int j = 0; j < 8; ++j) { const f32x4 gg = gr[64 * j]; v2u w; w.x = pk2(v[j].x * r * gg.x, v[j].y * r * gg.y); w.y = pk2(v[j].z * r * gg.z, v[j].w * r * gg.w); o8[64 * j] = w; }
    if (xb != nullptr) { v2u* x8 = (v2u*)xb + lane;
#pragma unroll
        for (int j = 0; j < 8; ++j) { v2u w; w.x = pk2(v[j].x, v[j].y); w.y = pk2(v[j].z, v[j].w); x8[64 * j] = w; } }
}
__device__ __forceinline__ void rms_xb_bf16(const bf16* xrow, const float* g, bf16* orow, int lane) {
    const v4u* xr = (const v4u*)xrow + lane; const f32x4* gr = (const f32x4*)g + 2 * lane;
    float v[4][8]; float s = 0.f;
#pragma unroll
    for (int j = 0; j < 4; ++j) { const v4u w = xr[64 * j]; v[j][0] = bflo(w.x); v[j][1] = bfhi(w.x); v[j][2] = bflo(w.y); v[j][3] = bfhi(w.y); v[j][4] = bflo(w.z); v[j][5] = bfhi(w.z); v[j][6] = bflo(w.w); v[j][7] = bfhi(w.w);
#pragma unroll
        for (int e = 0; e < 8; ++e) s += v[j][e] * v[j][e]; }
    const float r = __builtin_amdgcn_rsqf(wave_sum(s) * (1.f / D) + RMS_EPS);
    v4u* o = (v4u*)orow + lane;
#pragma unroll
    for (int j = 0; j < 4; ++j) { const f32x4 g0 = gr[128 * j], g1 = gr[128 * j + 1]; v4u w;
        w.x = pk2(v[j][0] * r * g0.x, v[j][1] * r * g0.y); w.y = pk2(v[j][2] * r * g0.z, v[j][3] * r * g0.w); w.z = pk2(v[j][4] * r * g1.x, v[j][5] * r * g1.y); w.w = pk2(v[j][6] * r * g1.z, v[j][7] * r * g1.w); o[64 * j] = w; }
}
__device__ __forceinline__ void rms_xb_f32(const bf16* xrow, const float* g, float* orow, int lane) {
    const v4u* xr = (const v4u*)xrow + lane; const f32x4* gr = (const f32x4*)g + 2 * lane;
    float v[4][8]; float s = 0.f;
#pragma unroll
    for (int j = 0; j < 4; ++j) { const v4u w = xr[64 * j]; v[j][0] = bflo(w.x); v[j][1] = bfhi(w.x); v[j][2] = bflo(w.y); v[j][3] = bfhi(w.y); v[j][4] = bflo(w.z); v[j][5] = bfhi(w.z); v[j][6] = bflo(w.w); v[j][7] = bfhi(w.w);
#pragma unroll
        for (int e = 0; e < 8; ++e) s += v[j][e] * v[j][e]; }
    const float r = __builtin_amdgcn_rsqf(wave_sum(s) * (1.f / D) + RMS_EPS);
    f32x4* o = (f32x4*)orow + 2 * lane;
#pragma unroll
    for (int j = 0; j < 4; ++j) { const f32x4 g0 = gr[128 * j], g1 = gr[128 * j + 1];
        o[128 * j] = (f32x4){v[j][0] * r * g0.x, v[j][1] * r * g0.y, v[j][2] * r * g0.z, v[j][3] * r * g0.w}; o[128 * j + 1] = (f32x4){v[j][4] * r * g1.x, v[j][5] * r * g1.y, v[j][6] * r * g1.z, v[j][7] * r * g1.w}; }
}
__device__ __forceinline__ void rms_xb_f32_x4(const bf16* x0, size_t rstride, const float* g, float* o0, size_t ostride, int lane) {
    v4u w[4][4];
#pragma unroll
    for (int q = 0; q < 4; ++q)
#pragma unroll
        for (int j = 0; j < 4; ++j) w[q][j] = ((const v4u*)(x0 + q * rstride) + lane)[64 * j];
    const f32x4* gr = (const f32x4*)g + 2 * lane;
#pragma unroll
    for (int q = 0; q < 4; ++q) { float v[4][8]; float s = 0.f;
#pragma unroll
        for (int j = 0; j < 4; ++j) { const v4u ww = w[q][j]; v[j][0] = bflo(ww.x); v[j][1] = bfhi(ww.x); v[j][2] = bflo(ww.y); v[j][3] = bfhi(ww.y); v[j][4] = bflo(ww.z); v[j][5] = bfhi(ww.z); v[j][6] = bflo(ww.w); v[j][7] = bfhi(ww.w);
#pragma unroll
            for (int e = 0; e < 8; ++e) s += v[j][e] * v[j][e]; }
        const float r = __builtin_amdgcn_rsqf(wave_sum(s) * (1.f / D) + RMS_EPS);
        f32x4* o = (f32x4*)(o0 + q * ostride) + 2 * lane;
#pragma unroll
        for (int j = 0; j < 4; ++j) { const f32x4 g0 = gr[128 * j], g1 = gr[128 * j + 1];
            o[128 * j] = (f32x4){v[j][0] * r * g0.x, v[j][1] * r * g0.y, v[j][2] * r * g0.z, v[j][3] * r * g0.w}; o[128 * j + 1] = (f32x4){v[j][4] * r * g1.x, v[j][5] * r * g1.y, v[j][6] * r * g1.z, v[j][7] * r * g1.w}; } }
}
__device__ __forceinline__ float rms_stat_xb(const bf16* xrow, int lane) {
    const v4u* xr = (const v4u*)xrow + lane; float s = 0.f;
#pragma unroll
    for (int j = 0; j < 4; ++j) { const v4u w = xr[64 * j]; const float a0 = bflo(w.x), a1 = bfhi(w.x), a2 = bflo(w.y), a3 = bfhi(w.y), a4 = bflo(w.z), a5 = bfhi(w.z), a6 = bflo(w.w), a7 = bfhi(w.w);
        s += ((a0 * a0 + a1 * a1) + (a2 * a2 + a3 * a3)) + ((a4 * a4 + a5 * a5) + (a6 * a6 + a7 * a7)); }
    return __builtin_amdgcn_rsqf(wave_sum(s) * (1.f / D) + RMS_EPS);
}
__device__ __forceinline__ float rms_stat_partials(const float* ssq_row) {
    float s = 0.f;
#pragma unroll
    for (int i = 0; i < 8; ++i) { const f32x4 v = ((const f32x4*)ssq_row)[i]; s += (v.x + v.y) + (v.z + v.w); }
    return __builtin_amdgcn_rsqf(s * (1.f / D) + RMS_EPS);
}
__device__ __forceinline__ float rms_stat_f32_copy(const float* xrow, bf16* xb, int lane) {
    const f32x4* xr = (const f32x4*)xrow + lane; v2u* x8 = (v2u*)xb + lane; float s = 0.f;
#pragma unroll
    for (int j = 0; j < 8; ++j) { const f32x4 v = xr[64 * j]; v2u w; w.x = pk2(v.x, v.y); w.y = pk2(v.z, v.w); x8[64 * j] = w;
        const float a0 = bflo(w.x), a1 = bfhi(w.x), a2 = bflo(w.y), a3 = bfhi(w.y); s += (a0 * a0 + a1 * a1) + (a2 * a2 + a3 * a3); }
    return __builtin_amdgcn_rsqf(wave_sum(s) * (1.f / D) + RMS_EPS);
}
__device__ __forceinline__ void rms_stat_f32_copy_x2(const float* x0, const float* x1, bf16* b0, bf16* b1, float* rs0, float* rs1, int lane) {
    f32x4 va[8], vb[8];
#pragma unroll
    for (int j = 0; j < 8; ++j) { va[j] = ((const f32x4*)x0 + lane)[64 * j]; vb[j] = ((const f32x4*)x1 + lane)[64 * j]; }
    float sa = 0.f, sb = 0.f;
#pragma unroll
    for (int j = 0; j < 8; ++j) { v2u w; w.x = pk2(va[j].x, va[j].y); w.y = pk2(va[j].z, va[j].w); ((v2u*)b0 + lane)[64 * j] = w;
        { const float a0 = bflo(w.x), a1 = bfhi(w.x), a2 = bflo(w.y), a3 = bfhi(w.y); sa += (a0 * a0 + a1 * a1) + (a2 * a2 + a3 * a3); }
        w.x = pk2(vb[j].x, vb[j].y); w.y = pk2(vb[j].z, vb[j].w); ((v2u*)b1 + lane)[64 * j] = w;
        { const float a0 = bflo(w.x), a1 = bfhi(w.x), a2 = bflo(w.y), a3 = bfhi(w.y); sb += (a0 * a0 + a1 * a1) + (a2 * a2 + a3 * a3); } }
    const float ra = __builtin_amdgcn_rsqf(wave_sum(sa) * (1.f / D) + RMS_EPS), rb = __builtin_amdgcn_rsqf(wave_sum(sb) * (1.f / D) + RMS_EPS);
    if (lane == 0) { *rs0 = ra; *rs1 = rb; }
}
__device__ __forceinline__ void rms_row_f32(const float* xrow, const float* g, float* orow, int lane) {
    const f32x4* xr = (const f32x4*)xrow + lane; const f32x4* gr = (const f32x4*)g + lane;
    f32x4 v[8]; float s = 0.f;
#pragma unroll
    for (int j = 0; j < 8; ++j) { v[j] = xr[64 * j]; s += (v[j].x * v[j].x + v[j].y * v[j].y) + (v[j].z * v[j].z + v[j].w * v[j].w); }
    const float r = __builtin_amdgcn_rsqf(wave_sum(s) * (1.f / D) + RMS_EPS);
    f32x4* o = (f32x4*)orow + lane;
#pragma unroll
    for (int j = 0; j < 8; ++j) { const f32x4 gg = gr[64 * j]; o[64 * j] = v[j] * r * gg; }
}
template <int NT>
__device__ __forceinline__ void transpose_items(const float* W, int N, const int (&k0)[NT], const int (&n0)[NT], bf16* WT, int Kd, const int (&drow0)[NT], LAS float* scr, int lane, const float* gk) {
    float v[NT][32];
#pragma unroll
    for (int t = 0; t < NT; ++t)
#pragma unroll
        for (int i = 0; i < 32; ++i) v[t][i] = W[(size_t)(k0[t] + 2 * i + (lane >> 5)) * N + n0[t] + (lane & 31)];
#pragma unroll
    for (int t = 0; t < NT; ++t)
#pragma unroll
        for (int i = 0; i < 32; ++i) scr[t * 2112 + (2 * i + (lane >> 5)) * 33 + (lane & 31)] = v[t][i];
    LDS_WAIT(); asm volatile("" ::: "memory");
    const int c = lane & 7;
#pragma unroll
    for (int t = 0; t < NT; ++t) {
        f32x4 ga = {1.f, 1.f, 1.f, 1.f}, gb = {1.f, 1.f, 1.f, 1.f}; if (gk) { ga = *(const f32x4*)(gk + k0[t] + 8 * c); gb = *(const f32x4*)(gk + k0[t] + 8 * c + 4); }
#pragma unroll
        for (int j = 0; j < 4; ++j) { const int n = (lane >> 3) + 8 * j; const LAS float* s = scr + t * 2112 + (8 * c) * 33 + n;
            v4u o; o.x = pk2(s[0 * 33] * ga.x, s[1 * 33] * ga.y); o.y = pk2(s[2 * 33] * ga.z, s[3 * 33] * ga.w); o.z = pk2(s[4 * 33] * gb.x, s[5 * 33] * gb.y); o.w = pk2(s[6 * 33] * gb.z, s[7 * 33] * gb.w);
            *(v4u*)(WT + (size_t)(drow0[t] + n) * Kd + k0[t] + 8 * c) = o; } }
    LDS_WAIT(); asm volatile("" ::: "memory");
}
__device__ __forceinline__ int win_row(int n) {
    if (n < 2048) return n;
    if (n < 3072) return 4096 + (n - 2048);
    if (n < 3584) return 2048 + (n - 3072);
    if (n < 4096) return 2560 + (n - 3584);
    if (n < 4608) return 5120 + (n - 4096);
    if (n < 5120) return 3072 + (n - 4608);
    if (n < 5632) return 3584 + (n - 5120);
    return n;
}
__device__ __forceinline__ void convert_matrix(const float* W, int K, int N, bf16* WT, int kind, int off, LAS float* scr, int gw, int NGW, int lane, const float* gk = nullptr) {
    const int nblk = N / 32, nitems = (K / 64) * nblk;
    int it = gw;
    for (; it + NGW < nitems; it += 2 * NGW) {
        int k0[2], n0[2], dr[2];
#pragma unroll
        for (int t = 0; t < 2; ++t) { const int i2 = it + t * NGW, kb = i2 / nblk, nb = i2 % nblk; k0[t] = 64 * kb; n0[t] = 32 * nb;
            dr[t] = (kind == 0) ? n0[t] + off : (kind == 1) ? (n0[t] >> 7) * 256 + off + (n0[t] & 127) : win_row(n0[t]); }
        transpose_items<2>(W, N, k0, n0, WT, K, dr, scr, lane, gk); }
    if (it < nitems) { const int kb = it / nblk, nb = it % nblk; const int k0[1] = {64 * kb}, n0[1] = {32 * nb};
        const int dr[1] = {(kind == 0) ? n0[0] + off : (kind == 1) ? (n0[0] >> 7) * 256 + off + (n0[0] & 127) : win_row(n0[0])};
        transpose_items<1>(W, N, k0, n0, WT, K, dr, scr, lane, gk); }
}
template <int ROWS, int ROWBYTES, int SB>
__device__ __forceinline__ void lds_fill(LAS unsigned char* dst, const bf16* src, size_t ld, int tid) {
    constexpr int CH = ROWBYTES / 16;
#pragma unroll 4
    for (int i = tid; i < ROWS * CH; i += NWAVES * 64) { const int rr = i / CH, c = i % CH;
        const v4u v = *(const v4u*)((const unsigned char*)(src + (size_t)rr * ld) + c * 16);
        LAS v2u* d = (LAS v2u*)(dst + rr * SB + c * 16); d[0] = (v2u){v.x, v.y}; d[1] = (v2u){v.z, v.w}; }
}
__device__ __forceinline__ void fill_kv_tiles(LAS unsigned char* lds, const bf16* kg, size_t kld, const bf16* vg, size_t vld, int tid) {
    v4u kreg[8], vreg[8];
#pragma unroll
    for (int i = 0; i < 8; ++i) { const int ci = tid + i * 512; kreg[i] = *(const v4u*)(kg + (size_t)(ci >> 4) * kld + (ci & 15) * 8); vreg[i] = *(const v4u*)(vg + (size_t)(ci >> 5) * vld + (ci & 31) * 8); }
#pragma unroll
    for (int i = 0; i < 8; ++i) { const int ci = tid + i * 512;
        *(LAS v4u*)(lds + KS_OFF + (ci >> 4) * KSB + (ci & 15) * 16) = kreg[i];
        LAS v2u* dv = (LAS v2u*)(lds + VS_OFF + (ci >> 5) * VSB + (ci & 31) * 16); dv[0] = (v2u){vreg[i].x, vreg[i].y}; dv[1] = (v2u){vreg[i].z, vreg[i].w}; }
}
__device__ __forceinline__ void load_qfrags(bf16x8 (&qf)[8], const bf16* qrow, int h) {
#pragma unroll
    for (int s = 0; s < 8; ++s) qf[s] = *(const bf16x8*)(qrow + 16 * s + 8 * h);
}
template <bool BIAS, bool CAUSAL>
__device__ __forceinline__ void attn_chunk(const LAS unsigned char* Kc, const LAS unsigned char* Vc, bf16x8 (&qf)[8], f32x16 (&o)[4], float& m, float& l,
                                           const int dist0, const float slope_l2, const int r, const int h, const bf16* qnext = nullptr) {
    constexpr float C = 0.08838834764831845f * 1.4426950408889634f;
    f32x16 st[4];
    bf16x8 kf[3][4];
#pragma unroll
    for (int s = 0; s < 4; ++s) kf[0][s] = *(const LAS bf16x8*)(Kc + r * KSB + s * 32 + h * 16);
#pragma unroll
    for (int s = 0; s < 4; ++s) kf[1][s] = *(const LAS bf16x8*)(Kc + r * KSB + (4 + s) * 32 + h * 16);
#pragma unroll
    for (int hb = 0; hb < 8; ++hb) { const int kt = hb >> 1, s0 = (hb & 1) * 4;
        if (hb < 6) { const int kn = (hb + 2) >> 1, sn = ((hb + 2) & 1) * 4;
#pragma unroll
            for (int s = 0; s < 4; ++s) kf[(hb + 2) % 3][s] = *(const LAS bf16x8*)(Kc + (kn * 32 + r) * KSB + (sn + s) * 32 + h * 16); }
        __builtin_amdgcn_sched_barrier(0);
        if (s0 == 0) {
#pragma unroll
            for (int e = 0; e < 16; ++e) st[kt][e] = 0.f; }
#pragma unroll
        for (int s = 0; s < 4; ++s) st[kt] = MFMA32(kf[hb % 3][s], qf[s0 + s], st[kt]);
        __builtin_amdgcn_sched_barrier(0);
    }
    v2u vlo[3][4], vhi[3][4];
#pragma unroll
    for (int i = 0; i < 4; ++i) { const LAS unsigned char* vp = Vc + r * VSB + ((i >> 1) * 32 + 16 * (i & 1) + 4 * h) * 2; vlo[0][i] = *(const LAS v2u*)vp; vhi[0][i] = *(const LAS v2u*)(vp + 16); }
    __builtin_amdgcn_sched_barrier(0);
    if (qnext != nullptr) load_qfrags(qf, qnext, h);
    int dl = dist0 - 4 * h;
    float sl2 = slope_l2; asm volatile("" : "+v"(sl2), "+v"(dl));
    const float bias0 = -sl2 * (float)dl;
    float mx = -1e30f;
#pragma unroll
    for (int kt = 0; kt < 4; ++kt)
#pragma unroll
        for (int e = 0; e < 16; ++e) { const int kk = kt * 32 + (e & 3) + 8 * (e >> 2);
            float x = st[kt][e] * C;
            if (BIAS) x += __builtin_fmaf(sl2, (float)kk, bias0);
            if (CAUSAL) x = (dl - kk >= 0) ? x : -1e30f;
            st[kt][e] = x; mx = fmaxf(mx, x); }
    mx = pg8::xor32_max(mx);
    const float mn = fmaxf(m, mx), alpha = fexp2(m - mn); m = mn;
    float ps = 0.f;
#pragma unroll
    for (int kt = 0; kt < 4; ++kt)
#pragma unroll
        for (int e = 0; e < 16; ++e) { const float p = fexp2(st[kt][e] - mn); st[kt][e] = p; ps += p; }
    ps = pg8::xor32_sum(ps);
    l = l * alpha + ps;
#pragma unroll
    for (int dt = 0; dt < 4; ++dt) o[dt] = o[dt] * alpha;
    bf16x8 pf[4][2];
#pragma unroll
    for (int kt = 0; kt < 4; ++kt)
#pragma unroll
        for (int sg = 0; sg < 2; ++sg) { v4u w; w.x = pk2(st[kt][8 * sg + 0], st[kt][8 * sg + 1]); w.y = pk2(st[kt][8 * sg + 2], st[kt][8 * sg + 3]);
            w.z = pk2(st[kt][8 * sg + 4], st[kt][8 * sg + 5]); w.w = pk2(st[kt][8 * sg + 6], st[kt][8 * sg + 7]); pf[kt][sg] = as_bf16x8(w); }
#pragma unroll
    for (int b0 = 1; b0 < 2; ++b0)
#pragma unroll
        for (int i = 0; i < 4; ++i) { const int ii = b0 * 4 + i; const LAS unsigned char* vp = Vc + r * VSB + ((ii >> 1) * 32 + 16 * (ii & 1) + 4 * h) * 2; vlo[b0][i] = *(const LAS v2u*)vp; vhi[b0][i] = *(const LAS v2u*)(vp + 16); }
#pragma unroll
    for (int hb = 0; hb < 8; ++hb) { const int dt = hb >> 1, i0 = (hb & 1) * 4;
        if (hb < 6) { const int dn = (hb + 2) >> 1, in0 = ((hb + 2) & 1) * 4;
#pragma unroll
            for (int i = 0; i < 4; ++i) { const int ii = in0 + i; const LAS unsigned char* vp = Vc + (dn * 32 + r) * VSB + ((ii >> 1) * 32 + 16 * (ii & 1) + 4 * h) * 2; vlo[(hb + 2) % 3][i] = *(const LAS v2u*)vp; vhi[(hb + 2) % 3][i] = *(const LAS v2u*)(vp + 16); } }
        __builtin_amdgcn_sched_barrier(0);
#pragma unroll
        for (int i = 0; i < 4; ++i) { const int ii = i0 + i; o[dt] = MFMA32(as_bf16x8((v4u){vlo[hb % 3][i].x, vlo[hb % 3][i].y, vhi[hb % 3][i].x, vhi[hb % 3][i].y}), pf[ii >> 1][ii & 1], o[dt]); }
        __builtin_amdgcn_sched_barrier(0);
    }
}
__device__ __forceinline__ void store_ot_bf16(const f32x16 (&o)[4], float inv, bf16* orow, int h) {
#pragma unroll
    for (int dt = 0; dt < 4; ++dt)
#pragma unroll
        for (int a = 0; a < 4; ++a) { v2u w; w.x = pk2(o[dt][4 * a] * inv, o[dt][4 * a + 1] * inv); w.y = pk2(o[dt][4 * a + 2] * inv, o[dt][4 * a + 3] * inv);
            *(v2u*)(orow + 32 * dt + 8 * a + 4 * h) = w; }
}

__device__ __forceinline__ void store_ot_private(const f32x16 (&o)[4], float inv, bf16* prow, int h) {
#pragma unroll
    for (int dt = 0; dt < 4; ++dt)
#pragma unroll
        for (int hh = 0; hh < 2; ++hh) { v4u w; w.x = pk2(o[dt][8 * hh] * inv, o[dt][8 * hh + 1] * inv); w.y = pk2(o[dt][8 * hh + 2] * inv, o[dt][8 * hh + 3] * inv); w.z = pk2(o[dt][8 * hh + 4] * inv, o[dt][8 * hh + 5] * inv); w.w = pk2(o[dt][8 * hh + 6] * inv, o[dt][8 * hh + 7] * inv);
            *(v4u*)(prow + h * 64 + dt * 16 + hh * 8) = w; }
}
__device__ __forceinline__ void mem_attn_unit(LAS unsigned char* lds, bf16* PM, const bf16* KMl, const bf16* VMTl, int u, int tid_in) {
    int tid = tid_in; asm volatile("" : "+v"(tid));
    const int wave = __builtin_amdgcn_readfirstlane(tid >> 6), lane = tid & 63, r = lane & 31, h = lane >> 5;
    const int qb = u & 63, mh = (u >> 6) & 3, b = u >> 8;
    bf16* qrow = PM + (size_t)(b * T + qb * 256 + wave * 32 + r) * NMAIN + CQM + mh * 128;
    bf16x8 qf[8]; load_qfrags(qf, qrow, h);
    fill_kv_tiles(lds, KMl + (size_t)(b * 256) * 512 + mh * 128, 512, VMTl + (size_t)(mh * 128) * 512 + b * 256, 512, tid);
    LDS_WAIT(); __syncthreads();
    f32x16 o[4]; float m = -1e30f, l = 0.f;
#pragma unroll
    for (int dt = 0; dt < 4; ++dt)
#pragma unroll
        for (int e = 0; e < 16; ++e) o[dt][e] = 0.f;
#pragma unroll 1
    for (int c = 0; c < 2; ++c) attn_chunk<false, false>(lds + KS_OFF + c * 128 * KSB, lds + VS_OFF + c * 256, qf, o, m, l, 0, 0.f, r, h);
    store_ot_bf16(o, __builtin_amdgcn_rcpf(l), qrow, h);
    __syncthreads();
}

#define TOP3_INS(v, j) do { if ((v) > v2) { if ((v) > v1) { v2 = v1; i2 = i1; if ((v) > v0) { v1 = v0; i1 = i0; v0 = (v); i0 = (j); } else { v1 = (v); i1 = (j); } } else { v2 = (v); i2 = (j); } } } while (0)
#define TOP3_INS_TIE(v, j) do { if ((v) > v2 || ((v) == v2 && (j) < i2)) { if ((v) > v1 || ((v) == v1 && (j) < i1)) { v2 = v1; i2 = i1; if ((v) > v0 || ((v) == v0 && (j) < i0)) { v1 = v0; i1 = i0; v0 = (v); i0 = (j); } else { v1 = (v); i1 = (j); } } else { v2 = (v); i2 = (j); } } } while (0)
__device__ __forceinline__ void moba_sel_unit(LAS unsigned char* lds, const bf16* PM, const float* kml, unsigned* SEL, int u, int tid) {
    const int wave = __builtin_amdgcn_readfirstlane(tid >> 6), lane = tid & 63, r = lane & 31, h = lane >> 5;
    const int blk = u & 63, bh = u >> 6, b = bh >> 3, hd = bh & 7;
    const int t = blk * 256 + wave * 32 + r;
    if (blk == 0) { if (h == 0) SEL[(size_t)bh * T + t] = 0x00ffffffu; return; }
    LAS unsigned char* KH = lds, * KL = lds + 64 * KSB;
    for (int it = tid; it < 64 * 16; it += NWAVES * 64) { const int j = it >> 4, d8 = (it & 15) * 8;
        const f32x4 a = *(const f32x4*)(kml + ((size_t)bh * 64 + j) * 128 + d8), c = *(const f32x4*)(kml + ((size_t)bh * 64 + j) * 128 + d8 + 4);
        float x[8] = {a.x, a.y, a.z, a.w, c.x, c.y, c.z, c.w}; unsigned hp[4], lp[4];
#pragma unroll
        for (int e = 0; e < 8; ++e) x[e] *= (1.f / 256.f);
#pragma unroll
        for (int e = 0; e < 4; ++e) { hp[e] = pk2(x[2 * e], x[2 * e + 1]); lp[e] = pk2(x[2 * e] - bflo(hp[e]), x[2 * e + 1] - bfhi(hp[e])); }
        LAS v2u* dh = (LAS v2u*)(KH + j * KSB + d8 * 2); LAS v2u* dl = (LAS v2u*)(KL + j * KSB + d8 * 2);
        dh[0] = (v2u){hp[0], hp[1]}; dh[1] = (v2u){hp[2], hp[3]};
        dl[0] = (v2u){lp[0], lp[1]}; dl[1] = (v2u){lp[2], lp[3]}; }
    bf16x8 qf[8]; load_qfrags(qf, PM + (size_t)(b * T + t) * NMAIN + CQA + hd * 128, h);
    LDS_WAIT(); __syncthreads();
    f32x16 st[2];
#pragma unroll
    for (int jt = 0; jt < 2; ++jt) {
#pragma unroll
        for (int e = 0; e < 16; ++e) st[jt][e] = 0.f;
#pragma unroll
        for (int s = 0; s < 8; ++s) { const bf16x8 kh = *(const LAS bf16x8*)(KH + (jt * 32 + r) * KSB + s * 32 + h * 16), kl = *(const LAS bf16x8*)(KL + (jt * 32 + r) * KSB + s * 32 + h * 16);
            st[jt] = MFMA32(kh, qf[s], st[jt]); st[jt] = MFMA32(kl, qf[s], st[jt]); }
    }
    float v0 = -3e38f, v1 = -3e38f, v2 = -3e38f; int i0 = 255, i1 = 255, i2 = 255;
#pragma unroll
    for (int jt = 0; jt < 2; ++jt)
#pragma unroll
        for (int e = 0; e < 16; ++e) { const int j = jt * 32 + (e & 3) + 8 * (e >> 2) + 4 * h; const float v = (j < blk) ? st[jt][e] : -3e38f; TOP3_INS(v, j); }
    const float p0 = __builtin_bit_cast(float, pg8::xor32_other(__builtin_bit_cast(unsigned, v0), h)), p1 = __builtin_bit_cast(float, pg8::xor32_other(__builtin_bit_cast(unsigned, v1), h)), p2 = __builtin_bit_cast(float, pg8::xor32_other(__builtin_bit_cast(unsigned, v2), h));
    const int q0 = (int)pg8::xor32_other((unsigned)i0, h), q1 = (int)pg8::xor32_other((unsigned)i1, h), q2 = (int)pg8::xor32_other((unsigned)i2, h);
    if (q0 != 255) TOP3_INS_TIE(p0, q0);
    if (q1 != 255) TOP3_INS_TIE(p1, q1);
    if (q2 != 255) TOP3_INS_TIE(p2, q2);
    if (h == 0) SEL[(size_t)bh * T + t] = (unsigned)i0 | ((unsigned)i1 << 8) | ((unsigned)i2 << 16);
    __syncthreads();
}
__device__ __forceinline__ void moba_partial_task(LAS unsigned char* lds, const bf16* PM, const bf16* VT, const unsigned* SEL, bf16* PO, float* ML, int bh, int j, int tid_in) {
    int tid = tid_in; asm volatile("" : "+v"(tid));
    const int wave = __builtin_amdgcn_readfirstlane(tid >> 6), lane = tid & 63, r = lane & 31, h = lane >> 5;
    const int b = bh >> 3, hd = bh & 7;
    const bf16* kg = PM + (size_t)(b * T + 256 * j) * NMAIN + CKA + hd * 128; const bf16* vg = VT + (size_t)(hd * 128) * M + b * T + 256 * j;
    fill_kv_tiles(lds, kg, NMAIN, vg, M, tid);
    LAS unsigned short* list = (LAS unsigned short*)(lds + LIST_OFF); LAS unsigned* wcnt = (LAS unsigned*)(lds + WCNT_OFF);
    const float slope_l2 = 1.4426950408889634f * __builtin_amdgcn_exp2f(-(float)(hd + 1));
#pragma unroll 1
    for (int t_beg = 256 * (j + 1); t_beg < T; t_beg += 8192) {
        const int t_end = (t_beg + 8192 < T) ? t_beg + 8192 : T;
        unsigned slots0 = 0u, slots1 = 0u; int tot = 0; unsigned wsel[16];
#pragma unroll
        for (int it = 0; it < 16; ++it) { const int t = t_beg + wave * 1024 + it * 64 + lane; wsel[it] = SEL[(size_t)bh * T + (t < t_end ? t : t_end - 1)]; }
#pragma unroll
        for (int it = 0; it < 16; ++it) { const int t = t_beg + wave * 1024 + it * 64 + lane; const unsigned w = (t < t_end) ? wsel[it] : 0x00ffffffu;
            const unsigned sl = ((w & 255u) == (unsigned)j) ? 1u : (((w >> 8) & 255u) == (unsigned)j) ? 2u : (((w >> 16) & 255u) == (unsigned)j) ? 3u : 0u;
            if (it < 8) slots0 |= sl << (4 * it); else slots1 |= sl << (4 * (it - 8)); tot += __builtin_popcountll(__ballot(sl != 0u)); }
        if (lane == 0) wcnt[wave] = (unsigned)tot;
        LDS_WAIT(); __syncthreads();
        int off = 0, n = 0;
#pragma unroll
        for (int w = 0; w < NWAVES; ++w) { const int c = (int)wcnt[w]; off += (w < wave) ? c : 0; n += c; }
#pragma unroll
        for (int it = 0; it < 16; ++it) { const unsigned sl = ((it < 8 ? slots0 : slots1) >> (4 * (it & 7))) & 15u; const unsigned long long bal = __ballot(sl != 0u);
            if (sl != 0u) list[off + __builtin_popcountll(bal & ((1ull << lane) - 1ull))] = (unsigned short)((wave * 1024 + it * 64 + lane) | ((sl - 1u) << 13));
            off += __builtin_popcountll(bal); }
        LDS_WAIT(); __syncthreads();
        const int ngroups = (n + 31) >> 5;
        bf16x8 qf[8]; unsigned e = 0u;
        if (wave < ngroups) { const int idx0 = wave * 32 + r; e = list[idx0 < n ? idx0 : n - 1]; load_qfrags(qf, PM + (size_t)(b * T + t_beg + (int)(e & 8191u)) * NMAIN + CQA + hd * 128, h); }
        for (int g = wave; g < ngroups; g += NWAVES) {
            const int idx = g * 32 + r;
            const int t = t_beg + (int)(e & 8191u), slot = (int)(e >> 13);
            unsigned en = 0u; const bool more = (g + NWAVES) < ngroups; const bf16* qnext = nullptr;
            if (more) { const int idn = (g + NWAVES) * 32 + r; en = list[idn < n ? idn : n - 1]; qnext = PM + (size_t)(b * T + t_beg + (int)(en & 8191u)) * NMAIN + CQA + hd * 128; }
            f32x16 o[4]; float m = -1e30f, l = 0.f;
#pragma unroll
            for (int dt = 0; dt < 4; ++dt)
#pragma unroll
                for (int q = 0; q < 16; ++q) o[dt][q] = 0.f;
#pragma unroll 1
            for (int c = 0; c < 2; ++c) attn_chunk<true, false>(lds + KS_OFF + c * 128 * KSB, lds + VS_OFF + c * 256, qf, o, m, l, t - 256 * j - 128 * c, slope_l2, r, h, c == 1 ? qnext : nullptr);
            if (idx < n) { const size_t pi = ((size_t)bh * T + t) * 3 + slot;
                store_ot_private(o, __builtin_amdgcn_rcpf(l), PO + pi * 128, h);
                if (h == 0) *(pg8::f32x2*)(ML + pi * 2) = (pg8::f32x2){m, l}; }
            e = en;
        }
        __syncthreads();
    }
}
__device__ __forceinline__ void moba_own_unit(LAS unsigned char* lds, bf16* PM, const bf16* VT, const unsigned* SEL, const bf16* PO, const float* ML, int u, int tid_in) {
    int tid = tid_in; asm volatile("" : "+v"(tid));
    const int wave = __builtin_amdgcn_readfirstlane(tid >> 6), lane = tid & 63, r = lane & 31, h = lane >> 5;
    const int blk = u & 63, bh = u >> 6, b = bh >> 3, hd = bh & 7;
    const int tl = wave * 32 + r, t = blk * 256 + tl;
    bf16* qrow = PM + (size_t)(b * T + t) * NMAIN + CQA + hd * 128;
    const unsigned selw = SEL[(size_t)bh * T + t];
    const size_t pi0 = ((size_t)bh * T + t) * 3;
    float mlr[6];
#pragma unroll
    for (int k = 0; k < 3; ++k) { const pg8::f32x2 v = *(const pg8::f32x2*)(ML + pi0 * 2 + 2 * k); mlr[2 * k] = v.x; mlr[2 * k + 1] = v.y; }
    bf16x8 qf[8]; load_qfrags(qf, qrow, h);
    fill_kv_tiles(lds, PM + (size_t)(b * T + 256 * blk) * NMAIN + CKA + hd * 128, NMAIN, VT + (size_t)(hd * 128) * M + b * T + 256 * blk, M, tid);
    LDS_WAIT(); __syncthreads();
    const float slope_l2 = 1.4426950408889634f * __builtin_amdgcn_exp2f(-(float)(hd + 1));
    f32x16 o[4]; float m = -1e30f, l = 0.f;
#pragma unroll
    for (int dt = 0; dt < 4; ++dt)
#pragma unroll
        for (int q = 0; q < 16; ++q) o[dt][q] = 0.f;
    const int nch = (wave < 4) ? 1 : 2;
#pragma unroll 1
    for (int c = 0; c < nch; ++c) attn_chunk<true, true>(lds + KS_OFF + c * 128 * KSB, lds + VS_OFF + c * 256, qf, o, m, l, tl - 128 * c, slope_l2, r, h);
    v4u pw[3][4][2];
#pragma unroll
    for (int k = 0; k < 3; ++k) { const bool ok = ((selw >> (8 * k)) & 255u) != 255u; const bf16* pr = PO + (pi0 + (ok ? k : 0)) * 128 + h * 64;
#pragma unroll
        for (int dt = 0; dt < 4; ++dt)
#pragma unroll
            for (int hh = 0; hh < 2; ++hh) { const v4u w = *(const v4u*)(pr + dt * 16 + hh * 8); pw[k][dt][hh] = ok ? w : (v4u){0u, 0u, 0u, 0u}; } }
    float mk[3], lk[3]; float mm = m;
#pragma unroll
    for (int k = 0; k < 3; ++k) { const bool ok = ((selw >> (8 * k)) & 255u) != 255u; mk[k] = ok ? mlr[2 * k] : -1e30f; lk[k] = ok ? mlr[2 * k + 1] : 0.f; mm = fmaxf(mm, mk[k]); }
    const float wo = fexp2(m - mm); float den = l * wo;
#pragma unroll
    for (int dt = 0; dt < 4; ++dt) o[dt] = o[dt] * wo;
#pragma unroll
    for (int k = 0; k < 3; ++k) { const bool ok = ((selw >> (8 * k)) & 255u) != 255u; const float wk = lk[k] * fexp2(mk[k] - mm); den += wk;
#pragma unroll
        for (int dt = 0; dt < 4; ++dt)
#pragma unroll
            for (int hh = 0; hh < 2; ++hh) { const v4u w = pw[k][dt][hh]; const float wv = ok ? wk : 0.f;
                o[dt][8 * hh] += wv * bflo(w.x); o[dt][8 * hh + 1] += wv * bfhi(w.x); o[dt][8 * hh + 2] += wv * bflo(w.y); o[dt][8 * hh + 3] += wv * bfhi(w.y);
                o[dt][8 * hh + 4] += wv * bflo(w.z); o[dt][8 * hh + 5] += wv * bfhi(w.z); o[dt][8 * hh + 6] += wv * bflo(w.w); o[dt][8 * hh + 7] += wv * bfhi(w.w); } }
    store_ot_bf16(o, __builtin_amdgcn_rcpf(den), qrow, h);
    __syncthreads();
}
constexpr int HG_G = 0, HG_TOT = 32768, HG_LB = 34816, HG_KT = 36864, HG_KK1 = 55296, HG_QS = 36864, HG_QG = 54272, HG_KD = 71680, HG_KO = 89088, HG_SS = 97792, HG_KK3 = 98816, KTSB = 144;
__device__ __forceinline__ void hgrn_lb_table(LAS unsigned char* lds, const float* lbl  , int layer, int tid) {
    float lb = 0.f; if (layer > 0) lb = fsigmoid(lbl[512 + tid] - lbl[tid]);
    ((LAS float*)(lds + HG_LB))[tid] = lb;
    LDS_WAIT(); __syncthreads();
}
__device__ __forceinline__ void hgrn_gates(LAS unsigned char* lds, int kk_off, const v4u (&fbr)[2], int hh, int tid) {
    LAS float* G = (LAS float*)(lds + HG_G); LAS float* TOT = (LAS float*)(lds + HG_TOT); LAS float* LB = (LAS float*)(lds + HG_LB) + hh * 128; LAS float* KK = (LAS float*)(lds + kk_off);
#pragma unroll
    for (int it = 0; it < 2; ++it) { const int item = tid + it * 512, s = item >> 4, d8 = (item & 15) * 8;
        const unsigned fw[4] = {fbr[it].x, fbr[it].y, fbr[it].z, fbr[it].w}; float lg[8], kv[8];
        const f32x4 lbA = *(const LAS f32x4*)(LB + d8), lbB = *(const LAS f32x4*)(LB + d8 + 4); const float lb8[8] = {lbA.x, lbA.y, lbA.z, lbA.w, lbB.x, lbB.y, lbB.z, lbB.w};
#pragma unroll
        for (int e = 0; e < 8; ++e) { const float x = (e & 1) ? bfhi(fw[e >> 1]) : bflo(fw[e >> 1]); const float lb = lb8[e];
            const float ex = __builtin_amdgcn_exp2f(-1.4426950408889634f * x);
            const float sg = __builtin_amdgcn_rcpf(1.f + ex);
            const float fg = lb + (1.f - lb) * sg; lg[e] = 0.6931471805599453f * __builtin_amdgcn_logf(fmaxf(fg, 1e-20f)); kv[e] = (1.f - lb) * (ex < 1e30f ? ex * sg : 1.f); }
        *(LAS f32x4*)(G + s * 128 + d8) = (f32x4){lg[0], lg[1], lg[2], lg[3]}; *(LAS f32x4*)(G + s * 128 + d8 + 4) = (f32x4){lg[4], lg[5], lg[6], lg[7]};
        *(LAS f32x4*)(KK + s * 128 + d8) = (f32x4){kv[0], kv[1], kv[2], kv[3]}; *(LAS f32x4*)(KK + s * 128 + d8 + 4) = (f32x4){kv[4], kv[5], kv[6], kv[7]}; }
    LDS_WAIT(); __syncthreads();
    { const int d = tid & 127, q = tid >> 7; float gv[16];
#pragma unroll
        for (int s = 0; s < 16; ++s) gv[s] = G[(16 * q + s) * 128 + d];
        float run = 0.f;
#pragma unroll
        for (int s = 0; s < 16; ++s) { run += gv[s]; G[(16 * q + s) * 128 + d] = run; }
        TOT[q * 128 + d] = run; }
    LDS_WAIT(); __syncthreads();
}
__device__ __forceinline__ void hgrn_local_load(const bf16* PM, const bf16* VT, int u, int tid_in, v4u (&fbr)[2], bf16x8 (&va)[4]) {
    int tid = tid_in; asm volatile("" : "+v"(tid));
    const int wave = __builtin_amdgcn_readfirstlane(tid >> 6), lane = tid & 63, r = lane & 31, h = lane >> 5;
    const int c = u & 255, bh = u >> 8, b = bh >> 2, hh = bh & 3;
    const size_t row0 = (size_t)b * T + (size_t)c * 64;
    const int dvt = wave >> 1;
#pragma unroll
    for (int it = 0; it < 2; ++it) { const int item = tid + it * 512; fbr[it] = *(const v4u*)(PM + (row0 + (item >> 4)) * NMAIN + CFB + hh * 128 + (item & 15) * 8); }
    const bf16* vrow = VT + (size_t)(1024 + hh * 128 + dvt * 32 + r) * M + row0;
#pragma unroll
    for (int sg = 0; sg < 4; ++sg) va[sg] = *(const bf16x8*)(vrow + 16 * sg + 8 * h);
}
__device__ __forceinline__ void hgrn_local_unit(LAS unsigned char* lds, bf16* ST, float* DEC, int u, int tid_in, const v4u (&fbr)[2], const bf16x8 (&va)[4]) {
    int tid = tid_in; asm volatile("" : "+v"(tid));
    const int wave = __builtin_amdgcn_readfirstlane(tid >> 6), lane = tid & 63, r = lane & 31, h = lane >> 5;
    const int c = u & 255, bh = u >> 8, hh = bh & 3;
    const int dvt = wave >> 1, dk0 = 2 * (wave & 1);
    hgrn_gates(lds, HG_KK1, fbr, hh, tid);
    LAS float* G = (LAS float*)(lds + HG_G); LAS float* TOT = (LAS float*)(lds + HG_TOT); LAS float* KK = (LAS float*)(lds + HG_KK1);
#pragma unroll
    for (int it = 0; it < 2; ++it) { const int item = tid + it * 512, d = item & 127, s8 = (item >> 7) * 8;
        const float t0 = TOT[d], t1 = TOT[128 + d], t2 = TOT[256 + d], t3 = TOT[384 + d], glast = ((t0 + t1) + t2) + t3;
        const float pre = (s8 >= 48) ? ((t0 + t1) + t2) : (s8 >= 32) ? (t0 + t1) : (s8 >= 16) ? t0 : 0.f;
        float kb[8];
#pragma unroll
        for (int e = 0; e < 8; ++e) kb[e] = KK[(s8 + e) * 128 + d] * fexp(glast - (G[(s8 + e) * 128 + d] + pre));
        *(LAS v4u*)(lds + HG_KT + d * KTSB + s8 * 2) = (v4u){pk2(kb[0], kb[1]), pk2(kb[2], kb[3]), pk2(kb[4], kb[5]), pk2(kb[6], kb[7])};
        if (s8 == 0) DEC[((size_t)bh * 256 + c) * 128 + d] = fexp(glast); }
    LDS_WAIT(); __syncthreads();
    f32x16 acc[2];
#pragma unroll
    for (int e = 0; e < 2; ++e)
#pragma unroll
        for (int q = 0; q < 16; ++q) acc[e][q] = 0.f;
#pragma unroll
    for (int sg = 0; sg < 4; ++sg) {
#pragma unroll
        for (int e = 0; e < 2; ++e) { const bf16x8 bb = *(const LAS bf16x8*)(lds + HG_KT + ((dk0 + e) * 32 + r) * KTSB + (16 * sg + 8 * h) * 2); acc[e] = MFMA32(va[sg], bb, acc[e]); } }
    bf16* stb = ST + ((size_t)bh * 256 + c) * 16384;
#pragma unroll
    for (int e = 0; e < 2; ++e)
#pragma unroll
        for (int q = 0; q < 16; ++q) stb[(size_t)(dvt * 32 + (q & 3) + 8 * (q >> 2) + 4 * h) * 128 + (dk0 + e) * 32 + r] = (bf16)f2bf(acc[e][q]);
    __syncthreads();
}
__device__ __forceinline__ void hgrn_scan(bf16* ST, const float* DEC, int vcu, int G, int tid) {
    for (int e = vcu * 512 + tid; e < 8 * 16384; e += G * 512) { const int bh = e >> 14, rem = e & 16383, dk = e & 127;
        bf16* sp = ST + (size_t)bh * 256 * 16384 + rem; const float* dp = DEC + (size_t)bh * 256 * 128 + dk; float S = 0.f;
#pragma unroll 1
        for (int c0 = 0; c0 < 256; c0 += 32) { float L[32], dc[32];
#pragma unroll
            for (int i = 0; i < 32; ++i) { L[i] = bf2f(sp[(size_t)(c0 + i) * 16384]); dc[i] = dp[(c0 + i) * 128]; }
#pragma unroll
            for (int i = 0; i < 32; ++i) { sp[(size_t)(c0 + i) * 16384] = (bf16)f2bf(S); S = dc[i] * S + L[i]; } } }
}
struct HoutPre { v4u fbr[2], qbr[2]; bf16x8 sa[8]; v2u vlo[2][2], vhi[2][2]; v2u gbr[4]; };
__device__ __forceinline__ void hgrn_out_load(const bf16* PM, const bf16* VT, const bf16* ST, int u, int tid_in, HoutPre& P) {
    int tid = tid_in; asm volatile("" : "+v"(tid));
    const int wave = __builtin_amdgcn_readfirstlane(tid >> 6), lane = tid & 63, r = lane & 31, h = lane >> 5;
    const int c = u & 255, bh = u >> 8, b = bh >> 2, hh = bh & 3;
    const size_t row0 = (size_t)b * T + (size_t)c * 64;
    const int dvt = wave & 3, tt = wave >> 2;
#pragma unroll
    for (int it = 0; it < 2; ++it) { const int item = tid + it * 512; const bf16* p = PM + (row0 + (item >> 4)) * NMAIN + hh * 128 + (item & 15) * 8; P.fbr[it] = *(const v4u*)(p + CFB); P.qbr[it] = *(const v4u*)(p + CQB); }
    { const bf16* srow = ST + ((size_t)bh * 256 + c) * 16384 + (size_t)(dvt * 32 + r) * 128;
#pragma unroll
      for (int sg = 0; sg < 8; ++sg) P.sa[sg] = *(const bf16x8*)(srow + 16 * sg + 8 * h); }
    const bf16* vrow = VT + (size_t)(1024 + hh * 128 + dvt * 32 + r) * M + row0;
#pragma unroll
    for (int st = 0; st < 2; ++st)
#pragma unroll
        for (int sg = 0; sg < 2; ++sg) { P.vlo[st][sg] = *(const v2u*)(vrow + st * 32 + 16 * sg + 4 * h); P.vhi[st][sg] = *(const v2u*)(vrow + st * 32 + 16 * sg + 8 + 4 * h); }
    const bf16* orow = PM + (row0 + tt * 32 + r) * NMAIN;
#pragma unroll
    for (int a = 0; a < 4; ++a) P.gbr[a] = *(const v2u*)(orow + CGB + hh * 128 + dvt * 32 + 8 * a + 4 * h);
}
__device__ __forceinline__ void hgrn_out_unit(LAS unsigned char* lds, bf16* PM, const float* gain  , int u, int tid_in, const HoutPre& P) {
    int tid = tid_in; asm volatile("" : "+v"(tid));
    const int wave = __builtin_amdgcn_readfirstlane(tid >> 6), lane = tid & 63, r = lane & 31, h = lane >> 5;
    const int c = u & 255, bh = u >> 8, b = bh >> 2, hh = bh & 3;
    const size_t row0 = (size_t)b * T + (size_t)c * 64;
    const int dvt = wave & 3, tt = wave >> 2;
    const v4u (&fbr)[2] = P.fbr; const v4u (&qbr)[2] = P.qbr; const bf16x8 (&sa)[8] = P.sa; const v2u (&vlo)[2][2] = P.vlo; const v2u (&vhi)[2][2] = P.vhi; const v2u (&gbr)[4] = P.gbr;
    bf16* orow = PM + (row0 + tt * 32 + r) * NMAIN;
    hgrn_gates(lds, HG_KK3, fbr, hh, tid);
    LAS float* G = (LAS float*)(lds + HG_G); LAS float* TOT = (LAS float*)(lds + HG_TOT); LAS float* KK = (LAS float*)(lds + HG_KK3);
#pragma unroll
    for (int it = 0; it < 2; ++it) { const int item = tid + it * 512, s = item >> 4, d8 = (item & 15) * 8;
        const unsigned qw[4] = {qbr[it].x, qbr[it].y, qbr[it].z, qbr[it].w}; float qs[8], qg[8], kd[8], ko[8];
        const f32x4 kA = *(const LAS f32x4*)(KK + s * 128 + d8), kB = *(const LAS f32x4*)(KK + s * 128 + d8 + 4), gA = *(const LAS f32x4*)(G + s * 128 + d8), gB = *(const LAS f32x4*)(G + s * 128 + d8 + 4);
        const f32x4 t0A = *(const LAS f32x4*)(TOT + d8), t0B = *(const LAS f32x4*)(TOT + d8 + 4), t1A = *(const LAS f32x4*)(TOT + 128 + d8), t1B = *(const LAS f32x4*)(TOT + 128 + d8 + 4), t2A = *(const LAS f32x4*)(TOT + 256 + d8), t2B = *(const LAS f32x4*)(TOT + 256 + d8 + 4);
        const float k8[8] = {kA.x, kA.y, kA.z, kA.w, kB.x, kB.y, kB.z, kB.w}, g8[8] = {gA.x, gA.y, gA.z, gA.w, gB.x, gB.y, gB.z, gB.w};
        const float u0[8] = {t0A.x, t0A.y, t0A.z, t0A.w, t0B.x, t0B.y, t0B.z, t0B.w}, u1[8] = {t1A.x, t1A.y, t1A.z, t1A.w, t1B.x, t1B.y, t1B.z, t1B.w}, u2[8] = {t2A.x, t2A.y, t2A.z, t2A.w, t2B.x, t2B.y, t2B.z, t2B.w};
        const bool s16 = s >= 16, s32 = s >= 32, s48 = s >= 48;
#pragma unroll
        for (int e = 0; e < 8; ++e) { const float qv = (e & 1) ? bfhi(qw[e >> 1]) : bflo(qw[e >> 1]);
            const float k = k8[e], g31 = u0[e] + u1[e];
            const float pre = s48 ? (g31 + u2[e]) : s32 ? g31 : s16 ? u0[e] : 0.f;
            const float gs = g8[e] + pre, gref = s32 ? g31 : 0.f;
            qs[e] = qv * fexp(gs - gref); qg[e] = qv * fexp(gs); kd[e] = k * fexp(fminf(gref - gs, 80.f)); ko[e] = k * fexp(fminf(g31 - gs, 0.f)); }
        *(LAS v4u*)(lds + HG_QS + s * KSB + d8 * 2) = (v4u){pk2(qs[0], qs[1]), pk2(qs[2], qs[3]), pk2(qs[4], qs[5]), pk2(qs[6], qs[7])};
        *(LAS v4u*)(lds + HG_QG + s * KSB + d8 * 2) = (v4u){pk2(qg[0], qg[1]), pk2(qg[2], qg[3]), pk2(qg[4], qg[5]), pk2(qg[6], qg[7])};
        *(LAS v4u*)(lds + HG_KD + s * KSB + d8 * 2) = (v4u){pk2(kd[0], kd[1]), pk2(kd[2], kd[3]), pk2(kd[4], kd[5]), pk2(kd[6], kd[7])};
        if (s < 32) *(LAS v4u*)(lds + HG_KO + s * KSB + d8 * 2) = (v4u){pk2(ko[0], ko[1]), pk2(ko[2], ko[3]), pk2(ko[4], ko[5]), pk2(ko[6], ko[7])}; }
    LDS_WAIT(); __syncthreads();
    f32x16 o;
#pragma unroll
    for (int q = 0; q < 16; ++q) o[q] = 0.f;
#pragma unroll
    for (int sg = 0; sg < 8; ++sg) { const bf16x8 bb = *(const LAS bf16x8*)(lds + HG_QG + (tt * 32 + r) * KSB + (16 * sg + 8 * h) * 2); o = MFMA32(sa[sg], bb, o); }
#pragma unroll
    for (int st = 0; st < 2; ++st) if (st <= tt) {
        f32x16 at;
#pragma unroll
        for (int q = 0; q < 16; ++q) at[q] = 0.f;
        const LAS unsigned char* kbase = (st == tt) ? (lds + HG_KD + (st * 32 + r) * KSB) : (lds + HG_KO + r * KSB);
#pragma unroll
        for (int sg = 0; sg < 8; ++sg) { const bf16x8 a = *(const LAS bf16x8*)(kbase + (16 * sg + 8 * h) * 2), bb = *(const LAS bf16x8*)(lds + HG_QS + (tt * 32 + r) * KSB + (16 * sg + 8 * h) * 2);
            at = MFMA32(a, bb, at); }
        if (st == tt) {
#pragma unroll
            for (int q = 0; q < 16; ++q) at[q] = ((q & 3) + 8 * (q >> 2) + 4 * h <= r) ? at[q] : 0.f; }
#pragma unroll
        for (int sg = 0; sg < 2; ++sg) { const v4u pw = {pk2(at[8 * sg], at[8 * sg + 1]), pk2(at[8 * sg + 2], at[8 * sg + 3]), pk2(at[8 * sg + 4], at[8 * sg + 5]), pk2(at[8 * sg + 6], at[8 * sg + 7])};
            o = MFMA32(as_bf16x8((v4u){vlo[st][sg].x, vlo[st][sg].y, vhi[st][sg].x, vhi[st][sg].y}), as_bf16x8(pw), o); }
    }
    LAS float* SS = (LAS float*)(lds + HG_SS);
    float ss = 0.f;
#pragma unroll
    for (int q = 0; q < 16; ++q) ss += o[q] * o[q];
    ss = pg8::xor32_sum(ss);
    if (h == 0) SS[(tt * 4 + dvt) * 32 + r] = ss;
    LDS_WAIT(); __syncthreads();
    const float tot = (SS[(tt * 4 + 0) * 32 + r] + SS[(tt * 4 + 1) * 32 + r]) + (SS[(tt * 4 + 2) * 32 + r] + SS[(tt * 4 + 3) * 32 + r]);
    const float rr = __builtin_amdgcn_rsqf(tot * (1.f / 128.f) + RMS_EPS);
#pragma unroll
    for (int a = 0; a < 4; ++a) { const int dv0 = dvt * 32 + 8 * a + 4 * h; const f32x4 gn = *(const f32x4*)(gain + dv0); const v2u gb = gbr[a];
        v2u w; w.x = pk2(o[4 * a] * rr * gn.x * bflo(gb.x), o[4 * a + 1] * rr * gn.y * bfhi(gb.x)); w.y = pk2(o[4 * a + 2] * rr * gn.z * bflo(gb.y), o[4 * a + 3] * rr * gn.w * bfhi(gb.y));
        *(v2u*)(orow + CQB + hh * 128 + dv0) = w; }
    __syncthreads();
}
struct Args { const float* in[21]; float* out; unsigned char* ws; int ph_lo, ph_hi; };
enum { IN_X = 0, IN_MEM, IN_F1N, IN_F1W1, IN_F1W3, IN_F1W2, IN_MIXN, IN_WIN, IN_LB, IN_HON, IN_MEMN, IN_WKV, IN_WPA, IN_WPB, IN_WPM, IN_WOUT, IN_F2N, IN_F2W1, IN_F2W3, IN_F2W2, IN_FINN };
constexpr int PH_PER_LAYER = 14, PH_FINAL = DEPTH * PH_PER_LAYER, PH_TOTAL = PH_FINAL + 1;
#ifndef DIS_GEMM
#define GEMM_PHASE(EPI, g, S, E) pg8::gemm_phase<EPI, pg8::StaticOrder, true, true>(lds + RING_OFF, g, S, E)
#else
#define GEMM_PHASE(EPI, g, S, E) do { (void)g; (void)S; (void)E; } while (0)
#endif
#ifdef DIS_G_SWIGLU
#define GEMM_PHASE_SWIGLU(EPI, g, S, E) do { (void)g; (void)S; (void)E; } while (0)
#else
#define GEMM_PHASE_SWIGLU(EPI, g, S, E) GEMM_PHASE(EPI, g, S, E)
#endif
#ifdef DIS_G_KV
#define GEMM_PHASE_KV(EPI, g, S, E) do { (void)g; (void)S; (void)E; } while (0)
#else
#define GEMM_PHASE_KV(EPI, g, S, E) GEMM_PHASE(EPI, g, S, E)
#endif
#ifdef DIS_G_DOWN
#define GEMM_PHASE_DOWN(EPI, g, S, E) do { (void)g; (void)S; (void)E; } while (0)
#else
#define GEMM_PHASE_DOWN(EPI, g, S, E) GEMM_PHASE(EPI, g, S, E)
#endif
#ifdef DIS_G_G3A
#define GEMM_PHASE_G3A(EPI, g, S, E) do { (void)g; (void)S; (void)E; } while (0)
#else
#define GEMM_PHASE_G3A(EPI, g, S, E) GEMM_PHASE(EPI, g, S, E)
#endif
#ifdef DIS_G_G3B
#define GEMM_PHASE_G3B(EPI, g, S, E) do { (void)g; (void)S; (void)E; } while (0)
#else
#define GEMM_PHASE_G3B(EPI, g, S, E) GEMM_PHASE(EPI, g, S, E)
#endif
#ifdef DIS_G_MERGE
#define GEMM_PHASE_MERGE(EPI, g, S, E) do { (void)g; (void)S; (void)E; } while (0)
#else
typedef pg8::MergeOrder<CQA * 2, CQB * 2, CQM * 2, (long)WO_PA, (long)WO_PB, (long)WO_PMM> MergeOrderG4;
#define GEMM_PHASE_MERGE(EPI, g, S, E) pg8::gemm_phase<EPI, MergeOrderG4, true, true>(lds + RING_OFF, g, S, E)
#endif
#ifdef DIS_G_OUT
#define GEMM_PHASE_OUT(EPI, g, S, E) do { (void)g; (void)S; (void)E; } while (0)
#else
#define GEMM_PHASE_OUT(EPI, g, S, E) GEMM_PHASE(EPI, g, S, E)
#endif

__global__ void __launch_bounds__(NWAVES * 64, 2) fwd(Args args) {
    extern __shared__ __attribute__((aligned(16))) unsigned char lds_raw[];
    LAS unsigned char* lds = (LAS unsigned char*)lds_raw;
    const int tid0 = threadIdx.x;
#define PHASE_IDS int tid = tid0; asm volatile("" : "+v"(tid)); const int lane = tid & 63, wave = __builtin_amdgcn_readfirstlane(tid >> 6), gw = vcu * NWAVES + wave; LAS float* scr = (LAS float*)(lds + wave * 19456); (void)lane; (void)gw; (void)scr
    const int G = gridDim.x, bx = blockIdx.x, vcu = (G % 8 == 0) ? (bx % 8) * (G / 8) + bx / 8 : bx;
    volatile LAS unsigned* MISC = (volatile LAS unsigned*)(lds + MISC_OFF);
    for (int u = tid0; u < (LDS_BYTES - MISC_OFF) / 4; u += NWAVES * 64) ((LAS unsigned*)(lds + MISC_OFF))[u] = 0u;
    __syncthreads();
    unsigned char* ws = args.ws;
    XcdBarrier bar = xcd_barrier_post((unsigned*)(ws + WS_CTL) + CW_BAR, MISC + 8);
    const int lo = args.ph_lo, hi = args.ph_hi;
#define RUN(k) (lo <= (k) && (k) < hi)
#define SEAM(k) do { if (RUN(k) && RUN((k) + 1)) xcd_barrier(bar); } while (0)
    float* const out = args.out; const float* const xin = args.in[IN_X];
    float* const RS = (float*)(ws + WS_RS);
    float* const SSQ = (float*)(ws + WS_SSQ);
    bf16* const XB = (bf16*)(ws + WS_R0);
    bf16* const YB = (bf16*)(ws + WS_PG + 192 * MiB);
    bf16* const R0 = (bf16*)(ws + WS_R0); bf16* const PMb = (bf16*)(ws + WS_PM); bf16* const VTb = (bf16*)(ws + WS_VT); bf16* const PGb = (bf16*)(ws + WS_PG);
    bf16* const Wb = (bf16*)(ws + WS_W); bf16* const MEMN = (bf16*)(ws + WS_MEMN); bf16* const WKV = (bf16*)(ws + WS_WKV); bf16* const KMb = (bf16*)(ws + WS_KM); bf16* const VMTb = (bf16*)(ws + WS_VMT);
    const int NGW = G * NWAVES;

#pragma unroll 1
    for (int l = 0; l < DEPTH; ++l) {
        const int pb = l * PH_PER_LAYER;
#pragma unroll 1
        for (int f = 0; f < 2; ++f) {
            const int p0 = pb + (f ? 11 : 0);
#ifndef DIS_THIN
            if (RUN(p0)) {
                PHASE_IDS;
                const float* gn = args.in[f ? IN_F2N : IN_F1N] + (size_t)l * D;
                if (l == 0 && f == 0) { int m = gw;
                    for (; m + NGW < M; m += 2 * NGW) rms_stat_f32_copy_x2(xin + (size_t)m * D, xin + (size_t)(m + NGW) * D, XB + (size_t)m * D, XB + (size_t)(m + NGW) * D, RS + m, RS + m + NGW, lane);
                    if (m < M) { const float r = rms_stat_f32_copy(xin + (size_t)m * D, XB + (size_t)m * D, lane); if (lane == 0) RS[m] = r; } }
                else { for (int m = gw * 64 + lane; m < M; m += NGW * 64) RS[m] = rms_stat_partials(SSQ + (size_t)m * 32); }
                const float* w1 = args.in[f ? IN_F2W1 : IN_F1W1] + (size_t)l * D * DFF; const float* w3 = args.in[f ? IN_F2W3 : IN_F1W3] + (size_t)l * D * DFF; const float* w2 = args.in[f ? IN_F2W2 : IN_F1W2] + (size_t)l * D * DFF;
                convert_matrix(w1, D, DFF, Wb, 1, 0, scr, gw, NGW, lane, gn);
                convert_matrix(w3, D, DFF, Wb, 1, 128, scr, gw, NGW, lane, gn);
                convert_matrix(w2, DFF, D, (bf16*)(ws + WS_W + WO_W2), 0, 0, scr, gw, NGW, lane);
                if (l == 0 && f == 0) {
                    for (int m = gw; m < DEPTH * 512; m += NGW) { const int ll = m >> 9, row = m & 511; rms_row_bf16(args.in[IN_MEM] + (size_t)row * D, args.in[IN_MEMN] + (size_t)ll * D, MEMN + (size_t)m * D, lane); }
                    for (int ll = 0; ll < DEPTH; ++ll) convert_matrix(args.in[IN_WKV] + (size_t)ll * D * 1024, D, 1024, WKV + (size_t)ll * 1024 * D, 0, 0, scr, gw, NGW, lane);
                }
            }
#endif
            SEAM(p0);
            if (RUN(p0 + 1)) {
                { pg8::Gemm g{XB, Wb, M, 2 * DFF, D, D, D}; pg8::StaticOrder S; S.init(M, 2 * DFF, G, bx); pg8::EpiSwiglu E{PGb, DFF, RS}; GEMM_PHASE_SWIGLU(pg8::EpiSwiglu, g, S, E); }
            }
            SEAM(p0 + 1);
            if (RUN(p0 + 2)) { pg8::Gemm g{PGb, (bf16*)(ws + WS_W + WO_W2), M, D, DFF, DFF, DFF}; pg8::StaticOrder S; S.init(M, D, G, bx); pg8::EpiResid E{XB, D, 0.5f, SSQ}; GEMM_PHASE_DOWN(pg8::EpiResid, g, S, E); }
            SEAM(p0 + 2);
            if (f == 0) {
                float* const kml = (float*)(ws + WS_KMEAN) + (size_t)l * 16 * 64 * 128;
                bf16* const POb = (bf16*)(ws + WS_PO); float* const MLb = (float*)(ws + WS_ML); bf16* const STb = (bf16*)(ws + WS_ST); float* const DECb = (float*)(ws + WS_DEC); unsigned* const SELb = (unsigned*)(ws + WS_SEL);
                const float* lbl = args.in[IN_LB];
#ifndef DIS_THIN
                if (RUN(pb + 3)) {
                PHASE_IDS;
                    const float* gn = args.in[IN_MIXN] + (size_t)l * D;
                    for (int m = gw * 64 + lane; m < M; m += NGW * 64) RS[m] = rms_stat_partials(SSQ + (size_t)m * 32);
                    const bool kvwg = (l == 0) && (bx < 32) && ((bx & 7) < 4);
                    if (kvwg) { const int q = bx >> 3, ll = q >> 1, vt = q & 1;
                        const bf16* mn = MEMN + (size_t)ll * 512 * D; const bf16* wk = WKV + (size_t)ll * 1024 * D + (vt ? (size_t)512 * D : 0);
                        pg8::Gemm g{vt ? wk : mn, vt ? mn : wk, 512, 512, D, D, D}; pg8::StaticOrder S; S.init(512, 512, G, bx & 7);
                        pg8::EpiBf16 E{(vt ? VMTb : KMb) + (size_t)ll * 512 * 512, 512, 0u, nullptr, nullptr, nullptr}; GEMM_PHASE_KV(pg8::EpiBf16, g, S, E); }
                    else { int gwc = gw, ngwc = NGW; if (l == 0) { const int below = (bx >= 32) ? 16 : ((bx >> 3) * 4 + ((bx & 7) < 4 ? (bx & 7) : 4)); gwc = (bx - below) * NWAVES + wave; ngwc = (G - 16) * NWAVES; }
                        convert_matrix(args.in[IN_WIN] + (size_t)l * D * NIN, D, NIN, Wb, 2, 0, scr, gwc, ngwc, lane, gn); }
                    convert_matrix(args.in[IN_WPA] + (size_t)l * 1024 * D, 1024, D, (bf16*)(ws + WS_W + WO_PA), 0, 0, scr, gw, NGW, lane);
                    convert_matrix(args.in[IN_WPB] + (size_t)l * 512 * D, 512, D, (bf16*)(ws + WS_W + WO_PB), 0, 0, scr, gw, NGW, lane);
                    convert_matrix(args.in[IN_WPM] + (size_t)l * 512 * D, 512, D, (bf16*)(ws + WS_W + WO_PMM), 0, 0, scr, gw, NGW, lane);
                    convert_matrix(args.in[IN_WOUT] + (size_t)l * D * D, D, D, (bf16*)(ws + WS_W + WO_OUT), 0, 0, scr, gw, NGW, lane);
                }
#endif
                SEAM(pb + 3);
                if (RUN(pb + 4)) {
#pragma unroll 1
                    for (int q = 0; q < 2; ++q) {
                        pg8::Gemm g{q ? Wb + (size_t)NMAIN * D : XB, q ? XB : Wb, q ? NVT : M, q ? M : NMAIN, D, D, D}; pg8::StaticOrder S; S.init(g.M, g.N, G, bx);
                        pg8::EpiBf16 E{q ? VTb : PMb, q ? M : NMAIN, q ? 0u : ((1u << 16) | (1u << 18) | (2u << 24) | (2u << 26)), q ? nullptr : kml, q ? nullptr : RS, q ? RS : nullptr}; GEMM_PHASE_G3A(pg8::EpiBf16, g, S, E); }
                }
                SEAM(pb + 4);
                if (RUN(pb + 5)) {
                PHASE_IDS;
                    #ifndef DIS_LOCAL
                    hgrn_lb_table(lds, lbl, l, tid);
                    { v4u fbr[2] = {}; bf16x8 va[4] = {}; int u = vcu;
                      if (u < 2048) hgrn_local_load(PMb, VTb, u, tid, fbr, va);
#pragma unroll 1
                      for (; u < 2048; u += G) { v4u fbn[2] = {}; bf16x8 van[4] = {}; const bool nx = (u + G) < 2048;
                          if (nx) hgrn_local_load(PMb, VTb, u + G, tid, fbn, van);
                          hgrn_local_unit(lds, STb, DECb, u, tid, fbr, va);
                          if (nx) { fbr[0] = fbn[0]; fbr[1] = fbn[1]; va[0] = van[0]; va[1] = van[1]; va[2] = van[2]; va[3] = van[3]; } } }
#endif
                    #ifndef DIS_SEL
                    for (int u = vcu; u < 1024; u += G) moba_sel_unit(lds, PMb, kml, SELb, u, tid);
#endif
                    #ifndef DIS_MEM
                    for (int u = vcu; u < 512; u += G) mem_attn_unit(lds, PMb, KMb + (size_t)l * 512 * 512, VMTb + (size_t)l * 512 * 512, u, tid);
#endif
                }
                SEAM(pb + 5);
                if (RUN(pb + 6)) {
                PHASE_IDS;
                    #ifndef DIS_PART
                    {
                        unsigned* qctr = (unsigned*)(ws + WS_CTL) + 12288 + 64 * l; LAS unsigned* qslot = (LAS unsigned*)(lds + WCNT_OFF + 32);
                        for (;;) {
                            if (tid == 0) *qslot = __hip_atomic_fetch_add(qctr, 1u, __ATOMIC_RELAXED, __HIP_MEMORY_SCOPE_AGENT);
                            LDS_WAIT(); __syncthreads();
                            const int u = (int)*qslot;
                            if (u >= 16 * 63) break;
                            moba_partial_task(lds, PMb, VTb, SELb, POb, MLb, u & 15, u >> 4, tid);
                        }
                    }
#endif
                    #ifndef DIS_SCAN
                    hgrn_scan(STb, DECb, vcu, G, tid);
#endif
                }
                SEAM(pb + 6);
                if (RUN(pb + 7)) {
                PHASE_IDS;
                    #ifndef DIS_OWN
                    for (int u = vcu; u < 1024; u += G) moba_own_unit(lds, PMb, VTb, SELb, POb, MLb, u, tid);
#endif
                    #ifndef DIS_HOUT
                    hgrn_lb_table(lds, lbl, l, tid);
                    { HoutPre P = {}; int u = vcu;
                      if (u < 2048) hgrn_out_load(PMb, VTb, STb, u, tid, P);
#pragma unroll 1
                      for (; u < 2048; u += G) { HoutPre Pn = {}; const bool nx = (u + G) < 2048;
                          if (nx) hgrn_out_load(PMb, VTb, STb, u + G, tid, Pn);
                          hgrn_out_unit(lds, PMb, args.in[IN_HON] + (size_t)l * 128, u, tid, P);
                          if (nx) P = Pn; } }
#endif
                }
                SEAM(pb + 7);
                if (RUN(pb + 8)) { pg8::Gemm g{XB, Wb + (size_t)(NMAIN + NVT) * D, M, NGATE, D, D, D}; pg8::StaticOrder S; S.init(M, NGATE, G, bx); pg8::EpiGateU8 E{(unsigned char*)PGb, NGATE, RS}; GEMM_PHASE_G3B(pg8::EpiGateU8, g, S, E); }
                SEAM(pb + 8);
                if (RUN(pb + 9)) {
                    pg8::Gemm g{PMb, (bf16*)(ws + WS_W + WO_PA), M, D, 1024, NMAIN, 1024};
                    MergeOrderG4 S; S.T.init(M, D, G, bx); S.A0 = (const char*)PMb; S.W0 = (const char*)(ws + WS_W);
                    pg8::EpiMergeR E{YB, D, (const unsigned char*)PGb, NGATE}; GEMM_PHASE_MERGE(pg8::EpiMergeR, g, S, E);
                }
                SEAM(pb + 9);
                if (RUN(pb + 10)) { pg8::Gemm g{YB, (bf16*)(ws + WS_W + WO_OUT), M, D, D, D, D}; pg8::StaticOrder S; S.init(M, D, G, bx); pg8::EpiResid E{XB, D, 1.0f, SSQ}; GEMM_PHASE_OUT(pg8::EpiResid, g, S, E); }
                SEAM(pb + 10);
            }
        }
    }
#ifndef DIS_THIN
    if (RUN(PH_FINAL)) { PHASE_IDS; const float* gn = args.in[IN_FINN]; if (M % (4 * NGW) == 0) { for (int m = gw; m < M; m += 4 * NGW) rms_xb_f32_x4(XB + (size_t)m * D, (size_t)NGW * D, gn, out + (size_t)m * D, (size_t)NGW * D, lane); }
        else { for (int m = gw; m < M; m += NGW) rms_xb_f32(XB + (size_t)m * D, gn, out + (size_t)m * D, lane); } }
#endif
#undef RUN
#undef SEAM
}

extern "C" void kernel_launch(void* const* d_in, const int* in_sizes, int n_in, void* d_out, int out_size, void* d_ws, size_t ws_size, hipStream_t stream) {
    static int grid = 0;
    if (grid == 0) {
        if (n_in != 21 || in_sizes[0] != M * D || out_size != M * D || ws_size < WS_END) { fprintf(stderr, "kernel_launch: unexpected shapes (n_in %d, in0 %d, out %d, ws %zu); nothing launched\n", n_in, n_in > 0 ? in_sizes[0] : -1, out_size, ws_size); grid = -1; return; }
        int dev = 0, cus = 0, per_cu = 0;
        if (hipGetDevice(&dev) != hipSuccess || hipDeviceGetAttribute(&cus, hipDeviceAttributeMultiprocessorCount, dev) != hipSuccess) { grid = -1; return; }
        if (hipFuncSetAttribute((const void*)fwd, hipFuncAttributeMaxDynamicSharedMemorySize, LDS_BYTES) != hipSuccess) { fprintf(stderr, "kernel_launch: hipFuncSetAttribute failed\n"); grid = -1; return; }
        if (hipOccupancyMaxActiveBlocksPerMultiprocessor(&per_cu, (const void*)fwd, NWAVES * 64, LDS_BYTES) != hipSuccess || per_cu < 1) fprintf(stderr, "kernel_launch: note: occupancy query reports %d\n", per_cu);
        (void)hipGetLastError();
        grid = cus;
    }
    if (grid < 0) return;
    if (hipMemsetAsync((char*)d_ws + WS_CTL, 0, CTL_ZERO_BYTES, stream) != hipSuccess) return;
    Args a{};
    for (int i = 0; i < 21; ++i) a.in[i] = (const float*)d_in[i];
    a.out = (float*)d_out; a.ws = (unsigned char*)d_ws; a.ph_lo = 0; a.ph_hi = PH_TOTAL;
    hipLaunchKernelGGL(fwd, dim3(grid), dim3(NWAVES * 64), LDS_BYTES, stream, a);
}
```
